# Optimizing an MI355X kernel written in HIP

```python
import jax, jax.numpy as jnp
from jax import lax
import numpy as np

D_MODEL = 1024
BATCH = 4
SEQ = 8192
DEPTH = 1

GRID_W = 64
CTX_LEN = 256
GLA_HEADS = 4
GLA_DK = 64
GLA_DV = 128
GLA_WIDTH = GLA_HEADS * GLA_DV
GATE_RANK = 16
GATE_NORMALIZER = 16.0
CHUNK = 64
POOL_WINDOWS = (2, 4, 8, 16)
POOL_GROUP = 128
POOL_WIDTH = POOL_GROUP * len(POOL_WINDOWS)
MIX_WIDTH = GLA_WIDTH + POOL_WIDTH
Q_COLS = GLA_HEADS * GLA_DK
K_COLS = GLA_HEADS * GLA_DK
V_COLS = GLA_WIDTH
G_COLS = GLA_WIDTH
A_COLS = 2 * GATE_RANK
P_COLS = POOL_WIDTH
OFF_K = Q_COLS
OFF_V = OFF_K + K_COLS
OFF_G = OFF_V + V_COLS
OFF_A = OFF_G + G_COLS
OFF_P = OFF_A + A_COLS
IN_COLS = OFF_P + P_COLS
N_GROUPS = 4
EXPERTS_PER_GROUP = 8
N_EXPERTS = N_GROUPS * EXPERTS_PER_GROUP
TOP_K_INNER = 2
D_EXPERT = 256
EPS = 1e-6

kernel_name = "hybrid_gla_pool_hmoe_prefix_dit"


def rmsnorm(x, g):
    xf = x.astype(jnp.float32)
    y = xf * lax.rsqrt(jnp.mean(xf * xf, axis=-1, keepdims=True) + EPS)
    return (y * g).astype(x.dtype)


def modulate(h, shift, scale):
    return h * (1.0 + scale) + shift


def flip(t):
    return jnp.flip(t, axis=1)


def split_heads_qkv(q, k, v):
    B, L, _ = q.shape
    q = q.reshape(B, L, GLA_HEADS, GLA_DK) * (GLA_DK ** -0.5)
    k = k.reshape(B, L, GLA_HEADS, GLA_DK)
    v = v.reshape(B, L, GLA_HEADS, GLA_DV)
    return q, k, v


def log_decay(a_low, w_dec, b_dec):
    B, L, _ = a_low.shape
    a = a_low.reshape(B, L, 2, GATE_RANK).astype(jnp.float32)
    la = jax.nn.log_sigmoid(jnp.einsum('bldr,drk->bldk', a, w_dec) + b_dec) / GATE_NORMALIZER
    la = la.reshape(B, L, 2, GLA_HEADS, GLA_DK)
    return la[:, :, 0], la[:, :, 1]


def gla_state(k, v, la, s0):
    B, L, H, dk = k.shape
    dv = v.shape[-1]
    N = L // CHUNK
    kc = k.reshape(B, N, CHUNK, H, dk).astype(jnp.float32)
    vc = v.reshape(B, N, CHUNK, H, dv)
    b = jnp.cumsum(la.reshape(B, N, CHUNK, H, dk), axis=2)
    b_last = b[:, :, -1]
    k_st = kc * jnp.exp(b_last[:, :, None] - b)
    d_state = jnp.einsum('bnchd,bnche->nbhde', k_st, vc)
    decay = jnp.exp(b_last).transpose(1, 0, 2, 3)

    def step(S, inp):
        d, ds = inp
        return d[..., None] * S + ds, S

    s_fin, s_prev = lax.scan(step, s0, (decay, d_state))
    return s_prev, s_fin, b


def gla_chunked(q, k, v, la, s0):
    s_prev, s_fin, b = gla_state(k, v, la, s0)
    B, L, H, dk = q.shape
    dv = v.shape[-1]
    N = L // CHUNK
    qb = q.reshape(B, N, CHUNK, H, dk).astype(jnp.float32) * jnp.exp(b)
    kb = k.reshape(B, N, CHUNK, H, dk).astype(jnp.float32) * jnp.exp(-b)
    vc = v.reshape(B, N, CHUNK, H, dv)
    mask = jnp.tril(jnp.ones((CHUNK, CHUNK), dtype=bool))
    scores = jnp.where(mask, jnp.einsum('bnihd,bnjhd->bnhij', qb, kb), 0.0)
    o = jnp.einsum('bnhij,bnjhe->bnihe', scores, vc) + jnp.einsum('bnihd,nbhde->bnihe', qb, s_prev)
    return o.reshape(B, L, H, dv), s_fin


def gla_bidirectional(q, k, v, la_f, la_b, s0_f, s0_b):
    o_f, s_f = gla_chunked(q, k, v, la_f, s0_f)
    o_b, s_b = gla_chunked(flip(q), flip(k), flip(v), flip(la_b), s0_b)
    return o_f + flip(o_b), s_f, s_b


def window_mean(x, w, axis):
    n = x.shape[axis]
    lo = w // 2
    hi = w - 1 - lo
    cs = jnp.cumsum(x.astype(jnp.float32), axis=axis)
    pad = [(0, 0)] * x.ndim
    pad[axis] = (1, 0)
    cs = jnp.pad(cs, pad)
    idx = np.arange(n)
    start = np.clip(idx - lo, 0, n)
    end = np.clip(idx + hi + 1, 0, n)
    s = jnp.take(cs, jnp.asarray(end), axis=axis) - jnp.take(cs, jnp.asarray(start), axis=axis)
    cshape = [1] * x.ndim
    cshape[axis] = n
    cnt = jnp.asarray((end - start).astype(np.float32).reshape(cshape))
    return s / cnt


def pool_mixer(p, w_pool, pool_scale, rows):
    B, L, _ = p.shape
    groups = p.reshape(B, L, len(POOL_WINDOWS), POOL_GROUP)
    outs = []
    for gi, w in enumerate(POOL_WINDOWS):
        xg = groups[:, :, gi]
        if rows is None:
            m = window_mean(xg, w, 1)
        else:
            xg2 = xg.reshape(B, rows, GRID_W, POOL_GROUP)
            m = window_mean(window_mean(xg2, w, 2), w, 1).reshape(B, L, POOL_GROUP)
        outs.append(m - xg)
    y = jnp.stack(outs, axis=2)
    y = jnp.einsum('blgc,gcd->blgd', y, w_pool).reshape(B, L, POOL_WIDTH)
    return y * pool_scale


def token_mixer(h, w_in, w_dec, b_dec, gla_norm_g, w_pool, pool_scale, w_out, s0_f, s0_b, rows):
    B, L, _ = h.shape
    proj = h @ w_in
    q, k, v, g, a_low, p = jnp.split(proj, [OFF_K, OFF_V, OFF_G, OFF_A, OFF_P], axis=-1)
    q, k, v = split_heads_qkv(q, k, v)
    la_f, la_b = log_decay(a_low, w_dec, b_dec)
    o, s_f, s_b = gla_bidirectional(q, k, v, la_f, la_b, s0_f, s0_b)
    o = rmsnorm(o, gla_norm_g).reshape(B, L, GLA_WIDTH) * jax.nn.silu(g)
    pooled = pool_mixer(p, w_pool, pool_scale, rows)
    out = jnp.concatenate([o, pooled.astype(o.dtype)], axis=-1) @ w_out
    return out, s_f, s_b


def context_states(h, w_in, w_dec, b_dec):
    B, L, _ = h.shape
    kv = h @ w_in[:, OFF_K:OFF_G]
    a_low = h @ w_in[:, OFF_A:OFF_P]
    k = kv[..., :K_COLS].reshape(B, L, GLA_HEADS, GLA_DK)
    v = kv[..., K_COLS:].reshape(B, L, GLA_HEADS, GLA_DV)
    la_f, la_b = log_decay(a_low, w_dec, b_dec)
    s0 = jnp.zeros((B, GLA_HEADS, GLA_DK, GLA_DV), jnp.float32)
    _, s_f, _ = gla_state(k, v, la_f, s0)
    _, s_b, _ = gla_state(flip(k), flip(v), flip(la_b), s0)
    return s_f, s_b


def hier_moe(h, w_rg, w_re, w_e_in, w_e_out):
    B, L, D = h.shape
    t = h.reshape(-1, D)
    pg = jax.nn.softmax((t @ w_rg).astype(jnp.float32), axis=-1)
    gp, gi = lax.top_k(pg, 1)
    le = (t @ w_re).astype(jnp.float32).reshape(-1, N_GROUPS, EXPERTS_PER_GROUP)
    le = jnp.take_along_axis(le, gi[:, :, None], axis=1)[:, 0]
    ew, ei = lax.top_k(jax.nn.softmax(le, axis=-1), TOP_K_INNER)
    ew = ew / jnp.sum(ew, axis=-1, keepdims=True)
    weights = gp * ew
    eid = gi * EXPERTS_PER_GROUP + ei
    gates = jnp.einsum('tk,tke->et', weights, jax.nn.one_hot(eid, N_EXPERTS, dtype=jnp.float32))

    def body(acc, inp):
        wi, wo, ge = inp
        a, u = jnp.split(t @ wi, 2, axis=-1)
        return acc + ((jax.nn.silu(a) * u) @ wo) * ge[:, None], None

    y, _ = lax.scan(body, jnp.zeros(t.shape, jnp.float32), (w_e_in, w_e_out, gates))
    return y.reshape(B, L, D).astype(h.dtype)


def setup_inputs(seed: int = 0) -> dict:
    key = jax.random.key(seed)
    ks = jax.random.split(key, 24)
    f32 = jnp.float32

    def nrm(k, shape, s):
        return jax.random.normal(k, shape, f32) * s

    D = D_MODEL
    return {
        "x": nrm(ks[0], (BATCH, SEQ, D), 1.0),
        "c": nrm(ks[1], (BATCH, D), 1.0),
        "ctx": nrm(ks[2], (BATCH, CTX_LEN, D), 1.0),
        "c_ctx": nrm(ks[3], (D,), 1.0),
        "w_ada": nrm(ks[4], (DEPTH, D, 6 * D), D ** -0.5),
        "b_ada": nrm(ks[5], (DEPTH, 6 * D), 0.02),
        "norm1_g": 1.0 + nrm(ks[6], (DEPTH, D), 0.02),
        "w_in": nrm(ks[7], (DEPTH, D, IN_COLS), D ** -0.5),
        "w_decay": nrm(ks[8], (DEPTH, 2, GATE_RANK, GLA_HEADS * GLA_DK), GATE_RANK ** -0.5),
        "b_decay": nrm(ks[9], (DEPTH, 2, GLA_HEADS * GLA_DK), 0.1),
        "gla_norm_g": 1.0 + nrm(ks[10], (DEPTH, GLA_DV), 0.02),
        "w_pool": nrm(ks[11], (DEPTH, len(POOL_WINDOWS), POOL_GROUP, POOL_GROUP), POOL_GROUP ** -0.5),
        "pool_scale": 1.0 + nrm(ks[12], (DEPTH, POOL_WIDTH), 0.02),
        "w_out": nrm(ks[13], (DEPTH, MIX_WIDTH, D), MIX_WIDTH ** -0.5),
        "norm2_g": 1.0 + nrm(ks[14], (DEPTH, D), 0.02),
        "w_router_group": nrm(ks[15], (DEPTH, D, N_GROUPS), D ** -0.5),
        "w_router_expert": nrm(ks[16], (DEPTH, D, N_EXPERTS), D ** -0.5),
        "w_expert_in": nrm(ks[17], (DEPTH, N_EXPERTS, D, 2 * D_EXPERT), D ** -0.5),
        "w_expert_out": nrm(ks[18], (DEPTH, N_EXPERTS, D_EXPERT, D), D_EXPERT ** -0.5),
        "final_norm_g": 1.0 + nrm(ks[19], (D,), 0.02),
    }


def reference(x, c, ctx, c_ctx, w_ada, b_ada, norm1_g, w_in, w_decay, b_decay, gla_norm_g, w_pool,
              pool_scale, w_out, norm2_g, w_router_group, w_router_expert, w_expert_in, w_expert_out,
              final_norm_g):
    rows = x.shape[1] // GRID_W
    xc = ctx
    for i in range(DEPTH):
        mod = jax.nn.silu(c) @ w_ada[i] + b_ada[i]
        sh_a, sc_a, gt_a, sh_m, sc_m, gt_m = jnp.split(mod[:, None, :], 6, axis=-1)
        mod_c = jax.nn.silu(c_ctx) @ w_ada[i] + b_ada[i]
        csh_a, csc_a, cgt_a, csh_m, csc_m, cgt_m = jnp.split(mod_c, 6, axis=-1)

        hc = modulate(rmsnorm(xc, norm1_g[i]), csh_a, csc_a)
        if i + 1 < DEPTH:
            zero_s = jnp.zeros((xc.shape[0], GLA_HEADS, GLA_DK, GLA_DV), jnp.float32)
            out_c, s_f, s_b = token_mixer(hc, w_in[i], w_decay[i], b_decay[i], gla_norm_g[i], w_pool[i],
                                          pool_scale[i], w_out[i], zero_s, zero_s, None)
            xc_next = xc + (cgt_a * out_c).astype(xc.dtype)
            hc2 = modulate(rmsnorm(xc_next, norm2_g[i]), csh_m, csc_m)
            xc_next = xc_next + (cgt_m * hier_moe(hc2, w_router_group[i], w_router_expert[i],
                                                  w_expert_in[i], w_expert_out[i])).astype(xc.dtype)
        else:
            s_f, s_b = context_states(hc, w_in[i], w_decay[i], b_decay[i])
            xc_next = xc

        h = modulate(rmsnorm(x, norm1_g[i]), sh_a, sc_a)
        out, _, _ = token_mixer(h, w_in[i], w_decay[i], b_decay[i], gla_norm_g[i], w_pool[i],
                                pool_scale[i], w_out[i], s_f, s_b, rows)
        x = x + (gt_a * out).astype(x.dtype)
        h2 = modulate(rmsnorm(x, norm2_g[i]), sh_m, sc_m)
        x = x + (gt_m * hier_moe(h2, w_router_group[i], w_router_expert[i],
                                 w_expert_in[i], w_expert_out[i])).astype(x.dtype)
        xc = xc_next
    return rmsnorm(x, final_norm_g)
```

```cpp
#include <hip/hip_runtime.h>
#include <cstdint>
#include <cstdio>

typedef unsigned short bf16;
typedef unsigned v4u __attribute__((ext_vector_type(4)));
typedef float f32x4 __attribute__((ext_vector_type(4)));

constexpr int D = 1024, NB = 4, SEQ = 8192, T = NB * SEQ, CTXL = 256, TC = NB * CTXL, TT = T + TC;
constexpr int IN_COLS = 2080, OFF_A = 1536, OFF_P = 1568;
constexpr int NPROJ = 2048;
constexpr int PQ = 0, PK = 256, PV = 512, PG = 1024, PP = 1536;
constexpr int NSI = 33;
constexpr int NE = 32, DE = 256;
constexpr float EPS = 1e-6f;

constexpr size_t MiB = 1u << 20;
constexpr size_t WS_CTL = 0, CTL_BYTES = 1 * MiB;
constexpr size_t WS_MOD = 1 * MiB;
constexpr size_t WS_WIN = 2 * MiB;
constexpr size_t WS_WA = 6 * MiB;
constexpr size_t WS_WOUT = 7 * MiB;
constexpr size_t WS_WR = 10 * MiB;
constexpr size_t WS_DEC = 11 * MiB;
constexpr size_t WS_RW = 12 * MiB;
constexpr size_t WS_LIST = 13 * MiB;
constexpr size_t WS_WE1 = 18 * MiB;
constexpr size_t WS_WE2 = 50 * MiB;
constexpr size_t WS_H = 66 * MiB;
constexpr size_t WS_ALOW = 132 * MiB;
constexpr size_t WS_PROJ = 138 * MiB;
constexpr size_t WS_DST = 270 * MiB;
constexpr size_t WS_SPREV = 303 * MiB;
constexpr size_t WS_MIX = 336 * MiB;
constexpr size_t WS_HID = 400 * MiB;
constexpr size_t WS_BC = 436 * MiB;
constexpr size_t WS_END = 502 * MiB;
constexpr int CW_CNT = 1024;

constexpr int LDS_BYTES = 147456;
constexpr int NPHASE = 12;

struct Params { const float* in[20]; float* out; unsigned char* ws; int ph_lo, ph_hi; };

__device__ __forceinline__ float bf2f(unsigned b) { return __uint_as_float(b << 16); }
__device__ __forceinline__ unsigned f2bf(float f) { unsigned u = __float_as_uint(f); return (u + 0x7fffu + ((u >> 16) & 1u)) >> 16; }
__device__ __forceinline__ unsigned pk2(float lo, float hi) { return f2bf(lo) | (f2bf(hi) << 16); }
__device__ __forceinline__ float wave_sum(float v) {
#pragma unroll
    for (int o = 1; o < 64; o <<= 1) v += __shfl_xor(v, o);
    return v;
}
__device__ __forceinline__ float silu(float s) { return s / (1.f + __expf(-s)); }
__device__ __forceinline__ float dot8(v4u a, v4u b) {
    float s = 0.f;
#pragma unroll
    for (int i = 0; i < 4; ++i) {
        s += __uint_as_float(a[i] << 16) * __uint_as_float(b[i] << 16);
        s += __uint_as_float(a[i] & 0xffff0000u) * __uint_as_float(b[i] & 0xffff0000u);
    }
    return s;
}
__device__ __forceinline__ float dot_bf16(const bf16* a, const bf16* b, int K) {
    const v4u* a4 = (const v4u*)a; const v4u* b4 = (const v4u*)b;
    float acc = 0.f;
    for (int k = 0; k < K / 8; ++k) acc += dot8(a4[k], b4[k]);
    return acc;
}


__device__ __forceinline__ void wave_dot4(const bf16* a, const bf16* b, size_t ldb, int K, int lane, float (&out)[4]) {
    float acc[4] = {0.f, 0.f, 0.f, 0.f};
    for (int c = lane; c < K / 8; c += 64) {
        const v4u av = ((const v4u*)a)[c];
#pragma unroll
        for (int q = 0; q < 4; ++q) acc[q] += dot8(av, ((const v4u*)(b + q * ldb))[c]);
    }
#pragma unroll
    for (int q = 0; q < 4; ++q) out[q] = wave_sum(acc[q]);
}

__device__ __forceinline__ void transpose_item(const float* W, int ldw, int nblk, bf16* WT, int ldt, float* scr, int item, int lane) {
    const int kb = item / nblk, nb = item - kb * nblk, k0 = 64 * kb, n0 = 32 * nb;
#pragma unroll 8
    for (int i = 0; i < 32; ++i) { const int kk = 2 * i + (lane >> 5); scr[kk * 33 + (lane & 31)] = W[(size_t)(k0 + kk) * ldw + n0 + (lane & 31)]; }
    asm volatile("s_waitcnt lgkmcnt(0)" ::: "memory");
    const int c = lane & 7;
#pragma unroll
    for (int j = 0; j < 4; ++j) { const int n = (lane >> 3) + 8 * j; const float* s = scr + (8 * c) * 33 + n;
        v4u o; o.x = pk2(s[0 * 33], s[1 * 33]); o.y = pk2(s[2 * 33], s[3 * 33]); o.z = pk2(s[4 * 33], s[5 * 33]); o.w = pk2(s[6 * 33], s[7 * 33]);
        *(v4u*)(WT + (size_t)(n0 + n) * ldt + k0 + 8 * c) = o; }
    asm volatile("s_waitcnt lgkmcnt(0)" ::: "memory");
}

__device__ __forceinline__ void phase0(const Params& p, unsigned char* lds) {
    const int tid = threadIdx.x, lane = tid & 63, wave = tid >> 6, G = gridDim.x;
    const int gtid = blockIdx.x * 512 + tid, gthreads = G * 512;
    float* MOD = (float*)(p.ws + WS_MOD);
    const float* c = p.in[1]; const float* cctx = p.in[3]; const float* w_ada = p.in[4]; const float* b_ada = p.in[5];
    for (int idx = gtid; idx < 5 * 6144; idx += gthreads) {
        const int v = idx / 6144, j = idx - v * 6144;
        const float* cv = v < 4 ? c + v * 1024 : cctx;
        float acc = b_ada[j];
        for (int k = 0; k < 1024; ++k) acc += silu(cv[k]) * w_ada[(size_t)k * 6144 + j];
        MOD[idx] = acc;
    }
    const float* w_in = p.in[7];
    float* WA = (float*)(p.ws + WS_WA);
    for (int idx = gtid; idx < 32 * 1024; idx += gthreads) { const int jj = idx >> 10, k = idx & 1023; WA[idx] = w_in[(size_t)k * IN_COLS + OFF_A + jj]; }
    const float* w_rg = p.in[15]; const float* w_re = p.in[16];
    float* WR = (float*)(p.ws + WS_WR);
    for (int idx = gtid; idx < 36 * 1024; idx += gthreads) { const int r = idx >> 10, k = idx & 1023; WR[idx] = r < 4 ? w_rg[k * 4 + r] : w_re[k * 32 + (r - 4)]; }
    float* scr = (float*)(lds + wave * 8448);
    const int gw = blockIdx.x * 8 + wave, NGW = G * 8;
    bf16* WIN = (bf16*)(p.ws + WS_WIN); bf16* WOUT = (bf16*)(p.ws + WS_WOUT); bf16* WE1 = (bf16*)(p.ws + WS_WE1); bf16* WE2 = (bf16*)(p.ws + WS_WE2);
    const float* w_out = p.in[13]; const float* w_e_in = p.in[17]; const float* w_e_out = p.in[18];
    constexpr int I_A = 16 * 48, I_P = 16 * 16, I_O = 16 * 32, I_E1 = 32 * 256, I_E2 = 32 * 128;
    for (int it = gw; it < I_A + I_P + I_O + I_E1 + I_E2; it += NGW) {
        int r = it;
        if (r < I_A) { transpose_item(w_in, IN_COLS, 48, WIN, 1024, scr, r, lane); continue; } r -= I_A;
        if (r < I_P) { transpose_item(w_in + OFF_P, IN_COLS, 16, WIN + (size_t)1536 * 1024, 1024, scr, r, lane); continue; } r -= I_P;
        if (r < I_O) { transpose_item(w_out, 1024, 32, WOUT, 1024, scr, r, lane); continue; } r -= I_O;
        if (r < I_E1) { const int e = r >> 8, sub = (r >> 6) & 3, item = r & 63, pn = sub >> 1, half = sub & 1;
            transpose_item(w_e_in + (size_t)e * 1024 * 512 + half * 256 + 128 * pn, 512, 4, WE1 + (size_t)e * 512 * 1024 + (size_t)(256 * pn + 128 * half) * 1024, 1024, scr, item, lane); continue; } r -= I_E1;
        { const int e = r >> 7, item = r & 127;
            transpose_item(w_e_out + (size_t)e * 256 * 1024, 1024, 32, WE2 + (size_t)e * 1024 * 256, 256, scr, item, lane); }
    }
}

__device__ __forceinline__ void phase1(const Params& p) {
    const int tid = threadIdx.x, lane = tid & 63, wave = tid >> 6, G = gridDim.x;
    const int gw = blockIdx.x * 8 + wave, NGW = G * 8;
    const float* MOD = (const float*)(p.ws + WS_MOD); const float* WA = (const float*)(p.ws + WS_WA);
    bf16* H = (bf16*)(p.ws + WS_H); float* ALOW = (float*)(p.ws + WS_ALOW);
    const float* g1 = p.in[6];
    for (int row = gw; row < TT; row += NGW) {
        const float* xr; int mrow;
        if (row < T) { xr = p.in[0] + (size_t)row * D; mrow = row >> 13; } else { xr = p.in[2] + (size_t)(row - T) * D; mrow = 4; }
        const float* md = MOD + mrow * 6144;
        f32x4 v[4]; float ss = 0.f;
#pragma unroll
        for (int j = 0; j < 4; ++j) { v[j] = ((const f32x4*)xr)[lane + 64 * j]; ss += v[j].x * v[j].x + v[j].y * v[j].y + v[j].z * v[j].z + v[j].w * v[j].w; }
        const float r = 1.f / sqrtf(wave_sum(ss) * (1.f / D) + EPS);
#pragma unroll
        for (int j = 0; j < 4; ++j) {
            const f32x4 g = ((const f32x4*)g1)[lane + 64 * j], sh = ((const f32x4*)md)[lane + 64 * j], sc = ((const f32x4*)(md + 1024))[lane + 64 * j];
            v[j] = v[j] * r * g * (sc + 1.f) + sh;
            unsigned long long o = (unsigned long long)pk2(v[j].x, v[j].y) | ((unsigned long long)pk2(v[j].z, v[j].w) << 32);
            ((unsigned long long*)(H + (size_t)row * D))[lane + 64 * j] = o;
        }
        for (int jj = 0; jj < 32; ++jj) {
            float s = 0.f;
#pragma unroll
            for (int j = 0; j < 4; ++j) { const f32x4 w = ((const f32x4*)(WA + jj * 1024))[lane + 64 * j]; s += v[j].x * w.x + v[j].y * w.y + v[j].z * w.z + v[j].w * w.w; }
            s = wave_sum(s);
            if (lane == 0) ALOW[(size_t)row * 32 + jj] = s;
        }
    }
}

__device__ __forceinline__ void phase2(const Params& p) {
    const int lane = threadIdx.x & 63, gw = blockIdx.x * 8 + (threadIdx.x >> 6), NGW = gridDim.x * 8;
    const bf16* H = (const bf16*)(p.ws + WS_H); const bf16* WIN = (const bf16*)(p.ws + WS_WIN); bf16* PROJ = (bf16*)(p.ws + WS_PROJ);
    for (int task = gw; task < TT * (NPROJ / 4); task += NGW) {
        const int row = task >> 9, n = (task & 511) * 4;
        float o[4]; wave_dot4(H + (size_t)row * D, WIN + (size_t)n * D, D, D, lane, o);
        if (lane == 0) *(unsigned long long*)(PROJ + (size_t)row * NPROJ + n) = (unsigned long long)pk2(o[0], o[1]) | ((unsigned long long)pk2(o[2], o[3]) << 32);
    }
}

__device__ __forceinline__ void phase3(const Params& p) {
    const int gtid = blockIdx.x * 512 + threadIdx.x, gthreads = gridDim.x * 512;
    const float* ALOW = (const float*)(p.ws + WS_ALOW); float* BC = (float*)(p.ws + WS_BC);
    const float* w_dec = p.in[8]; const float* b_dec = p.in[9];
    for (int idx = gtid; idx < (TT / 64) * 512; idx += gthreads) {
        const int c = idx >> 9, dir = (idx >> 8) & 1, hd = idx & 255;
        float wd[16];
#pragma unroll
        for (int r = 0; r < 16; ++r) wd[r] = w_dec[dir * 4096 + r * 256 + hd];
        const float bd = b_dec[dir * 256 + hd];
        float cum = 0.f;
        for (int jj = 0; jj < 64; ++jj) {
            const int j = dir ? 63 - jj : jj; const size_t row = (size_t)c * 64 + j;
            float z = bd;
#pragma unroll
            for (int r = 0; r < 16; ++r) z += ALOW[row * 32 + dir * 16 + r] * wd[r];
            const float la = (fminf(z, 0.f) - log1pf(__expf(-fabsf(z)))) * (1.f / 16.f);
            cum += la;
            BC[(row * 2 + dir) * 256 + hd] = cum;
        }
    }
}

__device__ __forceinline__ int row_base(int b, int si) { return si == 0 ? T + b * CTXL : b * SEQ + (si - 1) * 256; }
__device__ __forceinline__ void phase4(const Params& p) {
    const int tid = threadIdx.x, G = gridDim.x;
    const bf16* PROJ = (const bf16*)(p.ws + WS_PROJ); const float* BC = (const float*)(p.ws + WS_BC);
    float* DST = (float*)(p.ws + WS_DST); float* DEC = (float*)(p.ws + WS_DEC);
    const int d = tid >> 3, e0 = (tid & 7) * 16;
    for (int u = blockIdx.x; u < 2 * NB * NSI * 4; u += G) {
        const int h = u & 3, si = (u >> 2) % NSI, b = ((u >> 2) / NSI) & 3, dir = (u >> 2) / (NSI * NB);
        const int base = row_base(b, si);
        float L[16];
#pragma unroll
        for (int e = 0; e < 16; ++e) L[e] = 0.f;
        float dectot = 1.f;
        for (int cc = 0; cc < 4; ++cc) {
            const int c = dir ? 3 - cc : cc, r0 = base + 64 * c, jl = dir ? r0 : r0 + 63;
            const float blast = BC[((size_t)jl * 2 + dir) * 256 + h * 64 + d], dec = __expf(blast);
            dectot *= dec;
#pragma unroll
            for (int e = 0; e < 16; ++e) L[e] *= dec;
            for (int j = 0; j < 64; ++j) {
                const size_t row = (size_t)r0 + j;
                const float kst = bf2f(PROJ[row * NPROJ + PK + h * 64 + d]) * __expf(blast - BC[(row * 2 + dir) * 256 + h * 64 + d]);
                const v4u v0 = *(const v4u*)(PROJ + row * NPROJ + PV + h * 128 + e0), v1 = *(const v4u*)(PROJ + row * NPROJ + PV + h * 128 + e0 + 8);
#pragma unroll
                for (int q = 0; q < 4; ++q) { L[2 * q] += kst * __uint_as_float(v0[q] << 16); L[2 * q + 1] += kst * __uint_as_float(v0[q] & 0xffff0000u);
                    L[8 + 2 * q] += kst * __uint_as_float(v1[q] << 16); L[8 + 2 * q + 1] += kst * __uint_as_float(v1[q] & 0xffff0000u); }
            }
        }
#pragma unroll
        for (int e = 0; e < 16; ++e) DST[(size_t)u * 8192 + d * 128 + e0 + e] = L[e];
        if ((tid & 7) == 0) DEC[u * 64 + d] = dectot;
    }
}

__device__ __forceinline__ void phase5(const Params& p) {
    const int gtid = blockIdx.x * 512 + threadIdx.x, gthreads = gridDim.x * 512;
    const float* DST = (const float*)(p.ws + WS_DST); const float* DEC = (const float*)(p.ws + WS_DEC); float* SPREV = (float*)(p.ws + WS_SPREV);
    for (int idx = gtid; idx < 2 * NB * 4 * 8192; idx += gthreads) {
        const int de = idx & 8191, h = (idx >> 13) & 3, b = (idx >> 15) & 3, dir = idx >> 17, d = de >> 7;
        const int u0 = ((dir * NB + b) * NSI + 0) * 4 + h;
        float S = DST[(size_t)u0 * 8192 + de];
        for (int step = 0; step < 32; ++step) {
            const int si = dir ? 32 - step : 1 + step;
            const int u = ((dir * NB + b) * NSI + si) * 4 + h;
            SPREV[(size_t)u * 8192 + de] = S;
            S = DEC[u * 64 + d] * S + DST[(size_t)u * 8192 + de];
        }
    }
}

__device__ __forceinline__ void phase6(const Params& p, unsigned char* lds) {
    const int tid = threadIdx.x, G = gridDim.x;
    const bf16* PROJ = (const bf16*)(p.ws + WS_PROJ); const float* BC = (const float*)(p.ws + WS_BC);
    const float* SPREV = (const float*)(p.ws + WS_SPREV); float* OACC = (float*)(p.ws + WS_H); bf16* MIX = (bf16*)(p.ws + WS_MIX);
    const float* gng = p.in[10];
    float* S = (float*)lds;
    float* SC = (float*)(lds + 32768);
    const int i = tid >> 3, j0 = (tid & 7) * 8, e0 = (tid & 7) * 16;
    for (int unit = blockIdx.x; unit < NB * 32 * 4; unit += G) {
        const int h = unit & 3, sc = (unit >> 2) & 31, b = unit >> 7;
        const int base = b * SEQ + sc * 256;
        for (int dir = 0; dir < 2; ++dir) {
            const int u = ((dir * NB + b) * NSI + (sc + 1)) * 4 + h;
            __syncthreads();
            for (int q = tid; q < 8192; q += 512) S[q] = SPREV[(size_t)u * 8192 + q];
            __syncthreads();
            for (int cc = 0; cc < 4; ++cc) {
                const int c = dir ? 3 - cc : cc, r0 = base + 64 * c;
                {
                    const size_t ri = (size_t)r0 + i;
                    for (int jj = 0; jj < 8; ++jj) {
                        const int j = j0 + jj; const bool valid = dir ? (j >= i) : (j <= i);
                        float s = 0.f;
                        if (valid) {
                            const size_t rj = (size_t)r0 + j;
                            for (int d = 0; d < 64; ++d)
                                s += bf2f(PROJ[ri * NPROJ + PQ + h * 64 + d]) * 0.125f * __expf(BC[(ri * 2 + dir) * 256 + h * 64 + d] - BC[(rj * 2 + dir) * 256 + h * 64 + d]) * bf2f(PROJ[rj * NPROJ + PK + h * 64 + d]);
                        }
                        SC[i * 64 + j] = s;
                    }
                }
                __syncthreads();
                {
                    float o[16];
#pragma unroll
                    for (int e = 0; e < 16; ++e) o[e] = 0.f;
                    for (int j = 0; j < 64; ++j) {
                        const float sij = SC[i * 64 + j]; const size_t row = (size_t)r0 + j;
                        const v4u v0 = *(const v4u*)(PROJ + row * NPROJ + PV + h * 128 + e0), v1 = *(const v4u*)(PROJ + row * NPROJ + PV + h * 128 + e0 + 8);
#pragma unroll
                        for (int q = 0; q < 4; ++q) { o[2 * q] += sij * __uint_as_float(v0[q] << 16); o[2 * q + 1] += sij * __uint_as_float(v0[q] & 0xffff0000u);
                            o[8 + 2 * q] += sij * __uint_as_float(v1[q] << 16); o[8 + 2 * q + 1] += sij * __uint_as_float(v1[q] & 0xffff0000u); }
                    }
                    const size_t ri = (size_t)r0 + i;
                    for (int d = 0; d < 64; ++d) {
                        const float qb = bf2f(PROJ[ri * NPROJ + PQ + h * 64 + d]) * 0.125f * __expf(BC[(ri * 2 + dir) * 256 + h * 64 + d]);
#pragma unroll
                        for (int e = 0; e < 16; ++e) o[e] += qb * S[d * 128 + e0 + e];
                    }
                    float* oa = OACC + ri * 512 + h * 128 + e0;
                    if (dir == 0) {
#pragma unroll
                        for (int e = 0; e < 16; ++e) oa[e] = o[e];
                    } else {
                        float ss = 0.f;
#pragma unroll
                        for (int e = 0; e < 16; ++e) { o[e] += oa[e]; ss += o[e] * o[e]; }
                        ss += __shfl_xor(ss, 1); ss += __shfl_xor(ss, 2); ss += __shfl_xor(ss, 4);
                        const float r = 1.f / sqrtf(ss * (1.f / 128.f) + EPS);
#pragma unroll
                        for (int e = 0; e < 16; ++e) {
                            const float gv = bf2f(PROJ[ri * NPROJ + PG + h * 128 + e0 + e]);
                            MIX[ri * 1024 + h * 128 + e0 + e] = (bf16)f2bf(o[e] * r * gng[e0 + e] * silu(gv));
                        }
                    }
                }
                __syncthreads();
                {
                    const int d = i, jl = dir ? r0 : r0 + 63;
                    const float blast = BC[((size_t)jl * 2 + dir) * 256 + h * 64 + d], dec = __expf(blast);
                    float s[16];
#pragma unroll
                    for (int e = 0; e < 16; ++e) s[e] = S[d * 128 + e0 + e] * dec;
                    for (int j = 0; j < 64; ++j) {
                        const size_t row = (size_t)r0 + j;
                        const float kst = bf2f(PROJ[row * NPROJ + PK + h * 64 + d]) * __expf(blast - BC[(row * 2 + dir) * 256 + h * 64 + d]);
                        const v4u v0 = *(const v4u*)(PROJ + row * NPROJ + PV + h * 128 + e0), v1 = *(const v4u*)(PROJ + row * NPROJ + PV + h * 128 + e0 + 8);
#pragma unroll
                        for (int q = 0; q < 4; ++q) { s[2 * q] += kst * __uint_as_float(v0[q] << 16); s[2 * q + 1] += kst * __uint_as_float(v0[q] & 0xffff0000u);
                            s[8 + 2 * q] += kst * __uint_as_float(v1[q] << 16); s[8 + 2 * q + 1] += kst * __uint_as_float(v1[q] & 0xffff0000u); }
                    }
#pragma unroll
                    for (int e = 0; e < 16; ++e) S[d * 128 + e0 + e] = s[e];
                }
                __syncthreads();
            }
        }
    }
}

__device__ __forceinline__ void phase7(const Params& p, unsigned char* lds) {
    const int tid = threadIdx.x, G = gridDim.x;
    const bf16* PROJ = (const bf16*)(p.ws + WS_PROJ); bf16* MIX = (bf16*)(p.ws + WS_MIX);
    const float* w_pool = p.in[11]; const float* pscale = p.in[12];
    float* PD = (float*)lds;
    const int gi = tid >> 7, w = 2 << gi, lo = w >> 1, hi = w - 1 - lo;
    for (int unit = blockIdx.x; unit < T / 8; unit += G) {
        __syncthreads();
        for (int t = 0; t < 8; ++t) {
            const int tok = unit * 8 + t, b = tok >> 13, rr = (tok >> 6) & 127, cc = tok & 63;
            const int rs = max(rr - lo, 0), re = min(rr + hi + 1, 128), cs = max(cc - lo, 0), ce = min(cc + hi + 1, 64);
            float s = 0.f;
            for (int r2 = rs; r2 < re; ++r2)
                for (int c2 = cs; c2 < ce; ++c2) s += bf2f(PROJ[(size_t)(b * SEQ + r2 * 64 + c2) * NPROJ + PP + tid]);
            const float m = s / ((float)(re - rs) * (float)(ce - cs));
            PD[t * 512 + tid] = m - bf2f(PROJ[(size_t)tok * NPROJ + PP + tid]);
        }
        __syncthreads();
        float acc[8];
#pragma unroll
        for (int t = 0; t < 8; ++t) acc[t] = 0.f;
        const int dd = tid & 127;
        for (int c = 0; c < 128; ++c) {
            const float wv = w_pool[(size_t)gi * 16384 + c * 128 + dd];
#pragma unroll
            for (int t = 0; t < 8; ++t) acc[t] += PD[t * 512 + gi * 128 + c] * wv;
        }
        const float ps = pscale[tid];
#pragma unroll
        for (int t = 0; t < 8; ++t) MIX[(size_t)(unit * 8 + t) * 1024 + 512 + tid] = (bf16)f2bf(acc[t] * ps);
    }
}

__device__ __forceinline__ void phase8(const Params& p) {
    const int lane = threadIdx.x & 63, gw = blockIdx.x * 8 + (threadIdx.x >> 6), NGW = gridDim.x * 8;
    const bf16* MIX = (const bf16*)(p.ws + WS_MIX); const bf16* WOUT = (const bf16*)(p.ws + WS_WOUT); const float* MOD = (const float*)(p.ws + WS_MOD);
    const float* x = p.in[0];
    for (int task = gw; task < T * (D / 4); task += NGW) {
        const int row = task >> 8, n = (task & 255) * 4;
        float o[4]; wave_dot4(MIX + (size_t)row * 1024, WOUT + (size_t)n * 1024, 1024, 1024, lane, o);
        if (lane == 0) {
            const float* gt = MOD + (row >> 13) * 6144 + 2048 + n; const size_t idx = (size_t)row * D + n;
            f32x4 r; r.x = x[idx] + gt[0] * o[0]; r.y = x[idx + 1] + gt[1] * o[1]; r.z = x[idx + 2] + gt[2] * o[2]; r.w = x[idx + 3] + gt[3] * o[3];
            *(f32x4*)(p.out + idx) = r;
        }
    }
}

__device__ __forceinline__ void phase9(const Params& p, unsigned char* lds) {
    const int tid = threadIdx.x, lane = tid & 63, wave = tid >> 6, G = gridDim.x;
    const int gw = blockIdx.x * 8 + wave, NGW = G * 8;
    const float* MOD = (const float*)(p.ws + WS_MOD); const float* WR = (const float*)(p.ws + WS_WR);
    bf16* H2 = (bf16*)(p.ws + WS_H); float* RW = (float*)(p.ws + WS_RW); int* LIST = (int*)(p.ws + WS_LIST);
    unsigned* CNT = (unsigned*)(p.ws + WS_CTL) + CW_CNT;
    const float* g2 = p.in[14];
    for (int row = gw; row < T; row += NGW) {
        const float* xr = p.out + (size_t)row * D; const float* md = MOD + (row >> 13) * 6144;
        f32x4 v[4]; float ss = 0.f;
#pragma unroll
        for (int j = 0; j < 4; ++j) { v[j] = ((const f32x4*)xr)[lane + 64 * j]; ss += v[j].x * v[j].x + v[j].y * v[j].y + v[j].z * v[j].z + v[j].w * v[j].w; }
        const float r = 1.f / sqrtf(wave_sum(ss) * (1.f / D) + EPS);
#pragma unroll
        for (int j = 0; j < 4; ++j) {
            const f32x4 g = ((const f32x4*)g2)[lane + 64 * j], sh = ((const f32x4*)(md + 3072))[lane + 64 * j], sc = ((const f32x4*)(md + 4096))[lane + 64 * j];
            v[j] = v[j] * r * g * (sc + 1.f) + sh;
            unsigned long long o = (unsigned long long)pk2(v[j].x, v[j].y) | ((unsigned long long)pk2(v[j].z, v[j].w) << 32);
            ((unsigned long long*)(H2 + (size_t)row * D))[lane + 64 * j] = o;
        }
        float* lg = (float*)(lds + wave * 256);
#pragma unroll 1
        for (int q = 0; q < 36; ++q) {
            float s = 0.f;
#pragma unroll
            for (int j = 0; j < 4; ++j) { const f32x4 w = ((const f32x4*)(WR + q * 1024))[lane + 64 * j]; s += v[j].x * w.x + v[j].y * w.y + v[j].z * w.z + v[j].w * w.w; }
            s = wave_sum(s);
            if (lane == 0) lg[q] = s;
        }
        asm volatile("s_waitcnt lgkmcnt(0)" ::: "memory");
        int gi = 0; float gm = lg[0];
#pragma unroll
        for (int q = 1; q < 4; ++q) if (lg[q] > gm) { gm = lg[q]; gi = q; }
        float gs = 0.f;
#pragma unroll
        for (int q = 0; q < 4; ++q) gs += __expf(lg[q] - gm);
        const float gp = 1.f / gs;
        float le[8];
#pragma unroll
        for (int q = 0; q < 8; ++q) le[q] = lg[4 + gi * 8 + q];
        int i0 = 0; float m0 = le[0];
#pragma unroll
        for (int q = 1; q < 8; ++q) if (le[q] > m0) { m0 = le[q]; i0 = q; }
        int i1 = -1; float m1 = -3.0e38f;
#pragma unroll
        for (int q = 0; q < 8; ++q) if (q != i0 && le[q] > m1) { m1 = le[q]; i1 = q; }
        const float e1 = __expf(m1 - m0), w0 = gp / (1.f + e1), w1 = gp * e1 / (1.f + e1);
        if (lane == 0) {
            const int ea = gi * 8 + i0, eb = gi * 8 + i1;
            const unsigned pa = atomicAdd(CNT + ea, 1u); LIST[ea * T + pa] = row * 2; RW[row * 2] = w0;
            const unsigned pb = atomicAdd(CNT + eb, 1u); LIST[eb * T + pb] = row * 2 + 1; RW[row * 2 + 1] = w1;
        }
    }
}

__device__ __forceinline__ void phase10(const Params& p) {
    const int lane = threadIdx.x & 63, gw = blockIdx.x * 8 + (threadIdx.x >> 6), NGW = gridDim.x * 8;
    const bf16* H2 = (const bf16*)(p.ws + WS_H); const bf16* WE1 = (const bf16*)(p.ws + WS_WE1); bf16* HID = (bf16*)(p.ws + WS_HID);
    const int* LIST = (const int*)(p.ws + WS_LIST); const unsigned* CNT = (const unsigned*)(p.ws + WS_CTL) + CW_CNT;
    for (int task = gw; task < 2 * T * (DE / 4); task += NGW) {
        const int s = task >> 6, j = (task & 63) * 4;
        int e = 0, pre = 0, offp = 0;
        for (; e < NE - 1; ++e) { const int c = (int)CNT[e]; if (s < pre + c) break; pre += c; offp += (c + 255) & ~255; }
        const int i = s - pre, tok2 = LIST[e * T + i], row = tok2 >> 1;
        const int pn = j >> 7, jj = j & 127;
        const bf16* wb = WE1 + (size_t)e * 512 * 1024;
        float a[4], u[4];
        wave_dot4(H2 + (size_t)row * D, wb + (size_t)(256 * pn + jj) * 1024, 1024, 1024, lane, a);
        wave_dot4(H2 + (size_t)row * D, wb + (size_t)(256 * pn + 128 + jj) * 1024, 1024, 1024, lane, u);
        if (lane == 0) *(unsigned long long*)(HID + (size_t)(offp + i) * 256 + j) = (unsigned long long)pk2(silu(a[0]) * u[0], silu(a[1]) * u[1]) | ((unsigned long long)pk2(silu(a[2]) * u[2], silu(a[3]) * u[3]) << 32);
    }
}

__device__ __forceinline__ void phase11(const Params& p) {
    const int lane = threadIdx.x & 63, gw = blockIdx.x * 8 + (threadIdx.x >> 6), NGW = gridDim.x * 8;
    const bf16* HID = (const bf16*)(p.ws + WS_HID); const bf16* WE2 = (const bf16*)(p.ws + WS_WE2); bf16* Y = (bf16*)(p.ws + WS_PROJ);
    const int* LIST = (const int*)(p.ws + WS_LIST); const unsigned* CNT = (const unsigned*)(p.ws + WS_CTL) + CW_CNT; const float* RW = (const float*)(p.ws + WS_RW);
    for (int task = gw; task < 2 * T * (D / 4); task += NGW) {
        const int s = task >> 8, n = (task & 255) * 4;
        int e = 0, pre = 0, offp = 0;
        for (; e < NE - 1; ++e) { const int c = (int)CNT[e]; if (s < pre + c) break; pre += c; offp += (c + 255) & ~255; }
        const int i = s - pre, tok2 = LIST[e * T + i];
        float o[4]; wave_dot4(HID + (size_t)(offp + i) * 256, WE2 + (size_t)e * 1024 * 256 + (size_t)n * 256, 256, 256, lane, o);
        const float rw = RW[tok2];
        if (lane == 0) *(unsigned long long*)(Y + (size_t)tok2 * 1024 + n) = (unsigned long long)pk2(o[0] * rw, o[1] * rw) | ((unsigned long long)pk2(o[2] * rw, o[3] * rw) << 32);
    }
}

__device__ __forceinline__ void phase12(const Params& p) {
    const int tid = threadIdx.x, lane = tid & 63, wave = tid >> 6, G = gridDim.x;
    const int gw = blockIdx.x * 8 + wave, NGW = G * 8;
    const float* MOD = (const float*)(p.ws + WS_MOD); const bf16* Y = (const bf16*)(p.ws + WS_PROJ);
    const float* gf = p.in[19];
    for (int row = gw; row < T; row += NGW) {
        float* xr = p.out + (size_t)row * D; const float* md = MOD + (row >> 13) * 6144 + 5120;
        f32x4 v[4]; float ss = 0.f;
#pragma unroll
        for (int j = 0; j < 4; ++j) {
            v[j] = ((const f32x4*)xr)[lane + 64 * j];
            const f32x4 gt = ((const f32x4*)md)[lane + 64 * j];
            const unsigned long long y0 = ((const unsigned long long*)(Y + (size_t)(2 * row) * 1024))[lane + 64 * j], y1 = ((const unsigned long long*)(Y + (size_t)(2 * row + 1) * 1024))[lane + 64 * j];
            f32x4 ys;
            ys.x = bf2f((unsigned)(y0 & 0xffff)) + bf2f((unsigned)(y1 & 0xffff));
            ys.y = bf2f((unsigned)((y0 >> 16) & 0xffff)) + bf2f((unsigned)((y1 >> 16) & 0xffff));
            ys.z = bf2f((unsigned)((y0 >> 32) & 0xffff)) + bf2f((unsigned)((y1 >> 32) & 0xffff));
            ys.w = bf2f((unsigned)((y0 >> 48) & 0xffff)) + bf2f((unsigned)((y1 >> 48) & 0xffff));
            v[j] = v[j] + gt * ys;
            ss += v[j].x * v[j].x + v[j].y * v[j].y + v[j].z * v[j].z + v[j].w * v[j].w;
        }
        const float r = 1.f / sqrtf(wave_sum(ss) * (1.f / D) + EPS);
#pragma unroll
        for (int j = 0; j < 4; ++j) { const f32x4 g = ((const f32x4*)gf)[lane + 64 * j]; ((f32x4*)xr)[lane + 64 * j] = v[j] * r * g; }
    }
}

template <int PH> __global__ void __launch_bounds__(512, 2) mk_phase(Params p) {
    extern __shared__ __attribute__((aligned(16))) unsigned char lds[];
    if constexpr (PH == 0) phase0(p, lds);
    if constexpr (PH == 1) phase1(p);
    if constexpr (PH == 2) phase2(p);
    if constexpr (PH == 3) phase3(p);
    if constexpr (PH == 4) phase4(p);
    if constexpr (PH == 5) phase5(p);
    if constexpr (PH == 6) phase6(p, lds);
    if constexpr (PH == 7) phase7(p, lds);
    if constexpr (PH == 8) phase8(p);
    if constexpr (PH == 9) phase9(p, lds);
    if constexpr (PH == 10) phase10(p);
    if constexpr (PH == 11) phase11(p);
    if constexpr (PH == 12) phase12(p);
}
template <int PH> static void launch_phase(int grid, const Params& a, hipStream_t stream) {
    static bool attr = false;
    if (!attr) { (void)hipFuncSetAttribute((const void*)mk_phase<PH>, hipFuncAttributeMaxDynamicSharedMemorySize, LDS_BYTES); attr = true; }
    hipLaunchKernelGGL(mk_phase<PH>, dim3(grid), dim3(512), LDS_BYTES, stream, a);
}

extern "C" void kernel_launch(void* const* d_in, const int* in_sizes, int n_in, void* d_out, int out_size, void* d_ws, size_t ws_size, hipStream_t stream) {
    static int grid = 0;
    if (grid == 0) {
        if (n_in != 20 || in_sizes[0] != T * D || in_sizes[7] != D * IN_COLS || out_size != T * D || ws_size < WS_END) {
            fprintf(stderr, "kernel_launch: unexpected shapes (n_in %d in0 %d in7 %d out %d ws %zu)\n", n_in, n_in > 0 ? in_sizes[0] : -1, n_in > 7 ? in_sizes[7] : -1, out_size, ws_size); grid = -1; return; }
        int dev = 0, cus = 0;
        if (hipGetDevice(&dev) != hipSuccess || hipDeviceGetAttribute(&cus, hipDeviceAttributeMultiprocessorCount, dev) != hipSuccess) { grid = -1; return; }
        grid = cus;
    }
    if (grid < 0) return;
    hipMemsetAsync((char*)d_ws + WS_CTL, 0, CTL_BYTES, stream);
    Params a{};
    for (int i = 0; i < 20; ++i) a.in[i] = (const float*)d_in[i];
    a.out = (float*)d_out; a.ws = (unsigned char*)d_ws;
    launch_phase<0>(grid, a, stream); launch_phase<1>(grid, a, stream); launch_phase<2>(grid, a, stream); launch_phase<3>(grid, a, stream);
    launch_phase<4>(grid, a, stream); launch_phase<5>(grid, a, stream); launch_phase<6>(grid, a, stream); launch_phase<7>(grid, a, stream);
    launch_phase<8>(grid, a, stream); launch_phase<9>(grid, a, stream); launch_phase<10>(grid, a, stream); launch_phase<11>(grid, a, stream);
    launch_phase<12>(grid, a, stream);
}
```

```cpp
#include <hip/hip_runtime.h>
#include <cstdint>
#include <cstdio>

typedef unsigned short bf16;
typedef unsigned v4u __attribute__((ext_vector_type(4)));
typedef float f32x4 __attribute__((ext_vector_type(4)));

constexpr int D = 1024, NB = 4, SEQ = 8192, T = NB * SEQ, CTXL = 256, TC = NB * CTXL, TT = T + TC;
constexpr int IN_COLS = 2080, OFF_A = 1536, OFF_P = 1568;
constexpr int NPROJ = 2048;
constexpr int PQ = 0, PK = 256, PV = 512, PG = 1024, PP = 1536;
constexpr int NSI = 36;
constexpr int NE = 32, DE = 256;
constexpr float EPS = 1e-6f;

constexpr size_t MiB = 1u << 20;
constexpr size_t WS_CTL = 0, CTL_BYTES = 65536;
constexpr size_t WS_MOD = 1 * MiB;
constexpr size_t WS_WIN = 2 * MiB;
constexpr size_t WS_WA = 6 * MiB;
constexpr size_t WS_WOUT = 7 * MiB;
constexpr size_t WS_WPOOL = 9 * MiB;
constexpr size_t WS_WR = 10 * MiB;
constexpr size_t WS_DEC = 11 * MiB;
constexpr size_t WS_RW = 12 * MiB;
constexpr size_t WS_LIST = 502 * MiB;
constexpr size_t WS_WE1 = 18 * MiB;
constexpr size_t WS_WE2 = 50 * MiB;
constexpr size_t WS_H = 66 * MiB;
constexpr size_t WS_ALOW = 132 * MiB;
constexpr size_t WS_PROJ = 138 * MiB;
constexpr size_t WS_DST = 270 * MiB;
constexpr size_t WS_XMID = 270 * MiB;
constexpr size_t WS_OUTP = 438 * MiB;
constexpr size_t WS_SPREV = 306 * MiB;
constexpr size_t WS_MIX = 338 * MiB;
constexpr size_t WS_HID = 402 * MiB;
constexpr size_t WS_BC = 436 * MiB;
constexpr size_t WS_END = 510 * MiB;
constexpr int CW_CNT = 1024;
constexpr int CW_BAR = 4096;

constexpr int LDS_BYTES = 147456;
constexpr int MISC_OFF = LDS_BYTES - 1024;
constexpr int NPHASE = 12;

struct Params { const float* in[20]; float* out; unsigned char* ws; int ph_lo, ph_hi; };

__device__ __forceinline__ float bf2f(unsigned b) { return __uint_as_float(b << 16); }
typedef float f32x2_t __attribute__((ext_vector_type(2)));
typedef __bf16 bf16x2_t __attribute__((ext_vector_type(2)));
__device__ __forceinline__ unsigned pk2(float lo, float hi) { const f32x2_t v = {lo, hi}; return __builtin_bit_cast(unsigned, __builtin_convertvector(v, bf16x2_t)); }
__device__ __forceinline__ unsigned f2bf(float f) { return pk2(f, 0.f) & 0xffffu; }
__device__ __forceinline__ float frcp(float x) { return __builtin_amdgcn_rcpf(x); }
__device__ __forceinline__ float frsq(float x) { return __builtin_amdgcn_rsqf(x); }
template <int CTRL> __device__ __forceinline__ float dppf(float v) { return __int_as_float(__builtin_amdgcn_update_dpp(0, __float_as_int(v), CTRL, 0xf, 0xf, false)); }
__device__ __forceinline__ float wave_sum(float v) {
    v += dppf<0xB1>(v);
    v += dppf<0x4E>(v);
    v += dppf<0x141>(v);
    v += dppf<0x140>(v);
    const int iv = __float_as_int(v);
    return (__int_as_float(__builtin_amdgcn_readlane(iv, 0)) + __int_as_float(__builtin_amdgcn_readlane(iv, 16))) + (__int_as_float(__builtin_amdgcn_readlane(iv, 32)) + __int_as_float(__builtin_amdgcn_readlane(iv, 48)));
}
__device__ __forceinline__ int ltid() { int t = threadIdx.x; asm volatile("" : "+v"(t)); return t; }
__device__ __forceinline__ float silu(float s) { return s * frcp(1.f + __expf(-s)); }
__device__ __forceinline__ float dot8(v4u a, v4u b) {
    float s = 0.f;
#pragma unroll
    for (int i = 0; i < 4; ++i) {
        s += __uint_as_float(a[i] << 16) * __uint_as_float(b[i] << 16);
        s += __uint_as_float(a[i] & 0xffff0000u) * __uint_as_float(b[i] & 0xffff0000u);
    }
    return s;
}
__device__ __forceinline__ float dot_bf16(const bf16* a, const bf16* b, int K) {
    const v4u* a4 = (const v4u*)a; const v4u* b4 = (const v4u*)b;
    float acc = 0.f;
    for (int k = 0; k < K / 8; ++k) acc += dot8(a4[k], b4[k]);
    return acc;
}


__device__ __forceinline__ void wave_dot4(const bf16* a, const bf16* b, size_t ldb, int K, int lane, float (&out)[4]) {
    float acc[4] = {0.f, 0.f, 0.f, 0.f};
    for (int c = lane; c < K / 8; c += 64) {
        const v4u av = ((const v4u*)a)[c];
#pragma unroll
        for (int q = 0; q < 4; ++q) acc[q] += dot8(av, ((const v4u*)(b + q * ldb))[c]);
    }
#pragma unroll
    for (int q = 0; q < 4; ++q) out[q] = wave_sum(acc[q]);
}

struct TDesc { const float* W; int ldw; bf16* WT; int ldt; };
__device__ __forceinline__ void titem_load(const TDesc& d, float (&tv)[32], int lane) {
#pragma unroll
    for (int i = 0; i < 32; ++i) tv[i] = d.W[(size_t)(2 * i + (lane >> 5)) * d.ldw + (lane & 31)];
}
__device__ __forceinline__ void titem_store(const TDesc& d, const float (&tv)[32], float* scr, int lane) {
#pragma unroll
    for (int i = 0; i < 32; ++i) scr[(2 * i + (lane >> 5)) * 33 + (lane & 31)] = tv[i];
    asm volatile("s_waitcnt lgkmcnt(0)" ::: "memory");
    const int c = lane & 7;
#pragma unroll
    for (int j = 0; j < 4; ++j) { const int n = (lane >> 3) + 8 * j; const float* s = scr + (8 * c) * 33 + n;
        v4u o; o.x = pk2(s[0 * 33], s[1 * 33]); o.y = pk2(s[2 * 33], s[3 * 33]); o.z = pk2(s[4 * 33], s[5 * 33]); o.w = pk2(s[6 * 33], s[7 * 33]);
        *(v4u*)(d.WT + (size_t)n * d.ldt + 8 * c) = o; }
    asm volatile("s_waitcnt lgkmcnt(0)" ::: "memory");
}
__device__ __forceinline__ TDesc tdesc(const float* W, int ldw, int nblk, bf16* WT, int ldt, int item) {
    const int kb = item / nblk, nb = item - kb * nblk, k0 = 64 * kb, n0 = 32 * nb;
    return TDesc{W + (size_t)k0 * ldw + n0, ldw, WT + (size_t)n0 * ldt + k0, ldt};
}


namespace pg8 {
#define PG8_LAS __attribute__((address_space(3)))
typedef short bf16x8 __attribute__((ext_vector_type(8)));
typedef unsigned u32x4 __attribute__((ext_vector_type(4)));
constexpr int BM = 256, BK = 64, HALF = 128, HTB = HALF * BK * 2, STAGE_BYTES = 8 * HTB, NXCD = 8, WGM = 8;
__device__ __forceinline__ int lds_byte(int r, int c) { const int st = (r >> 4) * 2 + (c >> 5), rr = r & 15, cc = c & 31, ob = rr * 64 + cc * 2; return st * 1024 + (ob ^ (((ob >> 9) & 1) << 5)); }
__device__ __forceinline__ void stage_rc(int b, int& R, int& C) { const int st = b / 1024, sb = b % 1024, swz = sb ^ (((sb >> 9) & 1) << 5); R = (st >> 1) * 16 + swz / 64; C = (st & 1) * 32 + (swz % 64) / 2; }
__device__ __forceinline__ int perm32(int rho) { const int n = rho >> 4, i = rho & 15; return 8 * (i >> 2) + 4 * n + (i & 3); }
__device__ __forceinline__ unsigned cvt_pk_bf16(float lo, float hi) { return pk2(lo, hi); }

struct Unit { int pm, pn, e, ti; };

struct SchedDense {
    int nM, nN, nwg, G, c, K; const bf16* Bt;
    __device__ __forceinline__ void init(int M, int N, int K_, const bf16* Bt_, int G_, int c_) { nM = M / BM; nN = N / BM; nwg = nM * nN; G = G_; c = c_; K = K_; Bt = Bt_; }
    __device__ __forceinline__ bool next(int i, Unit& u) const {
        const long L = (long)i * G + c; if (L >= nwg) return false;
        int wgid = (int)L; { const int q = nwg / NXCD, r = nwg % NXCD, xcd = wgid % NXCD, off = wgid / NXCD; wgid = (xcd < r ? xcd * (q + 1) : r * (q + 1) + (xcd - r) * q) + off; }
        const int nig = WGM * nN, gid = wgid / nig, fm = gid * WGM, gsz = (nM - fm) < WGM ? (nM - fm) : WGM;
        u.pm = fm + ((wgid % nig) % gsz); u.pn = (wgid % nig) / gsz; u.e = 0; u.ti = 0; return true;
    }
    __device__ __forceinline__ unsigned arow(const Unit& u, int r) const { return (unsigned)(u.pm * BM + r) * (unsigned)(K * 2); }
    __device__ __forceinline__ const char* bbase(const Unit& u) const { return (const char*)Bt + (size_t)u.pn * BM * K * 2; }
};

template <class Epi, class Sched, bool ALIGN_EPI>
__device__ __forceinline__ void gemm_phase(PG8_LAS unsigned char* lds, const bf16* Aptr, const int K, const Sched& S, const Epi& E) {
    const int tid = ltid(), wid = __builtin_amdgcn_readfirstlane(tid >> 6), lane = tid & 63, wr = wid >> 2, wc = wid & 3, fr = lane & 15, fq = lane >> 4;
    const int nt = K / BK;
    const char* Abase = (const char*)Aptr;
    int sR[2]; unsigned sC[2]; unsigned voffB[2];
#pragma unroll
    for (int i = 0; i < 2; ++i) { int R, C; stage_rc(tid * 16 + i * 8192, R, C); const int Rb = Epi::PERM ? ((R & ~31) + perm32(R & 31)) : R;
        sR[i] = R; sC[i] = (unsigned)C * 2u; voffB[i] = (unsigned)(Rb * K + C) * 2u; }
    const unsigned kstep = (unsigned)(BK * 2);
    const size_t hstep = (size_t)HALF * K * 2;
    const unsigned ldsw = (unsigned)wid * 1024u;
    const int aoff = lds_byte(wr * 64 + fr, fq * 8), boff = lds_byte(wc * 32 + fr, fq * 8);
#define PG8_SA(b, h) (((b) * 2 + (h)) * HTB)
#define PG8_SB(b, h) ((4 + (b) * 2 + (h)) * HTB)
#define PG8_STAGE(bufoff, gbase, voff) do { _Pragma("unroll") for (int _i = 0; _i < 2; ++_i) \
        __builtin_amdgcn_global_load_lds((const unsigned*)((const char*)(gbase) + (voff)[_i]), (PG8_LAS unsigned*)(lds + (bufoff) + ldsw + _i * 8192), 16, 0, 0); } while (0)
#define PG8_STAGE_A(bufoff, AO, h, kb) do { _Pragma("unroll") for (int _i = 0; _i < 2; ++_i) \
        __builtin_amdgcn_global_load_lds((const unsigned*)(Abase + (AO)[h][_i] + (kb)), (PG8_LAS unsigned*)(lds + (bufoff) + ldsw + _i * 8192), 16, 0, 0); } while (0)
#define PG8_LDA(dst, b, h) do { _Pragma("unroll") for (int m = 0; m < 4; ++m) _Pragma("unroll") for (int k = 0; k < 2; ++k) dst[m][k] = *(const PG8_LAS bf16x8*)(lds + PG8_SA(b, h) + aoff + m * 2048 + k * 1024); } while (0)
#define PG8_LDB(dst, b, h) do { _Pragma("unroll") for (int n = 0; n < 2; ++n) _Pragma("unroll") for (int k = 0; k < 2; ++k) dst[n][k] = *(const PG8_LAS bf16x8*)(lds + PG8_SB(b, h) + boff + n * 2048 + k * 1024); } while (0)
#define PG8_MMA(ai, bj, At, Bt) do { __builtin_amdgcn_s_setprio(1); _Pragma("unroll") for (int m = 0; m < 4; ++m) _Pragma("unroll") for (int n = 0; n < 2; ++n) _Pragma("unroll") for (int k = 0; k < 2; ++k) \
        acc[ai][bj][m][n] = __builtin_amdgcn_mfma_f32_16x16x32_bf16(Bt[n][k], At[m][k], acc[ai][bj][m][n], 0, 0, 0); __builtin_amdgcn_s_setprio(0); } while (0)
#define PG8_WAIT_V(n) asm volatile("s_waitcnt vmcnt(" #n ")" ::: "memory")
#define PG8_WAIT_L(n) asm volatile("s_waitcnt lgkmcnt(" #n ")" ::: "memory")
#define PG8_BAR __builtin_amdgcn_s_barrier()
#define PG8_SCHED __builtin_amdgcn_sched_barrier(0)
#define PG8_AOFFS(dst, u) do { _Pragma("unroll") for (int _h = 0; _h < 2; ++_h) _Pragma("unroll") for (int _i = 0; _i < 2; ++_i) dst[_h][_i] = S.arow(u, _h * HALF + sR[_i]) + sC[_i]; } while (0)
    Unit cur, nxt; int ui = 0;
    if (!S.next(0, cur)) return;
    E.prefetch(cur, wr, fr);
    f32x4 acc[2][2][4][2];
#pragma unroll
    for (int a = 0; a < 2; ++a)
#pragma unroll
        for (int b = 0; b < 2; ++b)
#pragma unroll
            for (int m = 0; m < 4; ++m)
#pragma unroll
                for (int n = 0; n < 2; ++n) acc[a][b][m][n] = (f32x4){0.f, 0.f, 0.f, 0.f};
    bf16x8 At[4][2], B0[2][2], B1[2][2];
    unsigned cAo[2][2], nAo[2][2];
    PG8_AOFFS(cAo, cur);
    const char* cB = S.bbase(cur);
    PG8_STAGE(PG8_SB(0, 0), cB, voffB); PG8_STAGE(PG8_SB(0, 1), cB + hstep, voffB); PG8_STAGE_A(PG8_SA(0, 0), cAo, 0, 0u); PG8_STAGE_A(PG8_SA(0, 1), cAo, 1, 0u);
    if (wr == 1) PG8_BAR;
    PG8_WAIT_V(2); PG8_BAR;
    PG8_STAGE(PG8_SB(1, 0), cB + kstep, voffB); PG8_STAGE_A(PG8_SA(1, 0), cAo, 0, kstep); PG8_STAGE(PG8_SB(1, 1), cB + hstep + kstep, voffB);
    PG8_WAIT_V(6); PG8_BAR;
    for (;;) {
        const bool has_next = S.next(ui + 1, nxt);
        const char* nB = cB;
        if (has_next) { PG8_AOFFS(nAo, nxt); nB = S.bbase(nxt); }
        else {
#pragma unroll
            for (int _h = 0; _h < 2; ++_h)
#pragma unroll
                for (int _i = 0; _i < 2; ++_i) nAo[_h][_i] = cAo[_h][_i];
        }
#pragma unroll 1
        for (int t = 0; t < nt; t += 2) {
            const bool last = (t == nt - 2);
            const unsigned k1 = (unsigned)(t + 1) * kstep, k2 = last ? 0u : (unsigned)(t + 2) * kstep, k3 = k2 + kstep;
            unsigned xAo[2][2];
#pragma unroll
            for (int _h = 0; _h < 2; ++_h)
#pragma unroll
                for (int _i = 0; _i < 2; ++_i) xAo[_h][_i] = last ? nAo[_h][_i] : cAo[_h][_i];
            const char* b2 = last ? nB : cB + (size_t)(t + 2) * kstep; const char* b3 = b2 + kstep;
            PG8_LDB(B0, 0, 0); PG8_LDB(B1, 0, 1); PG8_SCHED; PG8_LDA(At, 0, 0); PG8_STAGE_A(PG8_SA(1, 1), cAo, 1, k1);
            PG8_WAIT_V(8); PG8_WAIT_L(0); PG8_BAR; PG8_MMA(0, 0, At, B0); PG8_MMA(0, 1, At, B1); PG8_BAR; PG8_SCHED;
            PG8_LDA(At, 0, 1); PG8_STAGE(PG8_SB(0, 0), b2, voffB); PG8_STAGE(PG8_SB(0, 1), b2 + hstep, voffB); PG8_STAGE_A(PG8_SA(0, 0), xAo, 0, k2);
            PG8_WAIT_V(8); PG8_WAIT_L(0); PG8_BAR; PG8_MMA(1, 0, At, B0); PG8_MMA(1, 1, At, B1); PG8_BAR; PG8_SCHED;
            PG8_LDB(B0, 1, 0); PG8_LDB(B1, 1, 1); PG8_SCHED; PG8_LDA(At, 1, 0); PG8_STAGE_A(PG8_SA(0, 1), xAo, 1, k2);
            PG8_WAIT_V(8); PG8_WAIT_L(0); PG8_BAR; PG8_MMA(0, 0, At, B0); PG8_MMA(0, 1, At, B1); PG8_BAR; PG8_SCHED;
            PG8_LDA(At, 1, 1); PG8_STAGE(PG8_SB(1, 0), b3, voffB); PG8_STAGE(PG8_SB(1, 1), b3 + hstep, voffB); PG8_STAGE_A(PG8_SA(1, 0), xAo, 0, k3);
            PG8_WAIT_V(8); PG8_WAIT_L(0); PG8_BAR; PG8_MMA(1, 0, At, B0); PG8_MMA(1, 1, At, B1); PG8_BAR; PG8_SCHED;
        }
        if constexpr (ALIGN_EPI) { if (wr == 0) PG8_BAR; }
        E(acc, cur, wr, wc, fr, fq);
        if (!has_next) break;
        E.prefetch(nxt, wr, fr);
#pragma unroll
        for (int a = 0; a < 2; ++a)
#pragma unroll
            for (int b = 0; b < 2; ++b)
#pragma unroll
                for (int m = 0; m < 4; ++m)
#pragma unroll
                    for (int n = 0; n < 2; ++n) acc[a][b][m][n] = (f32x4){0.f, 0.f, 0.f, 0.f};
        cur = nxt; cB = nB; ++ui;
#pragma unroll
        for (int _h = 0; _h < 2; ++_h)
#pragma unroll
            for (int _i = 0; _i < 2; ++_i) cAo[_h][_i] = nAo[_h][_i];
        if constexpr (ALIGN_EPI) { if (wr == 1) PG8_BAR; }
    }
    PG8_WAIT_V(0);
    if constexpr (!ALIGN_EPI) { if (wr == 0) PG8_BAR; }
    PG8_BAR;
#undef PG8_SA
#undef PG8_SB
#undef PG8_STAGE
#undef PG8_STAGE_A
#undef PG8_LDA
#undef PG8_LDB
#undef PG8_MMA
#undef PG8_WAIT_V
#undef PG8_WAIT_L
#undef PG8_BAR
#undef PG8_SCHED
#undef PG8_AOFFS
}

struct EpiProj {
    static constexpr bool PERM = true;
    __device__ __forceinline__ void prefetch(const Unit&, int, int) const {}
    __device__ __forceinline__ void rotate() const {}
    bf16* O; int ldc;
    __device__ __forceinline__ void operator()(const f32x4 (&acc)[2][2][4][2], const Unit& u, int wr, int wc, int fr, int fq) const {
        const int row0 = u.pm * BM + wr * 64 + fr, col0 = u.pn * BM + wc * 32 + 8 * fq;
#pragma unroll
        for (int ai = 0; ai < 2; ++ai)
#pragma unroll
            for (int m = 0; m < 4; ++m) { bf16* rowp = O + (size_t)(row0 + ai * HALF + m * 16) * ldc + col0;
#pragma unroll
                for (int bj = 0; bj < 2; ++bj) { const f32x4 v0 = acc[ai][bj][m][0], v1 = acc[ai][bj][m][1];
                    u32x4 w; w.x = cvt_pk_bf16(v0[0], v0[1]); w.y = cvt_pk_bf16(v0[2], v0[3]); w.z = cvt_pk_bf16(v1[0], v1[1]); w.w = cvt_pk_bf16(v1[2], v1[3]);
                    *(u32x4*)(rowp + bj * HALF) = w; } }
    }
};
struct EpiOut {
    static constexpr bool PERM = true;
    __device__ __forceinline__ void prefetch(const Unit&, int, int) const {}
    __device__ __forceinline__ void rotate() const {}
    bf16* xm; const float* MOD;
    __device__ __forceinline__ void operator()(const f32x4 (&acc)[2][2][4][2], const Unit& u, int wr, int wc, int fr, int fq) const {
        const int row0 = u.pm * BM + wr * 64 + fr, col0 = u.pn * BM + wc * 32 + 8 * fq;
        const float* gt = MOD + ((u.pm * BM) >> 13) * 6144 + 2048 + col0;
        f32x4 gv[2][2];
#pragma unroll
        for (int bj = 0; bj < 2; ++bj)
#pragma unroll
            for (int n = 0; n < 2; ++n) gv[bj][n] = *(const f32x4*)(gt + bj * HALF + n * 4);
#pragma unroll
        for (int ai = 0; ai < 2; ++ai)
#pragma unroll
            for (int m = 0; m < 4; ++m) { const size_t off = (size_t)(row0 + ai * HALF + m * 16) * 1024 + col0;
#pragma unroll
                for (int bj = 0; bj < 2; ++bj) {
                    const f32x4 v0 = gv[bj][0] * acc[ai][bj][m][0], v1 = gv[bj][1] * acc[ai][bj][m][1];
                    u32x4 w; w.x = cvt_pk_bf16(v0[0], v0[1]); w.y = cvt_pk_bf16(v0[2], v0[3]); w.z = cvt_pk_bf16(v1[0], v1[1]); w.w = cvt_pk_bf16(v1[2], v1[3]);
                    *(u32x4*)(xm + off + bj * HALF) = w; } }
    }
};

struct SchedMoE1 {
    const PG8_LAS int* tp; const PG8_LAS int* cnt; const int* LIST; const bf16* W; int G, c;
    __device__ __forceinline__ bool next(int i, Unit& u) const {
        const int NU = 2 * tp[32]; int L;
        if (G % 8 == 0) { const int per = (NU + 7) >> 3, x = c & 7; L = x * per + (c >> 3) + (G >> 3) * i; if (L >= min((x + 1) * per, NU)) return false; }
        else { L = i * G + c; if (L >= NU) return false; }
        const int rt = L >> 1; const int e = ((const PG8_LAS unsigned char*)(tp + 96))[rt];
        u.pm = rt; u.pn = L & 1; u.e = e; u.ti = rt - tp[e]; return true;
    }
    __device__ __forceinline__ unsigned arow(const Unit& u, int r) const { const int i = u.ti * 256 + r, ii = i < cnt[u.e] ? i : 0; return (unsigned)(LIST[2 * (u.e * T + ii)] >> 1) * 2048u; }
    __device__ __forceinline__ const char* bbase(const Unit& u) const { return (const char*)(W + ((size_t)u.e * 512 + u.pn * 256) * 1024); }
};
struct EpiSwiglu {
    static constexpr bool PERM = true;
    __device__ __forceinline__ void prefetch(const Unit&, int, int) const {}
    __device__ __forceinline__ void rotate() const {}
    bf16* HID;
    __device__ __forceinline__ void operator()(const f32x4 (&acc)[2][2][4][2], const Unit& u, int wr, int wc, int fr, int fq) const {
#pragma unroll
        for (int ai = 0; ai < 2; ++ai)
#pragma unroll
            for (int m = 0; m < 4; ++m) {
                float h[8];
#pragma unroll
                for (int n = 0; n < 2; ++n)
#pragma unroll
                    for (int q = 0; q < 4; ++q) { const float a = acc[ai][0][m][n][q], uu = acc[ai][1][m][n][q]; h[n * 4 + q] = a * frcp(1.f + __expf(-a)) * uu; }
                u32x4 w; w.x = cvt_pk_bf16(h[0], h[1]); w.y = cvt_pk_bf16(h[2], h[3]); w.z = cvt_pk_bf16(h[4], h[5]); w.w = cvt_pk_bf16(h[6], h[7]);
                *(u32x4*)(HID + (size_t)(u.pm * BM + ai * HALF + wr * 64 + m * 16 + fr) * 256 + u.pn * 128 + wc * 32 + 8 * fq) = w;
            }
    }
};
struct SchedMoE2 {
    const PG8_LAS int* tp; const bf16* W; int G, c;
    __device__ __forceinline__ bool next(int i, Unit& u) const {
        const int NU = 4 * tp[32]; int L;
        if (G % 8 == 0) { const int per = (NU + 7) >> 3, x = c & 7; L = x * per + (c >> 3) + (G >> 3) * i; if (L >= min((x + 1) * per, NU)) return false; }
        else { L = i * G + c; if (L >= NU) return false; }
        const int rt = L >> 2; const int e = ((const PG8_LAS unsigned char*)(tp + 96))[rt];
        u.pm = rt; u.pn = L & 3; u.e = e; u.ti = rt - tp[e]; return true;
    }
    __device__ __forceinline__ unsigned arow(const Unit& u, int r) const { return (unsigned)(u.pm * BM + r) * 512u; }
    __device__ __forceinline__ const char* bbase(const Unit& u) const { return (const char*)(W + ((size_t)u.e * 1024 + u.pn * 256) * 256); }
};
struct EpiScatter {
    static constexpr bool PERM = true;
    bf16* Y; const PG8_LAS int* cnt; const int* LIST;
    typedef int i32x2 __attribute__((ext_vector_type(2)));
    mutable i32x2 cu[8];
    __device__ __forceinline__ void prefetch(const Unit& u, int wr, int fr) const {
        const int ce = cnt[u.e];
#pragma unroll
        for (int q = 0; q < 8; ++q) { const int i = u.ti * 256 + (q >> 2) * HALF + wr * 64 + (q & 3) * 16 + fr;
            cu[q] = *(const i32x2*)(LIST + 2 * (size_t)(u.e * T + (i < ce ? i : 0))); if (i >= ce) cu[q].x = -1; }
    }
    __device__ __forceinline__ void rotate() const {}
    __device__ __forceinline__ void operator()(const f32x4 (&acc)[2][2][4][2], const Unit& u, int wr, int wc, int fr, int fq) const {
#pragma unroll
        for (int ai = 0; ai < 2; ++ai)
#pragma unroll
            for (int m = 0; m < 4; ++m) {
                const int tok2 = cu[ai * 4 + m].x; const float r = __int_as_float(cu[ai * 4 + m].y);
                if (tok2 >= 0) {
                    bf16* rowp = Y + (size_t)tok2 * 1024 + u.pn * BM + wc * 32 + 8 * fq;
#pragma unroll
                    for (int bj = 0; bj < 2; ++bj) { const f32x4 v0 = acc[ai][bj][m][0] * r, v1 = acc[ai][bj][m][1] * r;
                        u32x4 w; w.x = cvt_pk_bf16(v0[0], v0[1]); w.y = cvt_pk_bf16(v0[2], v0[3]); w.z = cvt_pk_bf16(v1[0], v1[1]); w.w = cvt_pk_bf16(v1[2], v1[3]);
                        *(u32x4*)(rowp + bj * HALF) = w; }
                }
            }
    }
};
}


namespace gla {
typedef short bf16x8 __attribute__((ext_vector_type(8)));
typedef float f32x16 __attribute__((ext_vector_type(16)));
typedef __attribute__((address_space(3))) unsigned char lds_t;
typedef __attribute__((address_space(3))) float lf;
typedef __attribute__((address_space(3))) unsigned short lus;
typedef __attribute__((address_space(3))) v4u lv4;
constexpr int LS = 144;
constexpr int O_VT = 0;
constexpr int O_QB = 18432;
constexpr int O_KB = 27648;
constexpr int O_KT = 36864;
constexpr int O_P = 46080;
constexpr int O_OUT = O_QB, OUT_LD = 132;
constexpr int O_ST = 55296;
constexpr int O_DEC = 73728;
constexpr int O_CS = 74240, O_CSB = 76288;
constexpr int O_ALS = 78336;
constexpr int O_RK = 86528, O_RQ = 95744;
constexpr int O_RV = 104960, RVS = 272;
static_assert(64 * OUT_LD * 4 <= 4 * 9216 && O_RV + 64 * RVS <= MISC_OFF, "gla LDS map");

__device__ __forceinline__ unsigned bfr(float f) { return f2bf(f); }

__device__ __forceinline__ f32x16 mm_tile(const lds_t* A, const lds_t* B, f32x16 acc, int lane) {
    const int off = (lane & 31) * LS + (lane >> 5) * 16;
#pragma unroll
    for (int s = 0; s < 4; ++s) {
        const bf16x8 a = *(const __attribute__((address_space(3))) bf16x8*)(A + off + s * 32);
        const bf16x8 b = *(const __attribute__((address_space(3))) bf16x8*)(B + off + s * 32);
        acc = __builtin_amdgcn_mfma_f32_32x32x16_bf16(a, b, acc, 0, 0, 0);
    }
    return acc;
}

struct Raw { v4u k, q, v0, v1; f32x4 al; };
template <bool NEEDQ, bool BOTH>
__device__ __forceinline__ void raw_load(Raw& R, const bf16* PROJ, const float* ALOW, int r0, int h, int dir, int tid) {
    const size_t row = (size_t)(r0 + (tid >> 3));
    R.k = *(const v4u*)(PROJ + row * NPROJ + PK + h * 64 + (tid & 7) * 8);
    if (NEEDQ) R.q = *(const v4u*)(PROJ + row * NPROJ + PQ + h * 64 + (tid & 7) * 8);
    R.v0 = *(const v4u*)(PROJ + row * NPROJ + PV + h * 128 + (tid & 7) * 16);
    R.v1 = *(const v4u*)(PROJ + row * NPROJ + PV + h * 128 + (tid & 7) * 16 + 8);
    if (BOTH) R.al = *(const f32x4*)(ALOW + row * 32 + (tid & 7) * 4);
    else if (tid < 256) R.al = *(const f32x4*)(ALOW + (size_t)(r0 + (tid >> 2)) * 32 + dir * 16 + (tid & 3) * 4);
}
template <bool NEEDQ, bool BOTH>
__device__ __forceinline__ void raw_stage(lds_t* L, const Raw& R, int tid) {
    const int j = tid >> 3, c = tid & 7;
    *(lv4*)(L + O_RK + j * LS + c * 16) = R.k;
    if (NEEDQ) *(lv4*)(L + O_RQ + j * LS + c * 16) = R.q;
    *(lv4*)(L + O_RV + j * RVS + c * 32) = R.v0;
    *(lv4*)(L + O_RV + j * RVS + c * 32 + 16) = R.v1;
    if (BOTH) *(__attribute__((address_space(3))) f32x4*)((lf*)(L + O_ALS) + j * 32 + c * 4) = R.al;
    else if (tid < 256) *(__attribute__((address_space(3))) f32x4*)((lf*)(L + O_ALS) + tid * 4) = R.al;
}
__device__ __forceinline__ void v_transpose(lds_t* L, int tid) {
    const int e = tid & 127, tg = tid >> 7;
    unsigned vr[16];
#pragma unroll
    for (int jj = 0; jj < 16; ++jj) vr[jj] = *(const lus*)(L + O_RV + (16 * tg + jj) * RVS + e * 2);
    v4u w0, w1;
    w0.x = vr[0] | (vr[1] << 16); w0.y = vr[2] | (vr[3] << 16); w0.z = vr[4] | (vr[5] << 16); w0.w = vr[6] | (vr[7] << 16);
    w1.x = vr[8] | (vr[9] << 16); w1.y = vr[10] | (vr[11] << 16); w1.z = vr[12] | (vr[13] << 16); w1.w = vr[14] | (vr[15] << 16);
    *(lv4*)(L + O_VT + e * LS + tg * 32) = w0;
    *(lv4*)(L + O_VT + e * LS + tg * 32 + 16) = w1;
}
template <int ALD>
__device__ __forceinline__ float la_cum(const lds_t* L, int to, int dir, int aoff, const float (&wd)[16], float bd, float (&bl)[8]) {
    const lf* ALS = (const lf*)(L + O_ALS);
    float cum = 0.f;
#pragma unroll
    for (int s2 = 0; s2 < 8; ++s2) {
        const int jj = dir ? 7 - s2 : s2, j = 8 * to + jj;
        float z = bd;
#pragma unroll
        for (int r4 = 0; r4 < 4; ++r4) { const f32x4 a = *(const __attribute__((address_space(3))) f32x4*)(ALS + j * ALD + aoff + r4 * 4);
            z += a.x * wd[r4 * 4] + a.y * wd[r4 * 4 + 1] + a.z * wd[r4 * 4 + 2] + a.w * wd[r4 * 4 + 3]; }
        const float la = (fminf(z, 0.f) - __logf(1.f + __expf(-fabsf(z)))) * (1.f / 16.f);
        cum += la; bl[jj] = cum;
    }
    return cum;
}
__device__ __forceinline__ void cs_combine(const lf* CS, int d, int to, int dir, float& offs, float& tot) {
    offs = 0.f; tot = 0.f;
#pragma unroll
    for (int o = 0; o < 8; ++o) { const float c = CS[o * 64 + d]; tot += c; if (dir ? (o > to) : (o < to)) offs += c; }
}

__device__ __forceinline__ void write_st(lds_t* L, const f32x16& S, int db, int eb, int lane) {
    const int e = 32 * eb + (lane & 31), hh = lane >> 5;
#pragma unroll
    for (int g = 0; g < 4; ++g) {
        const unsigned lo = pk2(S[4 * g], S[4 * g + 1]), hi = pk2(S[4 * g + 2], S[4 * g + 3]);
        *(__attribute__((address_space(3))) unsigned long long*)(L + O_ST + e * LS + (32 * db + 8 * g + 4 * hh) * 2) = (unsigned long long)lo | ((unsigned long long)hi << 32);
    }
}
__device__ __forceinline__ void scale_rows(lds_t* L, f32x16& S, int db, int lane) {
    const int hh = lane >> 5;
#pragma unroll
    for (int g = 0; g < 4; ++g) { const f32x4 dv = *(const __attribute__((address_space(3))) f32x4*)(L + O_DEC + (32 * db + 8 * g + 4 * hh) * 4);
        S[4 * g] *= dv.x; S[4 * g + 1] *= dv.y; S[4 * g + 2] *= dv.z; S[4 * g + 3] *= dv.w; }
}

__device__ __forceinline__ void state_unit(const Params& p, lds_t* L, int b, int si, int h) {
    const int tid = ltid(), lane = tid & 63, w = tid >> 6, hh = lane >> 5, d = lane, to = w;
    const bf16* PROJ = (const bf16*)(p.ws + WS_PROJ); const float* ALOW = (const float*)(p.ws + WS_ALOW);
    float* DST = (float*)(p.ws + WS_DST); float* DEC = (float*)(p.ws + WS_DEC);
    const float* w_dec = p.in[8]; const float* b_dec = p.in[9];
    const int db = w >> 2, eb = w & 3, base = si < 4 ? T + b * CTXL + 64 * si : b * SEQ + (si - 4) * 256, nch = si < 4 ? 1 : 4;
    float wf[16], wb[16];
#pragma unroll
    for (int r = 0; r < 16; ++r) { wf[r] = w_dec[r * 256 + h * 64 + d]; wb[r] = w_dec[4096 + r * 256 + h * 64 + d]; }
    const float bdf = b_dec[h * 64 + d], bdb = b_dec[256 + h * 64 + d];
    f32x16 Sf, Sb;
#pragma unroll
    for (int q = 0; q < 16; ++q) { Sf[q] = 0.f; Sb[q] = 0.f; }
    float pf = 1.f, pb = 1.f;
    Raw R;
    __syncthreads();
    raw_load<false, true>(R, PROJ, ALOW, base, h, 0, tid);
    raw_stage<false, true>(L, R, tid);
    __syncthreads();
#pragma unroll 1
    for (int c = 0; c < nch; ++c) {
        if (c + 1 < nch) raw_load<false, true>(R, PROJ, ALOW, base + 64 * (c + 1), h, 0, tid);
        float blf[8], blb[8];
        const float cf = la_cum<32>(L, to, 0, 0, wf, bdf, blf), cb = la_cum<32>(L, to, 1, 16, wb, bdb, blb);
        ((lf*)(L + O_CS))[to * 64 + d] = cf; ((lf*)(L + O_CSB))[to * 64 + d] = cb;
        __syncthreads();
        float of, tf, ob, tb;
        cs_combine((const lf*)(L + O_CS), d, to, 0, of, tf); cs_combine((const lf*)(L + O_CSB), d, to, 1, ob, tb);
        if (to == 0) ((lf*)(L + O_DEC))[d] = __expf(tf);
        float kf[8], kb[8];
#pragma unroll
        for (int jj = 0; jj < 8; ++jj) {
            const float k = bf2f(*(const lus*)(L + O_RK + (8 * to + jj) * LS + d * 2));
            kf[jj] = k * __expf(tf - (blf[jj] + of));
            kb[jj] = k * __expf(tb - (blb[jj] + ob)) * pb;
        }
        { v4u x; x.x = pk2(kf[0], kf[1]); x.y = pk2(kf[2], kf[3]); x.z = pk2(kf[4], kf[5]); x.w = pk2(kf[6], kf[7]); *(lv4*)(L + O_KT + d * LS + to * 16) = x; }
        { v4u x; x.x = pk2(kb[0], kb[1]); x.y = pk2(kb[2], kb[3]); x.z = pk2(kb[4], kb[5]); x.w = pk2(kb[6], kb[7]); *(lv4*)(L + O_KB + d * LS + to * 16) = x; }
        pf *= __expf(tf); pb *= __expf(tb);
        v_transpose(L, tid);
        __syncthreads();
        scale_rows(L, Sf, db, lane);
        Sf = mm_tile(L + O_KT + 32 * db * LS, L + O_VT + 32 * eb * LS, Sf, lane);
        Sb = mm_tile(L + O_KB + 32 * db * LS, L + O_VT + 32 * eb * LS, Sb, lane);
        if (c + 1 < nch) raw_stage<false, true>(L, R, tid);
        __syncthreads();
    }
    const int uf = ((0 * NB + b) * NSI + si) * 4 + h, ub = ((1 * NB + b) * NSI + si) * 4 + h;
#pragma unroll
    for (int q = 0; q < 16; ++q) { const int dl = (q & 3) + 8 * (q >> 2) + 4 * hh; const size_t o = (size_t)(32 * db + dl) * 128 + 32 * eb + (lane & 31);
        DST[(size_t)uf * 8192 + o] = Sf[q]; DST[(size_t)ub * 8192 + o] = Sb[q]; }
    if (to == 0) { DEC[uf * 64 + d] = pf; DEC[ub * 64 + d] = pb; }
}

template <int DIR>
__device__ __forceinline__ void out_pass(const Params& p, lds_t* L, int b, int sc, int h) {
    const int tid = ltid(), lane = tid & 63, w = tid >> 6, hh = lane >> 5, d = lane, to = w;
    const bf16* PROJ = (const bf16*)(p.ws + WS_PROJ); const float* ALOW = (const float*)(p.ws + WS_ALOW);
    const float* SPREV = (const float*)(p.ws + WS_SPREV); bf16* MIX = (bf16*)(p.ws + WS_MIX); float* OACC = (float*)(p.ws + WS_H);
    const float* w_dec = p.in[8]; const float* b_dec = p.in[9]; const float* gng = p.in[10];
    const int ib = w >> 2, eb = w & 3, base = b * SEQ + sc * 256;
    float wd[16];
#pragma unroll
    for (int r = 0; r < 16; ++r) wd[r] = w_dec[DIR * 4096 + r * 256 + h * 64 + d];
    const float bd = b_dec[DIR * 256 + h * 64 + d];
    const int u = ((DIR * NB + b) * 32 + sc) * 4 + h;
    f32x16 S;
#pragma unroll
    for (int q = 0; q < 16; ++q) { const int dl = (q & 3) + 8 * (q >> 2) + 4 * hh; S[q] = SPREV[(size_t)u * 8192 + (32 * ib + dl) * 128 + 32 * eb + (lane & 31)]; }
    float gnv[16];
    if (DIR == 0) {
#pragma unroll
        for (int q = 0; q < 16; ++q) gnv[q] = gng[(tid & 7) * 16 + q];
    }
    Raw R;
    __syncthreads();
    raw_load<true, false>(R, PROJ, ALOW, base + (DIR ? 192 : 0), h, DIR, tid);
    write_st(L, S, ib, eb, lane);
    raw_stage<true, false>(L, R, tid);
    __syncthreads();
#pragma unroll 1
    for (int cc = 0; cc < 4; ++cc) {
        const int c = DIR ? 3 - cc : cc, r0 = base + 64 * c;
        if (cc < 3) raw_load<true, false>(R, PROJ, ALOW, base + 64 * (DIR ? 2 - cc : cc + 1), h, DIR, tid);
        float* oa = OACC + (size_t)(r0 + 32 * ib + 4 * hh) * 512 + h * 128 + 32 * eb + (lane & 31);
        float ob[16]; v4u g0, g1;
        if (DIR == 0) {
#pragma unroll
            for (int q = 0; q < 16; ++q) ob[q] = oa[(size_t)((q & 3) + 8 * (q >> 2)) * 512];
            const size_t grow = (size_t)(r0 + (tid >> 3));
            g0 = *(const v4u*)(PROJ + grow * NPROJ + PG + h * 128 + (tid & 7) * 16); g1 = *(const v4u*)(PROJ + grow * NPROJ + PG + h * 128 + (tid & 7) * 16 + 8);
        }
        float bl[8];
        const float cum = la_cum<16>(L, to, DIR, 0, wd, bd, bl);
        ((lf*)(L + O_CS))[to * 64 + d] = cum;
        __syncthreads();
        float offs, tot; cs_combine((const lf*)(L + O_CS), d, to, DIR, offs, tot);
        const float dec = __expf(tot);
        if (to == 0) ((lf*)(L + O_DEC))[d] = dec;
        float kt[8];
#pragma unroll
        for (int jj = 0; jj < 8; ++jj) {
            const int j = 8 * to + jj;
            const float bq = bl[jj] + offs, E = __expf(bq), Einv = frcp(E);
            const float kf = bf2f(*(const lus*)(L + O_RK + j * LS + d * 2)) * Einv;
            const unsigned kq = pk2(kf, bf2f(*(const lus*)(L + O_RQ + j * LS + d * 2)) * 0.125f * E);
            *(lus*)(L + O_KB + j * LS + d * 2) = (unsigned short)kq;
            *(lus*)(L + O_QB + j * LS + d * 2) = (unsigned short)(kq >> 16);
            kt[jj] = kf * dec;
        }
        { v4u x; x.x = pk2(kt[0], kt[1]); x.y = pk2(kt[2], kt[3]); x.z = pk2(kt[4], kt[5]); x.w = pk2(kt[6], kt[7]); *(lv4*)(L + O_KT + d * LS + to * 16) = x; }
        v_transpose(L, tid);
        __syncthreads();
        if (w < 4) {
            const int pi = w >> 1, pj = w & 1;
            f32x16 pa;
#pragma unroll
            for (int q = 0; q < 16; ++q) pa[q] = 0.f;
            const bool dead = DIR ? (pj < pi) : (pj > pi);
            if (!dead) pa = mm_tile(L + O_QB + 32 * pi * LS, L + O_KB + 32 * pj * LS, pa, lane);
            const int jl = lane & 31;
#pragma unroll
            for (int q = 0; q < 16; q += 2) {
                const int il = (q & 3) + 8 * (q >> 2) + 4 * hh;
                float v0 = pa[q], v1 = pa[q + 1];
                if (pi == pj) { if (DIR ? (jl < il) : (jl > il)) v0 = 0.f; if (DIR ? (jl < il + 1) : (jl > il + 1)) v1 = 0.f; }
                const unsigned pw = pk2(v0, v1);
                *(lus*)(L + O_P + (32 * pi + il) * LS + (32 * pj + jl) * 2) = (unsigned short)pw;
                *(lus*)(L + O_P + (32 * pi + il + 1) * LS + (32 * pj + jl) * 2) = (unsigned short)(pw >> 16);
            }
        }
        __syncthreads();
        f32x16 o;
#pragma unroll
        for (int q = 0; q < 16; ++q) o[q] = 0.f;
        o = mm_tile(L + O_P + 32 * ib * LS, L + O_VT + 32 * eb * LS, o, lane);
        o = mm_tile(L + O_QB + 32 * ib * LS, L + O_ST + 32 * eb * LS, o, lane);
        scale_rows(L, S, ib, lane);
        S = mm_tile(L + O_KT + 32 * ib * LS, L + O_VT + 32 * eb * LS, S, lane);
        __syncthreads();
        write_st(L, S, ib, eb, lane);
        if (cc < 3) raw_stage<true, false>(L, R, tid);
        if (DIR == 1) {
#pragma unroll
            for (int q = 0; q < 16; ++q) oa[(size_t)((q & 3) + 8 * (q >> 2)) * 512] = o[q];
            __syncthreads();
        } else {
            lf* OUT = (lf*)(L + O_OUT);
#pragma unroll
            for (int q = 0; q < 16; ++q) { const int il = (q & 3) + 8 * (q >> 2) + 4 * hh; OUT[(32 * ib + il) * OUT_LD + 32 * eb + (lane & 31)] = o[q] + ob[q]; }
            __syncthreads();
            const int i = tid >> 3, e0 = (tid & 7) * 16;
            float v[16]; float ss = 0.f;
#pragma unroll
            for (int q4 = 0; q4 < 4; ++q4) { const f32x4 t = *(const __attribute__((address_space(3))) f32x4*)(OUT + i * OUT_LD + e0 + q4 * 4);
                v[q4 * 4] = t.x; v[q4 * 4 + 1] = t.y; v[q4 * 4 + 2] = t.z; v[q4 * 4 + 3] = t.w; ss += t.x * t.x + t.y * t.y + t.z * t.z + t.w * t.w; }
            ss += __shfl_xor(ss, 1); ss += __shfl_xor(ss, 2); ss += __shfl_xor(ss, 4);
            const float r = frsq(ss * (1.f / 128.f) + EPS);
            const size_t row = (size_t)(r0 + i);
            unsigned ow[8];
#pragma unroll
            for (int q = 0; q < 8; ++q) {
                const unsigned gw = q < 4 ? g0[q] : g1[q - 4];
                const float ga = __uint_as_float(gw << 16), gb = __uint_as_float(gw & 0xffff0000u);
                const float ya = v[2 * q] * r * gnv[2 * q] * (ga * frcp(1.f + __expf(-ga))), yb = v[2 * q + 1] * r * gnv[2 * q + 1] * (gb * frcp(1.f + __expf(-gb)));
                ow[q] = pk2(ya, yb);
            }
            v4u o0, o1; o0.x = ow[0]; o0.y = ow[1]; o0.z = ow[2]; o0.w = ow[3]; o1.x = ow[4]; o1.y = ow[5]; o1.z = ow[6]; o1.w = ow[7];
            *(v4u*)(MIX + row * 1024 + h * 128 + e0) = o0; *(v4u*)(MIX + row * 1024 + h * 128 + e0 + 8) = o1;
        }
    }
}
}

namespace pool {
typedef __attribute__((address_space(3))) unsigned char lds_t;
typedef __attribute__((address_space(3))) float lf;
constexpr int V_LD = 132, O_V0 = 0, O_V1 = 33792;
constexpr int PD_LS = 272;
constexpr int O_XG = 67584;
constexpr int O_PD = 102400;
static_assert(O_PD + 128 * PD_LS <= MISC_OFF, "pool LDS map");

template <int GI> struct PX { v4u x[2][(2 << GI) + 1]; };
template <int GI>
__device__ __forceinline__ void gload(PX<GI>& X, const Params& p, int b, int r0) {
    const int tid = ltid(), lane = tid & 63, wv = tid >> 6, co = lane & 15;
    const bf16* PROJ = (const bf16*)(p.ws + WS_PROJ);
    constexpr int w = 2 << GI, lo = w >> 1;
#pragma unroll
    for (int h2 = 0; h2 < 2; ++h2) {
        const int c = 8 * wv + 4 * h2 + (lane >> 4);
        const bf16* src = PROJ + (size_t)(b * SEQ + c) * NPROJ + PP + GI * 128 + 8 * co;
#pragma unroll
        for (int t = 0; t <= w; ++t) { const int r2 = min(max(r0 - lo + t, 0), 127); X.x[h2][t] = *(const v4u*)(src + (size_t)r2 * 64 * NPROJ); }
    }
}
template <int GI, class NX>
__device__ __forceinline__ void group(const Params& p, lds_t* L, int b, int r0, int tok0, PX<GI>& X, NX* nxt) {
    const int tid = ltid(), lane = tid & 63, wv = tid >> 6, hh = lane >> 5;
    const bf16* PROJ = (const bf16*)(p.ws + WS_PROJ); bf16* MIX = (bf16*)(p.ws + WS_MIX); const bf16* WPT = (const bf16*)(p.ws + WS_WPOOL);
    const float* pscale = p.in[12];
    constexpr int gi = GI, w = 2 << GI, lo = w >> 1, hi = w - 1 - lo;
    gla::bf16x8 bfr_[8];
    const int dcol = gi * 128 + 32 * (wv & 3) + (lane & 31);
    { const bf16* Bp = WPT + (size_t)gi * 16384 + (size_t)(32 * (wv & 3) + (lane & 31)) * 128 + hh * 8;
#pragma unroll
      for (int s2 = 0; s2 < 8; ++s2) bfr_[s2] = *(const gla::bf16x8*)(Bp + s2 * 16); }
    const float ps = pscale[dcol];
    {
        const int co = lane & 15;
        v4u (&x)[2][w + 1] = X.x;
#pragma unroll
        for (int h2 = 0; h2 < 2; ++h2) {
            const int c = 8 * wv + 4 * h2 + (lane >> 4);
            float a0[8], a1[8];
#pragma unroll
            for (int q = 0; q < 8; ++q) { a0[q] = 0.f; a1[q] = 0.f; }
#pragma unroll
            for (int t = 0; t <= w; ++t) { const int r2 = r0 - lo + t; const float m = (r2 >= 0 && r2 < 128) ? 1.f : 0.f;
#pragma unroll
                for (int q = 0; q < 4; ++q) { const float xl = m * __uint_as_float(x[h2][t][q] << 16), xh = m * __uint_as_float(x[h2][t][q] & 0xffff0000u);
                    if (t < w) { a0[2 * q] += xl; a0[2 * q + 1] += xh; }
                    if (t > 0) { a1[2 * q] += xl; a1[2 * q + 1] += xh; } } }
            lf* v0 = (lf*)(L + O_V0) + c * V_LD + 8 * co; lf* v1 = (lf*)(L + O_V1) + c * V_LD + 8 * co;
            *(__attribute__((address_space(3))) f32x4*)v0 = (f32x4){a0[0], a0[1], a0[2], a0[3]}; *(__attribute__((address_space(3))) f32x4*)(v0 + 4) = (f32x4){a0[4], a0[5], a0[6], a0[7]};
            *(__attribute__((address_space(3))) f32x4*)v1 = (f32x4){a1[0], a1[1], a1[2], a1[3]}; *(__attribute__((address_space(3))) f32x4*)(v1 + 4) = (f32x4){a1[4], a1[5], a1[6], a1[7]};
            *(__attribute__((address_space(3))) v4u*)(L + O_XG + c * PD_LS + co * 16) = x[h2][lo];
            *(__attribute__((address_space(3))) v4u*)(L + O_XG + (64 + c) * PD_LS + co * 16) = x[h2][lo + 1];
        }
    }
    __syncthreads();
    if constexpr (GI < 3) gload<GI + 1>(*nxt, p, b, r0);
#pragma unroll
    for (int rr = 0; rr < 2; ++rr) {
        const int r = r0 + rr, rs = max(r - lo, 0), re = min(r + hi + 1, 128);
        const int ch = tid & 127, c0 = 16 * (tid >> 7);
        const lf* V = (const lf*)(L + (rr ? O_V1 : O_V0)) + ch;
        const float invr = 1.f / (float)(re - rs);
        float sacc = 0.f;
        for (int c2 = max(c0 - lo, 0); c2 <= min(c0 + hi, 63); ++c2) sacc += V[c2 * V_LD];
#pragma unroll 4
        for (int ci = 0; ci < 16; ++ci) {
            const int c = c0 + ci;
            if (ci > 0) { const int ad = c + hi, rm = c - lo - 1; if (ad < 64) sacc += V[ad * V_LD]; if (rm >= 0) sacc -= V[rm * V_LD]; }
            const int cs = max(c - lo, 0), ce = min(c + hi + 1, 64);
            const float m = sacc * invr / (float)(ce - cs);
            const float x = bf2f(*(const __attribute__((address_space(3))) unsigned short*)(L + O_XG + (64 * rr + c) * PD_LS + ch * 2));
            *(__attribute__((address_space(3))) unsigned short*)(L + O_PD + (64 * rr + c) * PD_LS + ch * 2) = (unsigned short)f2bf(m - x);
        }
    }
    __syncthreads();
    {
        const int tb0 = wv >> 2, nb = wv & 3;
        gla::f32x16 acc0, acc1;
#pragma unroll
        for (int q = 0; q < 16; ++q) { acc0[q] = 0.f; acc1[q] = 0.f; }
        const lds_t* A0 = L + O_PD + (32 * tb0 + (lane & 31)) * PD_LS + hh * 16; const lds_t* A1 = A0 + 64 * PD_LS;
#pragma unroll
        for (int s2 = 0; s2 < 8; ++s2) {
            const gla::bf16x8 bb = bfr_[s2];
            acc0 = __builtin_amdgcn_mfma_f32_32x32x16_bf16(*(const __attribute__((address_space(3))) gla::bf16x8*)(A0 + s2 * 32), bb, acc0, 0, 0, 0);
            acc1 = __builtin_amdgcn_mfma_f32_32x32x16_bf16(*(const __attribute__((address_space(3))) gla::bf16x8*)(A1 + s2 * 32), bb, acc1, 0, 0, 0);
        }
#pragma unroll
        for (int q = 0; q < 16; ++q) { const int tl = (q & 3) + 8 * (q >> 2) + 4 * hh;
            MIX[(size_t)(tok0 + 32 * tb0 + tl) * 1024 + 512 + dcol] = (bf16)f2bf(acc0[q] * ps);
            MIX[(size_t)(tok0 + 64 + 32 * tb0 + tl) * 1024 + 512 + dcol] = (bf16)f2bf(acc1[q] * ps); }
    }
}
__device__ __forceinline__ void unit(const Params& p, lds_t* L, int b, int rp) {
    const int r0 = 2 * rp, tok0 = b * SEQ + r0 * 64;
    PX<0> x0; gload<0>(x0, p, b, r0);
    __syncthreads();
    PX<1> x1; group<0>(p, L, b, r0, tok0, x0, &x1);
    PX<2> x2; group<1>(p, L, b, r0, tok0, x1, &x2);
    PX<3> x3; group<2>(p, L, b, r0, tok0, x2, &x3);
    group<3>(p, L, b, r0, tok0, x3, (PX<3>*)nullptr);
}
}

__device__ __forceinline__ void phase0(const Params& p, unsigned char* lds) {
    const int tid = ltid(), lane = tid & 63, wave = tid >> 6, G = gridDim.x;
    const int gtid = blockIdx.x * 512 + tid, gthreads = G * 512;
    float* MOD = (float*)(p.ws + WS_MOD);
    const float* c = p.in[1]; const float* cctx = p.in[3]; const float* w_ada = p.in[4]; const float* b_ada = p.in[5];
    {
        float* SIL = (float*)lds;
        float* RED = (float*)(lds + 20480);
        for (int i = tid; i < 5 * 1024; i += 512) { const float v = i < 4096 ? c[i] : cctx[i - 4096]; SIL[i] = silu(v); }
        __syncthreads();
        for (int task = blockIdx.x; task < 192; task += G) {
            const int kg = tid >> 5, col = tid & 31;
            float wv[64];
#pragma unroll
            for (int k = 0; k < 64; ++k) wv[k] = w_ada[(size_t)(64 * kg + k) * 6144 + 32 * task + col];
            float a[5] = {0.f, 0.f, 0.f, 0.f, 0.f};
#pragma unroll
            for (int k = 0; k < 64; ++k)
#pragma unroll
                for (int v = 0; v < 5; ++v) a[v] += SIL[v * 1024 + 64 * kg + k] * wv[k];
#pragma unroll
            for (int v = 0; v < 5; ++v) RED[(kg * 5 + v) * 32 + col] = a[v];
            __syncthreads();
            if (tid < 160) { const int v = tid >> 5; float sacc = b_ada[32 * task + col];
#pragma unroll
                for (int g = 0; g < 16; ++g) sacc += RED[(g * 5 + v) * 32 + col];
                MOD[v * 6144 + 32 * task + col] = sacc; }
            __syncthreads();
        }
    }
    const float* w_in = p.in[7];
    bf16* WA = (bf16*)(p.ws + WS_WA);
    for (int idx = gtid; idx < 32 * 1024; idx += gthreads) { const int jj = idx >> 10, k = idx & 1023; WA[idx] = (bf16)f2bf(w_in[(size_t)k * IN_COLS + OFF_A + jj]); }
    const float* w_rg = p.in[15]; const float* w_re = p.in[16];
    bf16* WRH = (bf16*)(p.ws + WS_WR); bf16* WRL = WRH + 48 * 1024;
    for (int idx = gtid; idx < 48 * 1024; idx += gthreads) { const int r = idx >> 10, k = idx & 1023;
        const float v = r < 32 ? w_re[k * 32 + r] : (r < 36 ? w_rg[k * 4 + (r - 32)] : 0.f);
        const unsigned hi = f2bf(v); WRH[idx] = (bf16)hi; WRL[idx] = (bf16)f2bf(v - bf2f(hi)); }
    float* scr = (float*)(lds + wave * 8448);
    const int gw = blockIdx.x * 8 + wave, NGW = G * 8;
    bf16* WIN = (bf16*)(p.ws + WS_WIN); bf16* WOUT = (bf16*)(p.ws + WS_WOUT); bf16* WE1 = (bf16*)(p.ws + WS_WE1); bf16* WE2 = (bf16*)(p.ws + WS_WE2);
    const float* w_out = p.in[13]; const float* w_e_in = p.in[17]; const float* w_e_out = p.in[18];
    constexpr int I_A = 16 * 48, I_P = 16 * 16, I_O = 16 * 32, I_E1 = 32 * 256, I_E2 = 32 * 128, I_W = 32;
    auto desc_of = [&](int it) -> TDesc {
        int r = it;
        if (r >= I_A + I_P + I_O + I_E1 + I_E2) { r -= I_A + I_P + I_O + I_E1 + I_E2; const int g = r >> 3; return tdesc(p.in[11] + g * 16384, 128, 4, (bf16*)(p.ws + WS_WPOOL) + g * 16384, 128, r & 7); }
        if (r < I_A) return tdesc(w_in, IN_COLS, 48, WIN, 1024, r); r -= I_A;
        if (r < I_P) return tdesc(w_in + OFF_P, IN_COLS, 16, WIN + (size_t)1536 * 1024, 1024, r); r -= I_P;
        if (r < I_O) return tdesc(w_out, 1024, 32, WOUT, 1024, r); r -= I_O;
        if (r < I_E1) { const int e = r >> 8, sub = (r >> 6) & 3, item = r & 63, pn = sub >> 1, half = sub & 1;
            return tdesc(w_e_in + (size_t)e * 1024 * 512 + half * 256 + 128 * pn, 512, 4, WE1 + (size_t)e * 512 * 1024 + (size_t)(256 * pn + 128 * half) * 1024, 1024, item); } r -= I_E1;
        { const int e = r >> 7, item = r & 127; return tdesc(w_e_out + (size_t)e * 256 * 1024, 1024, 32, WE2 + (size_t)e * 1024 * 256, 256, item); }
    };
    constexpr int NIT = I_A + I_P + I_O + I_E1 + I_E2 + I_W;
    if (gw < NIT) {
        TDesc d = desc_of(gw); float tv[32]; titem_load(d, tv, lane);
        for (int it = gw; it < NIT; it += NGW) {
            const bool has = it + NGW < NIT;
            TDesc dn = d; float tn[32];
            if (has) { dn = desc_of(it + NGW); titem_load(dn, tn, lane); }
            titem_store(d, tv, scr, lane);
            if (has) { d = dn;
#pragma unroll
                for (int i = 0; i < 32; ++i) tv[i] = tn[i]; }
        }
    }
}

namespace skinny {
typedef __attribute__((address_space(3))) unsigned char lds_t;
typedef short bf16x8 __attribute__((ext_vector_type(8)));
constexpr int TLS = 2064;
constexpr int O_THI = 0, O_TLO = 16 * TLS, O_PART = 2 * 16 * TLS, O_LOG = O_PART + 8 * 16 * 48 * 4, O_RT = O_LOG + 16 * 48 * 4;
template <int NT, bool SPLIT>
__device__ __forceinline__ void mma_part(lds_t* L, const bf16* WH, const bf16* WL, int wv, int lane) {
    const int fr = lane & 15, fq = lane >> 4;
    f32x4 acc[NT];
#pragma unroll
    for (int t = 0; t < NT; ++t) acc[t] = (f32x4){0.f, 0.f, 0.f, 0.f};
#pragma unroll
    for (int s2 = 0; s2 < 4; ++s2) {
        const int k = 128 * wv + 32 * s2 + 8 * fq;
        const bf16x8 ah = *(const __attribute__((address_space(3))) bf16x8*)(L + O_THI + fr * TLS + k * 2);
        bf16x8 al; if (SPLIT) al = *(const __attribute__((address_space(3))) bf16x8*)(L + O_TLO + fr * TLS + k * 2);
#pragma unroll
        for (int t = 0; t < NT; ++t) {
            const bf16x8 bh = *(const bf16x8*)(WH + (size_t)(16 * t + fr) * 1024 + k);
            acc[t] = __builtin_amdgcn_mfma_f32_16x16x32_bf16(ah, bh, acc[t], 0, 0, 0);
            if (SPLIT) { const bf16x8 bl = *(const bf16x8*)(WL + (size_t)(16 * t + fr) * 1024 + k);
                acc[t] = __builtin_amdgcn_mfma_f32_16x16x32_bf16(al, bh, acc[t], 0, 0, 0);
                acc[t] = __builtin_amdgcn_mfma_f32_16x16x32_bf16(ah, bl, acc[t], 0, 0, 0); }
        }
    }
    __attribute__((address_space(3))) float* P = (__attribute__((address_space(3))) float*)(L + O_PART) + wv * 16 * 16 * NT;
#pragma unroll
    for (int t = 0; t < NT; ++t)
#pragma unroll
        for (int q = 0; q < 4; ++q) P[(4 * fq + q) * 16 * NT + 16 * t + fr] = acc[t][q];
}
template <int NT>
__device__ __forceinline__ void load_bfrags(bf16x8 (&bh)[NT][4], const bf16* W, int wv, int lane) {
    const int fr = lane & 15, fq = lane >> 4;
#pragma unroll
    for (int t = 0; t < NT; ++t)
#pragma unroll
        for (int s2 = 0; s2 < 4; ++s2) bh[t][s2] = *(const bf16x8*)(W + (size_t)(16 * t + fr) * 1024 + 128 * wv + 32 * s2 + 8 * fq);
}
template <int NT, bool SPLIT>
__device__ __forceinline__ void mma_part_reg(lds_t* L, const bf16x8 (&bh)[NT][4], int wv, int lane) {
    const int fr = lane & 15, fq = lane >> 4;
    f32x4 acc[NT];
#pragma unroll
    for (int t = 0; t < NT; ++t) acc[t] = (f32x4){0.f, 0.f, 0.f, 0.f};
#pragma unroll
    for (int s2 = 0; s2 < 4; ++s2) {
        const int k = 128 * wv + 32 * s2 + 8 * fq;
        const bf16x8 ah = *(const __attribute__((address_space(3))) bf16x8*)(L + O_THI + fr * TLS + k * 2);
        bf16x8 al; if (SPLIT) al = *(const __attribute__((address_space(3))) bf16x8*)(L + O_TLO + fr * TLS + k * 2);
#pragma unroll
        for (int t = 0; t < NT; ++t) {
            acc[t] = __builtin_amdgcn_mfma_f32_16x16x32_bf16(ah, bh[t][s2], acc[t], 0, 0, 0);
            if (SPLIT) acc[t] = __builtin_amdgcn_mfma_f32_16x16x32_bf16(al, bh[t][s2], acc[t], 0, 0, 0);
        }
    }
    __attribute__((address_space(3))) float* P = (__attribute__((address_space(3))) float*)(L + O_PART) + wv * 16 * 16 * NT;
#pragma unroll
    for (int t = 0; t < NT; ++t)
#pragma unroll
        for (int q = 0; q < 4; ++q) P[(4 * fq + q) * 16 * NT + 16 * t + fr] = acc[t][q];
}
template <int NT>
__device__ __forceinline__ float part_sum(const lds_t* L, int idx) {
    const __attribute__((address_space(3))) float* P = (const __attribute__((address_space(3))) float*)(L + O_PART);
    float s = 0.f;
#pragma unroll
    for (int w = 0; w < 8; ++w) s += P[w * 16 * 16 * NT + idx];
    return s;
}
}

struct P1Iters {
    int G, b;
    __device__ __forceinline__ int count() const { if (G != 256) return (TT / 16 - b + G - 1) / G; return 9; }
    __device__ __forceinline__ int at(int li) const {
        if (G != 256) return b + li * G;
        return li == 0 ? T / 16 + (b >> 2) : b * 8 + (li - 1);
    }
    __device__ __forceinline__ int quarter() const { return G != 256 ? -1 : (b & 3); }
};
__device__ __forceinline__ void phase1(const Params& p, unsigned char* lds) {
    using namespace skinny;
    lds_t* L = (lds_t*)lds;
    const int tid = ltid(), lane = tid & 63, wave = tid >> 6, G = gridDim.x;
    const float* MOD = (const float*)(p.ws + WS_MOD); const bf16* WA = (const bf16*)(p.ws + WS_WA); const bf16* WIN = (const bf16*)(p.ws + WS_WIN);
    bf16* H = (bf16*)(p.ws + WS_H); float* ALOW = (float*)(p.ws + WS_ALOW); bf16* PROJ = (bf16*)(p.ws + WS_PROJ);
    const float* g1 = p.in[6];
    const P1Iters I{G, (int)blockIdx.x};
    const int nit = I.count();
    bf16x8 bw[2][4]; load_bfrags<2>(bw, WA, wave, lane);
    f32x4 nx[2][4], nx2[2][4];
#pragma unroll
    for (int rr = 0; rr < 2; ++rr)
#pragma unroll
        for (int j = 0; j < 4; ++j) { nx[rr][j] = (f32x4){0.f, 0.f, 0.f, 0.f}; nx2[rr][j] = (f32x4){0.f, 0.f, 0.f, 0.f}; }
    auto xrow = [&](int it, int rr) -> const float* { const int row = it * 16 + wave * 2 + rr; return row < T ? p.in[0] + (size_t)row * D : p.in[2] + (size_t)(row - T) * D; };
    if (nit > 0) {
#pragma unroll
        for (int rr = 0; rr < 2; ++rr)
#pragma unroll
            for (int j = 0; j < 4; ++j) nx[rr][j] = ((const f32x4*)xrow(I.at(0), rr))[lane + 64 * j]; }
    if (nit > 1) {
#pragma unroll
        for (int rr = 0; rr < 2; ++rr)
#pragma unroll
            for (int j = 0; j < 4; ++j) nx2[rr][j] = ((const f32x4*)xrow(I.at(1), rr))[lane + 64 * j]; }
#pragma unroll 1
    for (int li = 0; li < nit; ++li) {
        const int it = I.at(li);
        f32x4 v[2][4];
#pragma unroll
        for (int rr = 0; rr < 2; ++rr)
#pragma unroll
            for (int j = 0; j < 4; ++j) { v[rr][j] = nx[rr][j]; nx[rr][j] = nx2[rr][j]; }
        if (li + 2 < nit) {
#pragma unroll
            for (int rr = 0; rr < 2; ++rr)
#pragma unroll
                for (int j = 0; j < 4; ++j) nx2[rr][j] = ((const f32x4*)xrow(I.at(li + 2), rr))[lane + 64 * j]; }
        f32x4 gm1[4], sh1[4];
        { const float* md = MOD + (it * 16 < T ? ((it * 16) >> 13) : 4) * 6144;
#pragma unroll
          for (int j = 0; j < 4; ++j) { gm1[j] = ((const f32x4*)g1)[lane + 64 * j] * (((const f32x4*)(md + 1024))[lane + 64 * j] + 1.f); sh1[j] = ((const f32x4*)md)[lane + 64 * j]; } }
        __syncthreads();
#pragma unroll
        for (int rr = 0; rr < 2; ++rr) {
            const int lr = wave * 2 + rr, row = it * 16 + lr;
            float ss = 0.f;
#pragma unroll
            for (int j = 0; j < 4; ++j) ss += v[rr][j].x * v[rr][j].x + v[rr][j].y * v[rr][j].y + v[rr][j].z * v[rr][j].z + v[rr][j].w * v[rr][j].w;
            const float r = frsq(wave_sum(ss) * (1.f / D) + EPS);
#pragma unroll
            for (int j = 0; j < 4; ++j) {
                const f32x4 hv = v[rr][j] * r * gm1[j] + sh1[j];
                const unsigned long long o = (unsigned long long)pk2(hv.x, hv.y) | ((unsigned long long)pk2(hv.z, hv.w) << 32);
                if (row < T) ((unsigned long long*)(H + (size_t)row * D))[lane + 64 * j] = o;
                *(__attribute__((address_space(3))) unsigned long long*)(L + O_THI + lr * TLS + (lane + 64 * j) * 8) = o;
            }
        }
        __syncthreads();
        mma_part_reg<2, false>(L, bw, wave, lane);
        if (it >= T / 16) {
            const int fr = lane & 15, fq = lane >> 4, q0 = I.quarter() < 0 ? 0 : I.quarter(), q1 = I.quarter() < 0 ? 4 : I.quarter() + 1;
            for (int qt = q0; qt < q1; ++qt) {
                f32x4 acc[3];
#pragma unroll
                for (int t = 0; t < 3; ++t) acc[t] = (f32x4){0.f, 0.f, 0.f, 0.f};
                const int c0 = PK + 192 * qt + 48 * (wave & 3), kh = wave >> 2;
                const bf16* wb = WIN + (size_t)(c0 + fr) * 1024 + 512 * kh + 8 * fq;
#pragma unroll 1
                for (int sb = 0; sb < 4; ++sb) {
                    bf16x8 bq[4][3];
#pragma unroll
                    for (int s2 = 0; s2 < 4; ++s2)
#pragma unroll
                        for (int t = 0; t < 3; ++t) bq[s2][t] = *(const bf16x8*)(wb + (size_t)t * 16 * 1024 + 32 * (4 * sb + s2));
#pragma unroll
                    for (int s2 = 0; s2 < 4; ++s2) {
                        const bf16x8 a = *(const __attribute__((address_space(3))) bf16x8*)(L + O_THI + fr * TLS + (512 * kh + 32 * (4 * sb + s2) + 8 * fq) * 2);
#pragma unroll
                        for (int t = 0; t < 3; ++t) acc[t] = __builtin_amdgcn_mfma_f32_16x16x32_bf16(a, bq[s2][t], acc[t], 0, 0, 0);
                    }
                }
                __attribute__((address_space(3))) float* CP = (__attribute__((address_space(3))) float*)(L + O_LOG);
#pragma unroll
                for (int t = 0; t < 3; ++t)
#pragma unroll
                    for (int q = 0; q < 4; ++q) CP[(kh * 16 + 4 * fq + q) * 192 + 48 * (wave & 3) + 16 * t + fr] = acc[t][q];
                __syncthreads();
                for (int idx = tid; idx < 16 * 96; idx += 512) { const int r = idx / 96, c2 = (idx - r * 96) * 2;
                    const float v0 = CP[r * 192 + c2] + CP[(16 + r) * 192 + c2], v1 = CP[r * 192 + c2 + 1] + CP[(16 + r) * 192 + c2 + 1];
                    *(unsigned*)(PROJ + (size_t)(it * 16 + r) * NPROJ + PK + 192 * qt + c2) = pk2(v0, v1); }
                __syncthreads();
            }
        }
        __syncthreads();
        ALOW[(size_t)it * 16 * 32 + tid] = part_sum<2>(L, tid);
    }
}

__device__ __forceinline__ void phase2(const Params& p, unsigned char* lds) {
    const bf16* H = (const bf16*)(p.ws + WS_H); const bf16* WIN = (const bf16*)(p.ws + WS_WIN); bf16* PROJ = (bf16*)(p.ws + WS_PROJ);
    pg8::SchedDense S; S.init(T, NPROJ, D, WIN, (int)gridDim.x, (int)blockIdx.x);
    pg8::EpiProj E{PROJ, NPROJ};
    pg8::gemm_phase<pg8::EpiProj, pg8::SchedDense, true>((PG8_LAS unsigned char*)lds, H, D, S, E);
}

__device__ __forceinline__ void phase3(const Params& p) {
    const int gtid = blockIdx.x * 512 + threadIdx.x, gthreads = gridDim.x * 512;
    const float* ALOW = (const float*)(p.ws + WS_ALOW); float* BC = (float*)(p.ws + WS_BC);
    const float* w_dec = p.in[8]; const float* b_dec = p.in[9];
    for (int idx = gtid; idx < (TT / 64) * 512; idx += gthreads) {
        const int c = idx >> 9, dir = (idx >> 8) & 1, hd = idx & 255;
        float wd[16];
#pragma unroll
        for (int r = 0; r < 16; ++r) wd[r] = w_dec[dir * 4096 + r * 256 + hd];
        const float bd = b_dec[dir * 256 + hd];
        float cum = 0.f;
        for (int jj = 0; jj < 64; ++jj) {
            const int j = dir ? 63 - jj : jj; const size_t row = (size_t)c * 64 + j;
            float z = bd;
#pragma unroll
            for (int r = 0; r < 16; ++r) z += ALOW[row * 32 + dir * 16 + r] * wd[r];
            const float la = (fminf(z, 0.f) - log1pf(__expf(-fabsf(z)))) * (1.f / 16.f);
            cum += la;
            BC[(row * 2 + dir) * 256 + hd] = cum;
        }
    }
}

__device__ __forceinline__ int row_base(int b, int si) { return si == 0 ? T + b * CTXL : b * SEQ + (si - 1) * 256; }
__device__ __forceinline__ void phase4(const Params& p, unsigned char* lds) {
    for (int u = blockIdx.x; u < NB * 32 * 4 + NB * 4 * 4; u += gridDim.x) {
        if (u < NB * 32 * 4) gla::state_unit(p, (gla::lds_t*)lds, u >> 7, 4 + ((u >> 2) & 31), u & 3);
        else { const int v = u - NB * 32 * 4; gla::state_unit(p, (gla::lds_t*)lds, v >> 4, (v >> 2) & 3, v & 3); }
    }
    __syncthreads();
}

__device__ __forceinline__ void phase5(const Params& p) {
    const int gtid = blockIdx.x * 512 + threadIdx.x, gthreads = gridDim.x * 512;
    const float* DST = (const float*)(p.ws + WS_DST); const float* DEC = (const float*)(p.ws + WS_DEC); float* SPREV = (float*)(p.ws + WS_SPREV);
    typedef float f32x2 __attribute__((ext_vector_type(2)));
    for (int idx = gtid; idx < 2 * NB * 4 * 4096; idx += gthreads) {
        const int de = (idx & 4095) * 2, h = (idx >> 12) & 3, b = (idx >> 14) & 3, dir = idx >> 16, d = de >> 7;
        const int ub = ((dir * NB + b) * NSI) * 4 + h, us = ((dir * NB + b) * 32) * 4 + h;
        f32x2 ds[NSI]; float dc[NSI];
#pragma unroll
        for (int si = 0; si < NSI; ++si) { ds[si] = *(const f32x2*)(DST + (size_t)(ub + 4 * si) * 8192 + de); dc[si] = DEC[(ub + 4 * si) * 64 + d]; }
        if (dir == 0) {
            f32x2 S = ds[0];
#pragma unroll
            for (int si = 1; si < 4; ++si) S = S * dc[si] + ds[si];
#pragma unroll
            for (int si = 4; si < NSI; ++si) { *(f32x2*)(SPREV + (size_t)(us + 4 * (si - 4)) * 8192 + de) = S; S = S * dc[si] + ds[si]; }
        } else {
            f32x2 S = ds[3];
#pragma unroll
            for (int si = 2; si >= 0; --si) S = S * dc[si] + ds[si];
#pragma unroll
            for (int si = NSI - 1; si >= 4; --si) { *(f32x2*)(SPREV + (size_t)(us + 4 * (si - 4)) * 8192 + de) = S; S = S * dc[si] + ds[si]; }
        }
    }
}

__device__ __forceinline__ void phase6(const Params& p, unsigned char* lds) {
    gla::lds_t* L = (gla::lds_t*)lds;
    for (int unit = blockIdx.x; unit < NB * 32 * 4; unit += gridDim.x) {
        const int h = unit & 3, sc = (unit >> 2) & 31, b = unit >> 7;
        gla::out_pass<1>(p, L, b, sc, h);
        gla::out_pass<0>(p, L, b, sc, h);
    }
    __syncthreads();
}

__device__ __forceinline__ void phase7(const Params& p, unsigned char* lds) {
    const int G = gridDim.x, vcu = (G % 8 == 0) ? (int)(blockIdx.x % 8) * (G / 8) + (int)(blockIdx.x / 8) : (int)blockIdx.x;
    for (int u = vcu; u < NB * 64; u += G) pool::unit(p, (pool::lds_t*)lds, u >> 6, u & 63);
    __syncthreads();
}

__device__ __forceinline__ void phase8(const Params& p, unsigned char* lds) {
    const bf16* MIX = (const bf16*)(p.ws + WS_MIX); const bf16* WOUT = (const bf16*)(p.ws + WS_WOUT); const float* MOD = (const float*)(p.ws + WS_MOD);
    pg8::SchedDense S; S.init(T, D, D, WOUT, (int)gridDim.x, (int)blockIdx.x);
    pg8::EpiOut E{(bf16*)(p.ws + WS_OUTP), MOD};
    pg8::gemm_phase<pg8::EpiOut, pg8::SchedDense, true>((PG8_LAS unsigned char*)lds, MIX, D, S, E);
}

__device__ __forceinline__ void phase9(const Params& p, unsigned char* lds) {
    using namespace skinny;
    lds_t* L = (lds_t*)lds;
    typedef __attribute__((address_space(3))) float lf; typedef __attribute__((address_space(3))) int li;
    const int tid = ltid(), lane = tid & 63, wave = tid >> 6, G = gridDim.x;
    const float* MOD = (const float*)(p.ws + WS_MOD); const bf16* WRH = (const bf16*)(p.ws + WS_WR); const bf16* WRL = WRH + 48 * 1024;
    bf16* H2 = (bf16*)(p.ws + WS_H); float* RW = (float*)(p.ws + WS_RW); int* LIST = (int*)(p.ws + WS_LIST);
    unsigned* CNT = (unsigned*)(p.ws + WS_CTL) + CW_CNT;
    const float* g2 = p.in[14];
    lf* LOG = (lf*)(L + O_LOG);
    li* EID = (li*)(L + O_RT);
    lf* EWT = (lf*)(L + O_RT + 1024);
    li* RNK = (li*)(L + O_RT + 2048);
    li* LCN = (li*)(L + O_RT + 3072);
    bf16x8 bwh[3][4]; load_bfrags<3>(bwh, WRH, wave, lane);
    for (int blk = blockIdx.x; blk < T / 128; blk += G) {
        __syncthreads();
        if (tid < 32) LCN[tid] = 0;
        f32x4 gm9[4], sh9[4];
        { const float* md = MOD + ((blk * 128) >> 13) * 6144;
#pragma unroll
          for (int j = 0; j < 4; ++j) { gm9[j] = ((const f32x4*)g2)[lane + 64 * j] * (((const f32x4*)(md + 4096))[lane + 64 * j] + 1.f); sh9[j] = ((const f32x4*)(md + 3072))[lane + 64 * j]; } }
        unsigned long long nx[2][4]; f32x4 nf[2][4];
#pragma unroll
        for (int rr = 0; rr < 2; ++rr)
#pragma unroll
            for (int j = 0; j < 4; ++j) { const size_t ro = (size_t)(blk * 128 + wave * 2 + rr) * D;
                nx[rr][j] = ((const unsigned long long*)((const bf16*)(p.ws + WS_OUTP) + ro))[lane + 64 * j]; nf[rr][j] = ((const f32x4*)(p.in[0] + ro))[lane + 64 * j]; }
#pragma unroll 1
        for (int it8 = 0; it8 < 8; ++it8) {
            const int row0 = blk * 128 + it8 * 16;
            unsigned long long cx[2][4]; f32x4 cf[2][4];
#pragma unroll
            for (int rr = 0; rr < 2; ++rr)
#pragma unroll
                for (int j = 0; j < 4; ++j) { cx[rr][j] = nx[rr][j]; cf[rr][j] = nf[rr][j]; }
            if (it8 < 7) {
#pragma unroll
                for (int rr = 0; rr < 2; ++rr)
#pragma unroll
                    for (int j = 0; j < 4; ++j) { const size_t ro = (size_t)(row0 + 16 + wave * 2 + rr) * D;
                        nx[rr][j] = ((const unsigned long long*)((const bf16*)(p.ws + WS_OUTP) + ro))[lane + 64 * j]; nf[rr][j] = ((const f32x4*)(p.in[0] + ro))[lane + 64 * j]; }
            }
            __syncthreads();
#pragma unroll
            for (int rr = 0; rr < 2; ++rr) {
                const int lr = wave * 2 + rr, row = row0 + lr;
                const float* md = MOD + (row >> 13) * 6144;
                f32x4 v[4]; float ss = 0.f;
#pragma unroll
                for (int j = 0; j < 4; ++j) { const unsigned long long xw = cx[rr][j];
                    v[j].x = cf[rr][j].x + bf2f((unsigned)(xw & 0xffff)); v[j].y = cf[rr][j].y + bf2f((unsigned)((xw >> 16) & 0xffff)); v[j].z = cf[rr][j].z + bf2f((unsigned)((xw >> 32) & 0xffff)); v[j].w = cf[rr][j].w + bf2f((unsigned)(xw >> 48));
                    ((unsigned long long*)((bf16*)(p.ws + WS_XMID) + (size_t)row * D))[lane + 64 * j] = (unsigned long long)pk2(v[j].x, v[j].y) | ((unsigned long long)pk2(v[j].z, v[j].w) << 32);
                    ss += v[j].x * v[j].x + v[j].y * v[j].y + v[j].z * v[j].z + v[j].w * v[j].w; }
                const float r = frsq(wave_sum(ss) * (1.f / D) + EPS);
#pragma unroll
                for (int j = 0; j < 4; ++j) {
                    v[j] = v[j] * r * gm9[j] + sh9[j];
                    const unsigned h0 = f2bf(v[j].x), h1 = f2bf(v[j].y), h2 = f2bf(v[j].z), h3 = f2bf(v[j].w);
                    const unsigned long long o = (unsigned long long)(h0 | (h1 << 16)) | ((unsigned long long)(h2 | (h3 << 16)) << 32);
                    const unsigned long long ol = (unsigned long long)pk2(v[j].x - bf2f(h0), v[j].y - bf2f(h1)) | ((unsigned long long)pk2(v[j].z - bf2f(h2), v[j].w - bf2f(h3)) << 32);
                    ((unsigned long long*)(H2 + (size_t)row * D))[lane + 64 * j] = o;
                    *(__attribute__((address_space(3))) unsigned long long*)(L + O_THI + lr * TLS + (lane + 64 * j) * 8) = o;
                    *(__attribute__((address_space(3))) unsigned long long*)(L + O_TLO + lr * TLS + (lane + 64 * j) * 8) = ol;
                }
            }
            __syncthreads();
            mma_part_reg<3, true>(L, bwh, wave, lane);
            __syncthreads();
            LOG[tid] = part_sum<3>(L, tid);
            if (tid < 256) LOG[512 + tid] = part_sum<3>(L, 512 + tid);
            __syncthreads();
            if (tid < 16) {
                const lf* lg = LOG + tid * 48;
                int gi = 0; float gm = lg[32];
#pragma unroll
                for (int q = 1; q < 4; ++q) if (lg[32 + q] > gm) { gm = lg[32 + q]; gi = q; }
                float gs = 0.f;
#pragma unroll
                for (int q = 0; q < 4; ++q) gs += __expf(lg[32 + q] - gm);
                const float gp = 1.f / gs;
                float le[8];
#pragma unroll
                for (int q = 0; q < 8; ++q) le[q] = lg[gi * 8 + q];
                int i0 = 0; float m0 = le[0];
#pragma unroll
                for (int q = 1; q < 8; ++q) if (le[q] > m0) { m0 = le[q]; i0 = q; }
                int i1 = -1; float m1 = -3.0e38f;
#pragma unroll
                for (int q = 0; q < 8; ++q) if (q != i0 && le[q] > m1) { m1 = le[q]; i1 = q; }
                const float e1 = __expf(m1 - m0), w0 = gp / (1.f + e1), w1 = gp * e1 / (1.f + e1);
                const int pr = (it8 * 16 + tid) * 2;
                EID[pr] = gi * 8 + i0; EWT[pr] = w0; EID[pr + 1] = gi * 8 + i1; EWT[pr + 1] = w1;
            }
        }
        __syncthreads();
        if (tid < 256) RNK[tid] = __hip_atomic_fetch_add((int*)(LCN + EID[tid]), 1, __ATOMIC_RELAXED, __HIP_MEMORY_SCOPE_WORKGROUP);
        __syncthreads();
        if (tid < 32) { const int c = LCN[tid]; LCN[tid] = c ? (int)atomicAdd(CNT + tid, (unsigned)c) : 0; }
        __syncthreads();
        if (tid < 256) { const int e = EID[tid], tok2 = blk * 256 + tid; const size_t sl = (size_t)(e * T + LCN[e] + RNK[tid]); LIST[2 * sl] = tok2; LIST[2 * sl + 1] = __float_as_int(EWT[tid]); }
    }
}

__device__ __forceinline__ void moe_tables(const Params& p, unsigned char* lds) {
    PG8_LAS int* tp = (PG8_LAS int*)((PG8_LAS unsigned char*)lds + MISC_OFF) + 32; PG8_LAS int* cn = tp + 64;
    const unsigned* CNT = (const unsigned*)(p.ws + WS_CTL) + CW_CNT;
    __syncthreads();
    if (threadIdx.x < 32) cn[threadIdx.x] = (int)CNT[threadIdx.x];
    __syncthreads();
    if (threadIdx.x == 0) { int a = 0; for (int e = 0; e < 32; ++e) { tp[e] = a; a += (cn[e] + 255) >> 8; } tp[32] = a; }
    __syncthreads();
    {
        PG8_LAS unsigned char* r2e = (PG8_LAS unsigned char*)(tp + 96);
        for (int rt = threadIdx.x; rt < 288; rt += 512) { int e = 0; while (e < 31 && tp[e + 1] <= rt) ++e; r2e[rt] = (unsigned char)e; }
    }
    __syncthreads();
}
__device__ __forceinline__ void phase10(const Params& p, unsigned char* lds) {
    moe_tables(p, lds);
    const PG8_LAS int* tp = (const PG8_LAS int*)((PG8_LAS unsigned char*)lds + MISC_OFF) + 32; const PG8_LAS int* cn = tp + 64;
    pg8::SchedMoE1 S{tp, cn, (const int*)(p.ws + WS_LIST), (const bf16*)(p.ws + WS_WE1), (int)gridDim.x, (int)blockIdx.x};
    pg8::EpiSwiglu E{(bf16*)(p.ws + WS_HID)};
    pg8::gemm_phase<pg8::EpiSwiglu, pg8::SchedMoE1, true>((PG8_LAS unsigned char*)lds, (const bf16*)(p.ws + WS_H), D, S, E);
}
__device__ __forceinline__ void phase11(const Params& p, unsigned char* lds) {
    const PG8_LAS int* tp = (const PG8_LAS int*)((PG8_LAS unsigned char*)lds + MISC_OFF) + 32; const PG8_LAS int* cn = tp + 64;
    pg8::SchedMoE2 S{tp, (const bf16*)(p.ws + WS_WE2), (int)gridDim.x, (int)blockIdx.x};
    pg8::EpiScatter E{(bf16*)(p.ws + WS_PROJ), cn, (const int*)(p.ws + WS_LIST)};
    pg8::gemm_phase<pg8::EpiScatter, pg8::SchedMoE2, true>((PG8_LAS unsigned char*)lds, (const bf16*)(p.ws + WS_HID), DE, S, E);
}

__device__ __forceinline__ void phase12(const Params& p) {
    const int tid = ltid(), lane = tid & 63, wave = tid >> 6, G = gridDim.x;
    const int gw = blockIdx.x * 8 + wave, NGW = G * 8;
    const float* MOD = (const float*)(p.ws + WS_MOD); const bf16* Y = (const bf16*)(p.ws + WS_PROJ); const bf16* XM = (const bf16*)(p.ws + WS_XMID);
    f32x4 gfin[4];
#pragma unroll
    for (int j = 0; j < 4; ++j) gfin[j] = ((const f32x4*)p.in[19])[lane + 64 * j];
    for (int row = gw; row < T; row += 2 * NGW) {
        unsigned long long xw[2][4], y0[2][4], y1[2][4]; f32x4 gt[2][4];
#pragma unroll
        for (int rr = 0; rr < 2; ++rr) {
            const int r = min(row + rr * NGW, T - 1);
#pragma unroll
            for (int j = 0; j < 4; ++j) {
                xw[rr][j] = ((const unsigned long long*)(XM + (size_t)r * D))[lane + 64 * j];
                y0[rr][j] = ((const unsigned long long*)(Y + (size_t)(2 * r) * 1024))[lane + 64 * j];
                y1[rr][j] = ((const unsigned long long*)(Y + (size_t)(2 * r + 1) * 1024))[lane + 64 * j];
                gt[rr][j] = ((const f32x4*)(MOD + (r >> 13) * 6144 + 5120))[lane + 64 * j];
            }
        }
#pragma unroll
        for (int rr = 0; rr < 2; ++rr) {
            const int r = row + rr * NGW;
            f32x4 v[4]; float ss = 0.f;
#pragma unroll
            for (int j = 0; j < 4; ++j) {
                const unsigned long long a = xw[rr][j], b0 = y0[rr][j], b1 = y1[rr][j];
                f32x4 xv, ys;
                xv.x = bf2f((unsigned)(a & 0xffff)); xv.y = bf2f((unsigned)((a >> 16) & 0xffff)); xv.z = bf2f((unsigned)((a >> 32) & 0xffff)); xv.w = bf2f((unsigned)(a >> 48));
                ys.x = bf2f((unsigned)(b0 & 0xffff)) + bf2f((unsigned)(b1 & 0xffff));
                ys.y = bf2f((unsigned)((b0 >> 16) & 0xffff)) + bf2f((unsigned)((b1 >> 16) & 0xffff));
                ys.z = bf2f((unsigned)((b0 >> 32) & 0xffff)) + bf2f((unsigned)((b1 >> 32) & 0xffff));
                ys.w = bf2f((unsigned)(b0 >> 48)) + bf2f((unsigned)(b1 >> 48));
                v[j] = xv + gt[rr][j] * ys;
                ss += v[j].x * v[j].x + v[j].y * v[j].y + v[j].z * v[j].z + v[j].w * v[j].w;
            }
            const float rn = frsq(wave_sum(ss) * (1.f / D) + EPS);
            if (r < T) {
#pragma unroll
                for (int j = 0; j < 4; ++j) ((f32x4*)(p.out + (size_t)r * D))[lane + 64 * j] = v[j] * rn * gfin[j];
            }
        }
    }
}

#define LAS __attribute__((address_space(3)))
#define XB_TMO      128
#define XB_XCNT(j)  (256  + 64 * (j))
#define XB_XSUB(j)  (1280 + 64 * (j))
#define XB_XGEN(j)  (2304 + 64 * (j))
#define XB_TOP      3328
#define XB_TOPGEN   3392
#define XCD_BAR_WORDS 3456
#define XB_SPIN_CAP (1u << 18)
__device__ __forceinline__ unsigned xb_ld(unsigned* p)              { return __hip_atomic_load(p, __ATOMIC_RELAXED, __HIP_MEMORY_SCOPE_AGENT); }
__device__ __forceinline__ unsigned xb_add(unsigned* p, unsigned v) { return __hip_atomic_fetch_add(p, v, __ATOMIC_RELAXED, __HIP_MEMORY_SCOPE_AGENT); }
__device__ __forceinline__ unsigned xb_xcc_id() { return (unsigned)__builtin_amdgcn_s_getreg((3 << 11) | 20) & 0xFu; }
#define XB_SPIN(cond, bar) do { unsigned _sp = 0; while (cond) { __builtin_amdgcn_s_sleep(1); \
    if ((++_sp & 255u) == 0u) { if (xb_ld(&(bar)[XB_TMO])) break; if (_sp > XB_SPIN_CAP) { atomicAdd(&(bar)[XB_TMO], 1u); break; } } } } while (0)
struct XcdBarrier { unsigned* bar; unsigned x; volatile LAS unsigned* st; };
__device__ __forceinline__ XcdBarrier xcd_barrier_post(unsigned* bar, volatile LAS unsigned* st) {
    XcdBarrier b; b.bar = bar; b.x = xb_xcc_id(); b.st = st;
    if (threadIdx.x == 0) (void)xb_add(&bar[XB_XCNT(b.x)], 1u);
    return b;
}
__device__ __forceinline__ void xcd_barrier_complete(unsigned* bar, unsigned x, unsigned& nloc, unsigned& nx) {
    const unsigned G = gridDim.x * gridDim.y * gridDim.z;
    unsigned sum, cnt, mine, sp = 0u;
    for (;;) {
        sum = 0u; cnt = 0u; mine = 0u;
#pragma unroll
        for (unsigned j = 0; j < 16; ++j) { const unsigned c = xb_ld(&bar[XB_XCNT(j)]); sum += c; cnt += (c > 0u) ? 1u : 0u; mine = (j == x) ? c : mine; }
        if (sum == G) break;
        __builtin_amdgcn_s_sleep(1);
        if ((++sp & 255u) == 0u) { if (xb_ld(&bar[XB_TMO])) break; if (sp > XB_SPIN_CAP) { atomicAdd(&bar[XB_TMO], 1u); break; } }
    }
    nloc = mine > 0u ? mine : 1u; nx = cnt > 0u ? cnt : 1u;
}
__device__ __forceinline__ void xcd_barrier(const XcdBarrier& b) {
    asm volatile("s_waitcnt vmcnt(0)" ::: "memory");
    __syncthreads();
    if (threadIdx.x == 0) {
        unsigned* bar = b.bar;
        __builtin_amdgcn_s_waitcnt(0);
        unsigned nloc = b.st[0], nx = b.st[1];
        if (nloc == 0u) { xcd_barrier_complete(bar, b.x, nloc, nx); b.st[0] = nloc; b.st[1] = nx; }
        const unsigned old = xb_add(&bar[XB_XSUB(b.x)], 1u);
        const unsigned gen = old / nloc;
        if (old + 1u == (gen + 1u) * nloc) {
            __builtin_amdgcn_fence(__ATOMIC_RELEASE, "agent");
            asm volatile("s_waitcnt vmcnt(0)" ::: "memory");
            const unsigned og = xb_add(&bar[XB_TOP], 1u);
            const unsigned tg = og / nx;
            if (og + 1u == (tg + 1u) * nx) xb_add(&bar[XB_TOPGEN], 1u);
            else XB_SPIN(xb_ld(&bar[XB_TOPGEN]) == tg, bar);
            __builtin_amdgcn_fence(__ATOMIC_ACQUIRE, "agent");
            xb_add(&bar[XB_XGEN(b.x)], 1u);
            asm volatile("s_waitcnt vmcnt(0)" ::: "memory");
        } else {
            XB_SPIN(xb_ld(&bar[XB_XGEN(b.x)]) == gen, bar);
            __builtin_amdgcn_fence(__ATOMIC_ACQUIRE, "agent");
            asm volatile("s_waitcnt vmcnt(0)" ::: "memory");
        }
    }
    __syncthreads();
}

constexpr int MISC_OFF_UNUSED = 0;
__global__ void __launch_bounds__(512, 2) mk_fwd(Params p) {
    extern __shared__ __attribute__((aligned(16))) unsigned char lds[];
    volatile LAS unsigned* MISC = (volatile LAS unsigned*)((LAS unsigned char*)lds + MISC_OFF);
    if (threadIdx.x < 256) MISC[threadIdx.x] = 0u;
    __syncthreads();
    XcdBarrier bar = xcd_barrier_post((unsigned*)(p.ws + WS_CTL) + CW_BAR, MISC + 8);
#ifndef REPEAT_PHASE
#define REPEAT_PHASE -1
#endif
#define PHASE(k, call) { call; xcd_barrier(bar); if ((k) == REPEAT_PHASE) { call; xcd_barrier(bar); call; xcd_barrier(bar); } }
    PHASE(0, phase0(p, lds))
    PHASE(1, phase1(p, lds))
    PHASE(2, phase2(p, lds))
    PHASE(4, phase4(p, lds))
    PHASE(5, phase5(p))
    PHASE(6, phase6(p, lds); phase7(p, lds))
    PHASE(8, phase8(p, lds))
    PHASE(9, phase9(p, lds))
    PHASE(10, phase10(p, lds))
    PHASE(11, phase11(p, lds))
    phase12(p);
}

extern "C" void kernel_launch(void* const* d_in, const int* in_sizes, int n_in, void* d_out, int out_size, void* d_ws, size_t ws_size, hipStream_t stream) {
    static int grid = 0;
    if (grid == 0) {
        if (n_in != 20 || in_sizes[0] != T * D || in_sizes[7] != D * IN_COLS || out_size != T * D || ws_size < WS_END) {
            fprintf(stderr, "kernel_launch: unexpected shapes (n_in %d in0 %d in7 %d out %d ws %zu)\n", n_in, n_in > 0 ? in_sizes[0] : -1, n_in > 7 ? in_sizes[7] : -1, out_size, ws_size); grid = -1; return; }
        int dev = 0, cus = 0;
        if (hipGetDevice(&dev) != hipSuccess || hipDeviceGetAttribute(&cus, hipDeviceAttributeMultiprocessorCount, dev) != hipSuccess) { grid = -1; return; }
        if (hipFuncSetAttribute((const void*)mk_fwd, hipFuncAttributeMaxDynamicSharedMemorySize, LDS_BYTES) != hipSuccess) { grid = -1; return; }
        grid = cus;
    }
    if (grid < 0) return;
    (void)hipMemsetAsync((char*)d_ws + WS_CTL, 0, CTL_BYTES, stream);
    Params a{};
    for (int i = 0; i < 20; ++i) a.in[i] = (const float*)d_in[i];
    a.out = (float*)d_out; a.ws = (unsigned char*)d_ws;
    hipLaunchKernelGGL(mk_fwd, dim3(grid), dim3(512), LDS_BYTES, stream, a);
}
```

```cpp
#include <hip/hip_runtime.h>
#include <cstdint>
#include <cstdio>

typedef unsigned short bf16;
typedef unsigned v4u __attribute__((ext_vector_type(4)));
typedef float f32x4 __attribute__((ext_vector_type(4)));

constexpr int D = 1024, NB = 4, SEQ = 8192, T = NB * SEQ, CTXL = 256, TC = NB * CTXL, TT = T + TC;
constexpr int IN_COLS = 2080, OFF_A = 1536, OFF_P = 1568;
constexpr int NPROJ = 2048;
constexpr int PQ = 0, PK = 256, PV = 512, PG = 1024, PP = 1536;
constexpr int NSI = 36;
constexpr int NE = 32, DE = 256;
constexpr float EPS = 1e-6f;

constexpr size_t MiB = 1u << 20;
constexpr size_t WS_CTL = 0, CTL_BYTES = 65536;
constexpr size_t WS_MOD = 1 * MiB;
constexpr size_t WS_WIN = 2 * MiB;
constexpr size_t WS_WA = 6 * MiB;
constexpr size_t WS_WOUT = 7 * MiB;
constexpr size_t WS_WPOOL = 9 * MiB;
constexpr size_t WS_WR = 10 * MiB;
constexpr size_t WS_DEC = 11 * MiB;
constexpr size_t WS_LIST = 502 * MiB;
constexpr size_t WS_WE1 = 18 * MiB;
constexpr size_t WS_WE2 = 50 * MiB;
constexpr size_t WS_H = 66 * MiB;
constexpr size_t WS_ALOW = 132 * MiB;
constexpr size_t WS_PROJ = 138 * MiB;
constexpr size_t WS_DST = 270 * MiB;
constexpr size_t WS_XMID = 270 * MiB;
constexpr size_t WS_OUTP = 438 * MiB;
constexpr size_t WS_SPREV = 306 * MiB;
constexpr size_t WS_MIX = 338 * MiB;
constexpr size_t WS_HID = 402 * MiB;
constexpr size_t WS_END = 510 * MiB;
constexpr int CW_CNT = 1024;
constexpr int CW_BAR = 4096;

constexpr int LDS_BYTES = 147456;
constexpr int MISC_OFF = LDS_BYTES - 1024;
constexpr int NPHASE = 12;

struct Params { const float* in[20]; float* out; unsigned char* ws; int ph_lo, ph_hi; };

__device__ __forceinline__ float bf2f(unsigned b) { return __uint_as_float(b << 16); }
typedef float f32x2_t __attribute__((ext_vector_type(2)));
typedef __bf16 bf16x2_t __attribute__((ext_vector_type(2)));
__device__ __forceinline__ unsigned pk2(float lo, float hi) { const f32x2_t v = {lo, hi}; return __builtin_bit_cast(unsigned, __builtin_convertvector(v, bf16x2_t)); }
__device__ __forceinline__ unsigned f2bf(float f) { return pk2(f, 0.f) & 0xffffu; }
__device__ __forceinline__ float frcp(float x) { return __builtin_amdgcn_rcpf(x); }
__device__ __forceinline__ float frsq(float x) { return __builtin_amdgcn_rsqf(x); }
template <int CTRL> __device__ __forceinline__ float dppf(float v) { return __int_as_float(__builtin_amdgcn_update_dpp(0, __float_as_int(v), CTRL, 0xf, 0xf, false)); }
__device__ __forceinline__ float wave_sum(float v) {
    v += dppf<0xB1>(v);
    v += dppf<0x4E>(v);
    v += dppf<0x141>(v);
    v += dppf<0x140>(v);
    const int iv = __float_as_int(v);
    return (__int_as_float(__builtin_amdgcn_readlane(iv, 0)) + __int_as_float(__builtin_amdgcn_readlane(iv, 16))) + (__int_as_float(__builtin_amdgcn_readlane(iv, 32)) + __int_as_float(__builtin_amdgcn_readlane(iv, 48)));
}
__device__ __forceinline__ int ltid() { int t = threadIdx.x; asm volatile("" : "+v"(t)); return t; }
__device__ __forceinline__ float silu(float s) { return s * frcp(1.f + __expf(-s)); }
struct TDesc { const float* W; int ldw; bf16* WT; int ldt; };
__device__ __forceinline__ void titem_load(const TDesc& d, float (&tv)[32], int lane) {
#pragma unroll
    for (int i = 0; i < 32; ++i) tv[i] = d.W[(size_t)(2 * i + (lane >> 5)) * d.ldw + (lane & 31)];
}
__device__ __forceinline__ void titem_store(const TDesc& d, const float (&tv)[32], float* scr, int lane) {
#pragma unroll
    for (int i = 0; i < 32; ++i) scr[(2 * i + (lane >> 5)) * 33 + (lane & 31)] = tv[i];
    asm volatile("s_waitcnt lgkmcnt(0)" ::: "memory");
    const int c = lane & 7;
#pragma unroll
    for (int j = 0; j < 4; ++j) { const int n = (lane >> 3) + 8 * j; const float* s = scr + (8 * c) * 33 + n;
        v4u o; o.x = pk2(s[0 * 33], s[1 * 33]); o.y = pk2(s[2 * 33], s[3 * 33]); o.z = pk2(s[4 * 33], s[5 * 33]); o.w = pk2(s[6 * 33], s[7 * 33]);
        *(v4u*)(d.WT + (size_t)n * d.ldt + 8 * c) = o; }
    asm volatile("s_waitcnt lgkmcnt(0)" ::: "memory");
}
__device__ __forceinline__ TDesc tdesc(const float* W, int ldw, int nblk, bf16* WT, int ldt, int item) {
    const int kb = item / nblk, nb = item - kb * nblk, k0 = 64 * kb, n0 = 32 * nb;
    return TDesc{W + (size_t)k0 * ldw + n0, ldw, WT + (size_t)n0 * ldt + k0, ldt};
}


namespace pg8 {
#define PG8_LAS __attribute__((address_space(3)))
typedef short bf16x8 __attribute__((ext_vector_type(8)));
typedef unsigned u32x4 __attribute__((ext_vector_type(4)));
constexpr int BM = 256, BK = 64, HALF = 128, HTB = HALF * BK * 2, STAGE_BYTES = 8 * HTB, NXCD = 8, WGM = 8;
__device__ __forceinline__ int lds_byte(int r, int c) { const int st = (r >> 4) * 2 + (c >> 5), rr = r & 15, cc = c & 31, ob = rr * 64 + cc * 2; return st * 1024 + (ob ^ (((ob >> 9) & 1) << 5)); }
__device__ __forceinline__ void stage_rc(int b, int& R, int& C) { const int st = b / 1024, sb = b % 1024, swz = sb ^ (((sb >> 9) & 1) << 5); R = (st >> 1) * 16 + swz / 64; C = (st & 1) * 32 + (swz % 64) / 2; }
__device__ __forceinline__ int perm32(int rho) { const int n = rho >> 4, i = rho & 15; return 8 * (i >> 2) + 4 * n + (i & 3); }
__device__ __forceinline__ unsigned cvt_pk_bf16(float lo, float hi) { return pk2(lo, hi); }

struct Unit { int pm, pn, e, ti; };

struct SchedDense {
    int nM, nN, nwg, G, c, K; const bf16* Bt;
    __device__ __forceinline__ void init(int M, int N, int K_, const bf16* Bt_, int G_, int c_) { nM = M / BM; nN = N / BM; nwg = nM * nN; G = G_; c = c_; K = K_; Bt = Bt_; }
    __device__ __forceinline__ bool next(int i, Unit& u) const {
        const long L = (long)i * G + c; if (L >= nwg) return false;
        int wgid = (int)L; { const int q = nwg / NXCD, r = nwg % NXCD, xcd = wgid % NXCD, off = wgid / NXCD; wgid = (xcd < r ? xcd * (q + 1) : r * (q + 1) + (xcd - r) * q) + off; }
        const int nig = WGM * nN, gid = wgid / nig, fm = gid * WGM, gsz = (nM - fm) < WGM ? (nM - fm) : WGM;
        u.pm = fm + ((wgid % nig) % gsz); u.pn = (wgid % nig) / gsz; u.e = 0; u.ti = 0; return true;
    }
    __device__ __forceinline__ unsigned arow(const Unit& u, int r) const { return (unsigned)(u.pm * BM + r) * (unsigned)(K * 2); }
    __device__ __forceinline__ const char* bbase(const Unit& u) const { return (const char*)Bt + (size_t)u.pn * BM * K * 2; }
};

template <class Epi, class Sched, bool ALIGN_EPI>
__device__ __forceinline__ void gemm_phase(PG8_LAS unsigned char* lds, const bf16* Aptr, const int K, const Sched& S, const Epi& E) {
    const int tid = ltid(), wid = __builtin_amdgcn_readfirstlane(tid >> 6), lane = tid & 63, wr = wid >> 2, wc = wid & 3, fr = lane & 15, fq = lane >> 4;
    const int nt = K / BK;
    const char* Abase = (const char*)Aptr;
    int sR[2]; unsigned sC[2]; unsigned voffB[2];
#pragma unroll
    for (int i = 0; i < 2; ++i) { int R, C; stage_rc(tid * 16 + i * 8192, R, C); const int Rb = Epi::PERM ? ((R & ~31) + perm32(R & 31)) : R;
        sR[i] = R; sC[i] = (unsigned)C * 2u; voffB[i] = (unsigned)(Rb * K + C) * 2u; }
    const unsigned kstep = (unsigned)(BK * 2);
    const size_t hstep = (size_t)HALF * K * 2;
    const unsigned ldsw = (unsigned)wid * 1024u;
    const int aoff = lds_byte(wr * 64 + fr, fq * 8), boff = lds_byte(wc * 32 + fr, fq * 8);
#define PG8_SA(b, h) (((b) * 2 + (h)) * HTB)
#define PG8_SB(b, h) ((4 + (b) * 2 + (h)) * HTB)
#define PG8_STAGE(bufoff, gbase, voff) do { _Pragma("unroll") for (int _i = 0; _i < 2; ++_i) \
        __builtin_amdgcn_global_load_lds((const unsigned*)((const char*)(gbase) + (voff)[_i]), (PG8_LAS unsigned*)(lds + (bufoff) + ldsw + _i * 8192), 16, 0, 0); } while (0)
#define PG8_STAGE_A(bufoff, AO, h, kb) do { _Pragma("unroll") for (int _i = 0; _i < 2; ++_i) \
        __builtin_amdgcn_global_load_lds((const unsigned*)(Abase + (AO)[h][_i] + (kb)), (PG8_LAS unsigned*)(lds + (bufoff) + ldsw + _i * 8192), 16, 0, 0); } while (0)
#define PG8_LDA(dst, b, h) do { _Pragma("unroll") for (int m = 0; m < 4; ++m) _Pragma("unroll") for (int k = 0; k < 2; ++k) dst[m][k] = *(const PG8_LAS bf16x8*)(lds + PG8_SA(b, h) + aoff + m * 2048 + k * 1024); } while (0)
#define PG8_LDB(dst, b, h) do { _Pragma("unroll") for (int n = 0; n < 2; ++n) _Pragma("unroll") for (int k = 0; k < 2; ++k) dst[n][k] = *(const PG8_LAS bf16x8*)(lds + PG8_SB(b, h) + boff + n * 2048 + k * 1024); } while (0)
#define PG8_MMA(ai, bj, At, Bt) do { __builtin_amdgcn_s_setprio(1); _Pragma("unroll") for (int m = 0; m < 4; ++m) _Pragma("unroll") for (int n = 0; n < 2; ++n) _Pragma("unroll") for (int k = 0; k < 2; ++k) \
        acc[ai][bj][m][n] = __builtin_amdgcn_mfma_f32_16x16x32_bf16(Bt[n][k], At[m][k], acc[ai][bj][m][n], 0, 0, 0); __builtin_amdgcn_s_setprio(0); } while (0)
#define PG8_WAIT_V(n) asm volatile("s_waitcnt vmcnt(" #n ")" ::: "memory")
#define PG8_WAIT_L(n) asm volatile("s_waitcnt lgkmcnt(" #n ")" ::: "memory")
#define PG8_BAR __builtin_amdgcn_s_barrier()
#define PG8_SCHED __builtin_amdgcn_sched_barrier(0)
#define PG8_AOFFS(dst, u) do { _Pragma("unroll") for (int _h = 0; _h < 2; ++_h) _Pragma("unroll") for (int _i = 0; _i < 2; ++_i) dst[_h][_i] = S.arow(u, _h * HALF + sR[_i]) + sC[_i]; } while (0)
    Unit cur, nxt; int ui = 0;
    if (!S.next(0, cur)) return;
    E.prefetch(cur, wr, fr);
    f32x4 acc[2][2][4][2];
#pragma unroll
    for (int a = 0; a < 2; ++a)
#pragma unroll
        for (int b = 0; b < 2; ++b)
#pragma unroll
            for (int m = 0; m < 4; ++m)
#pragma unroll
                for (int n = 0; n < 2; ++n) acc[a][b][m][n] = (f32x4){0.f, 0.f, 0.f, 0.f};
    bf16x8 At[4][2], B0[2][2], B1[2][2];
    unsigned cAo[2][2], nAo[2][2];
    PG8_AOFFS(cAo, cur);
    const char* cB = S.bbase(cur);
    PG8_STAGE(PG8_SB(0, 0), cB, voffB); PG8_STAGE(PG8_SB(0, 1), cB + hstep, voffB); PG8_STAGE_A(PG8_SA(0, 0), cAo, 0, 0u); PG8_STAGE_A(PG8_SA(0, 1), cAo, 1, 0u);
    if (wr == 1) PG8_BAR;
    PG8_WAIT_V(2); PG8_BAR;
    PG8_STAGE(PG8_SB(1, 0), cB + kstep, voffB); PG8_STAGE_A(PG8_SA(1, 0), cAo, 0, kstep); PG8_STAGE(PG8_SB(1, 1), cB + hstep + kstep, voffB);
    PG8_WAIT_V(6); PG8_BAR;
    for (;;) {
        const bool has_next = S.next(ui + 1, nxt);
        const char* nB = cB;
        if (has_next) { PG8_AOFFS(nAo, nxt); nB = S.bbase(nxt); }
        else {
#pragma unroll
            for (int _h = 0; _h < 2; ++_h)
#pragma unroll
                for (int _i = 0; _i < 2; ++_i) nAo[_h][_i] = cAo[_h][_i];
        }
#pragma unroll 1
        for (int t = 0; t < nt; t += 2) {
            const bool last = (t == nt - 2);
            const unsigned k1 = (unsigned)(t + 1) * kstep, k2 = last ? 0u : (unsigned)(t + 2) * kstep, k3 = k2 + kstep;
            unsigned xAo[2][2];
#pragma unroll
            for (int _h = 0; _h < 2; ++_h)
#pragma unroll
                for (int _i = 0; _i < 2; ++_i) xAo[_h][_i] = last ? nAo[_h][_i] : cAo[_h][_i];
            const char* b2 = last ? nB : cB + (size_t)(t + 2) * kstep; const char* b3 = b2 + kstep;
            PG8_LDB(B0, 0, 0); PG8_LDB(B1, 0, 1); PG8_SCHED; PG8_LDA(At, 0, 0); PG8_STAGE_A(PG8_SA(1, 1), cAo, 1, k1);
            PG8_WAIT_V(8); PG8_WAIT_L(0); PG8_BAR; PG8_MMA(0, 0, At, B0); PG8_MMA(0, 1, At, B1); PG8_BAR; PG8_SCHED;
            PG8_LDA(At, 0, 1); PG8_STAGE(PG8_SB(0, 0), b2, voffB); PG8_STAGE(PG8_SB(0, 1), b2 + hstep, voffB); PG8_STAGE_A(PG8_SA(0, 0), xAo, 0, k2);
            PG8_WAIT_V(8); PG8_WAIT_L(0); PG8_BAR; PG8_MMA(1, 0, At, B0); PG8_MMA(1, 1, At, B1); PG8_BAR; PG8_SCHED;
            PG8_LDB(B0, 1, 0); PG8_LDB(B1, 1, 1); PG8_SCHED; PG8_LDA(At, 1, 0); PG8_STAGE_A(PG8_SA(0, 1), xAo, 1, k2);
            PG8_WAIT_V(8); PG8_WAIT_L(0); PG8_BAR; PG8_MMA(0, 0, At, B0); PG8_MMA(0, 1, At, B1); PG8_BAR; PG8_SCHED;
            PG8_LDA(At, 1, 1); PG8_STAGE(PG8_SB(1, 0), b3, voffB); PG8_STAGE(PG8_SB(1, 1), b3 + hstep, voffB); PG8_STAGE_A(PG8_SA(1, 0), xAo, 0, k3);
            PG8_WAIT_V(8); PG8_WAIT_L(0); PG8_BAR; PG8_MMA(1, 0, At, B0); PG8_MMA(1, 1, At, B1); PG8_BAR; PG8_SCHED;
        }
        if constexpr (ALIGN_EPI) { if (wr == 0) PG8_BAR; }
        E(acc, cur, wr, wc, fr, fq);
        if (!has_next) break;
        E.prefetch(nxt, wr, fr);
#pragma unroll
        for (int a = 0; a < 2; ++a)
#pragma unroll
            for (int b = 0; b < 2; ++b)
#pragma unroll
                for (int m = 0; m < 4; ++m)
#pragma unroll
                    for (int n = 0; n < 2; ++n) acc[a][b][m][n] = (f32x4){0.f, 0.f, 0.f, 0.f};
        cur = nxt; cB = nB; ++ui;
#pragma unroll
        for (int _h = 0; _h < 2; ++_h)
#pragma unroll
            for (int _i = 0; _i < 2; ++_i) cAo[_h][_i] = nAo[_h][_i];
        if constexpr (ALIGN_EPI) { if (wr == 1) PG8_BAR; }
    }
    PG8_WAIT_V(0);
    if constexpr (!ALIGN_EPI) { if (wr == 0) PG8_BAR; }
    PG8_BAR;
#undef PG8_SA
#undef PG8_SB
#undef PG8_STAGE
#undef PG8_STAGE_A
#undef PG8_LDA
#undef PG8_LDB
#undef PG8_MMA
#undef PG8_WAIT_V
#undef PG8_WAIT_L
#undef PG8_BAR
#undef PG8_SCHED
#undef PG8_AOFFS
}

struct EpiProj {
    static constexpr bool PERM = true;
    __device__ __forceinline__ void prefetch(const Unit&, int, int) const {}
    __device__ __forceinline__ void rotate() const {}
    bf16* O; int ldc;
    __device__ __forceinline__ void operator()(const f32x4 (&acc)[2][2][4][2], const Unit& u, int wr, int wc, int fr, int fq) const {
        const int row0 = u.pm * BM + wr * 64 + fr, col0 = u.pn * BM + wc * 32 + 8 * fq;
#pragma unroll
        for (int ai = 0; ai < 2; ++ai)
#pragma unroll
            for (int m = 0; m < 4; ++m) { bf16* rowp = O + (size_t)(row0 + ai * HALF + m * 16) * ldc + col0;
#pragma unroll
                for (int bj = 0; bj < 2; ++bj) { const f32x4 v0 = acc[ai][bj][m][0], v1 = acc[ai][bj][m][1];
                    u32x4 w; w.x = cvt_pk_bf16(v0[0], v0[1]); w.y = cvt_pk_bf16(v0[2], v0[3]); w.z = cvt_pk_bf16(v1[0], v1[1]); w.w = cvt_pk_bf16(v1[2], v1[3]);
                    *(u32x4*)(rowp + bj * HALF) = w; } }
    }
};
struct EpiOut {
    static constexpr bool PERM = true;
    __device__ __forceinline__ void prefetch(const Unit&, int, int) const {}
    __device__ __forceinline__ void rotate() const {}
    bf16* xm; const float* MOD;
    __device__ __forceinline__ void operator()(const f32x4 (&acc)[2][2][4][2], const Unit& u, int wr, int wc, int fr, int fq) const {
        const int row0 = u.pm * BM + wr * 64 + fr, col0 = u.pn * BM + wc * 32 + 8 * fq;
        const float* gt = MOD + ((u.pm * BM) >> 13) * 6144 + 2048 + col0;
        f32x4 gv[2][2];
#pragma unroll
        for (int bj = 0; bj < 2; ++bj)
#pragma unroll
            for (int n = 0; n < 2; ++n) gv[bj][n] = *(const f32x4*)(gt + bj * HALF + n * 4);
#pragma unroll
        for (int ai = 0; ai < 2; ++ai)
#pragma unroll
            for (int m = 0; m < 4; ++m) { const size_t off = (size_t)(row0 + ai * HALF + m * 16) * 1024 + col0;
#pragma unroll
                for (int bj = 0; bj < 2; ++bj) {
                    const f32x4 v0 = gv[bj][0] * acc[ai][bj][m][0], v1 = gv[bj][1] * acc[ai][bj][m][1];
                    u32x4 w; w.x = cvt_pk_bf16(v0[0], v0[1]); w.y = cvt_pk_bf16(v0[2], v0[3]); w.z = cvt_pk_bf16(v1[0], v1[1]); w.w = cvt_pk_bf16(v1[2], v1[3]);
                    *(u32x4*)(xm + off + bj * HALF) = w; } }
    }
};

struct SchedMoE1 {
    const PG8_LAS int* tp; const PG8_LAS int* cnt; const int* LIST; const bf16* W; int G, c;
    __device__ __forceinline__ bool next(int i, Unit& u) const {
        const int NU = 2 * tp[32]; int L;
        if (G % 8 == 0) { const int per = (NU + 7) >> 3, x = c & 7; L = x * per + (c >> 3) + (G >> 3) * i; if (L >= min((x + 1) * per, NU)) return false; }
        else { L = i * G + c; if (L >= NU) return false; }
        const int rt = L >> 1; const int e = ((const PG8_LAS unsigned char*)(tp + 96))[rt];
        u.pm = rt; u.pn = L & 1; u.e = e; u.ti = rt - tp[e]; return true;
    }
    __device__ __forceinline__ unsigned arow(const Unit& u, int r) const { const int i = u.ti * 256 + r, ii = i < cnt[u.e] ? i : 0; return (unsigned)(LIST[2 * (u.e * T + ii)] >> 1) * 2048u; }
    __device__ __forceinline__ const char* bbase(const Unit& u) const { return (const char*)(W + ((size_t)u.e * 512 + u.pn * 256) * 1024); }
};
struct EpiSwiglu {
    static constexpr bool PERM = true;
    __device__ __forceinline__ void prefetch(const Unit&, int, int) const {}
    __device__ __forceinline__ void rotate() const {}
    bf16* HID;
    __device__ __forceinline__ void operator()(const f32x4 (&acc)[2][2][4][2], const Unit& u, int wr, int wc, int fr, int fq) const {
#pragma unroll
        for (int ai = 0; ai < 2; ++ai)
#pragma unroll
            for (int m = 0; m < 4; ++m) {
                float h[8];
#pragma unroll
                for (int n = 0; n < 2; ++n)
#pragma unroll
                    for (int q = 0; q < 4; ++q) { const float a = acc[ai][0][m][n][q], uu = acc[ai][1][m][n][q]; h[n * 4 + q] = a * frcp(1.f + __expf(-a)) * uu; }
                u32x4 w; w.x = cvt_pk_bf16(h[0], h[1]); w.y = cvt_pk_bf16(h[2], h[3]); w.z = cvt_pk_bf16(h[4], h[5]); w.w = cvt_pk_bf16(h[6], h[7]);
                *(u32x4*)(HID + (size_t)(u.pm * BM + ai * HALF + wr * 64 + m * 16 + fr) * 256 + u.pn * 128 + wc * 32 + 8 * fq) = w;
            }
    }
};
struct SchedMoE2 {
    const PG8_LAS int* tp; const bf16* W; int G, c;
    __device__ __forceinline__ bool next(int i, Unit& u) const {
        const int NU = 4 * tp[32]; int L;
        if (G % 8 == 0) { const int per = (NU + 7) >> 3, x = c & 7; L = x * per + (c >> 3) + (G >> 3) * i; if (L >= min((x + 1) * per, NU)) return false; }
        else { L = i * G + c; if (L >= NU) return false; }
        const int rt = L >> 2; const int e = ((const PG8_LAS unsigned char*)(tp + 96))[rt];
        u.pm = rt; u.pn = L & 3; u.e = e; u.ti = rt - tp[e]; return true;
    }
    __device__ __forceinline__ unsigned arow(const Unit& u, int r) const { return (unsigned)(u.pm * BM + r) * 512u; }
    __device__ __forceinline__ const char* bbase(const Unit& u) const { return (const char*)(W + ((size_t)u.e * 1024 + u.pn * 256) * 256); }
};
struct EpiScatter {
    static constexpr bool PERM = true;
    bf16* Y; const PG8_LAS int* cnt; const int* LIST;
    typedef int i32x2 __attribute__((ext_vector_type(2)));
    mutable i32x2 cu[8];
    __device__ __forceinline__ void prefetch(const Unit& u, int wr, int fr) const {
        const int ce = cnt[u.e];
#pragma unroll
        for (int q = 0; q < 8; ++q) { const int i = u.ti * 256 + (q >> 2) * HALF + wr * 64 + (q & 3) * 16 + fr;
            cu[q] = *(const i32x2*)(LIST + 2 * (size_t)(u.e * T + (i < ce ? i : 0))); if (i >= ce) cu[q].x = -1; }
    }
    __device__ __forceinline__ void rotate() const {}
    __device__ __forceinline__ void operator()(const f32x4 (&acc)[2][2][4][2], const Unit& u, int wr, int wc, int fr, int fq) const {
#pragma unroll
        for (int ai = 0; ai < 2; ++ai)
#pragma unroll
            for (int m = 0; m < 4; ++m) {
                const int tok2 = cu[ai * 4 + m].x; const float r = __int_as_float(cu[ai * 4 + m].y);
                if (tok2 >= 0) {
                    bf16* rowp = Y + (size_t)tok2 * 1024 + u.pn * BM + wc * 32 + 8 * fq;
#pragma unroll
                    for (int bj = 0; bj < 2; ++bj) { const f32x4 v0 = acc[ai][bj][m][0] * r, v1 = acc[ai][bj][m][1] * r;
                        u32x4 w; w.x = cvt_pk_bf16(v0[0], v0[1]); w.y = cvt_pk_bf16(v0[2], v0[3]); w.z = cvt_pk_bf16(v1[0], v1[1]); w.w = cvt_pk_bf16(v1[2], v1[3]);
                        *(u32x4*)(rowp + bj * HALF) = w; }
                }
            }
    }
};
}


namespace gla {
typedef short bf16x8 __attribute__((ext_vector_type(8)));
typedef float f32x16 __attribute__((ext_vector_type(16)));
typedef __attribute__((address_space(3))) unsigned char lds_t;
typedef __attribute__((address_space(3))) float lf;
typedef __attribute__((address_space(3))) unsigned short lus;
typedef __attribute__((address_space(3))) v4u lv4;
constexpr int LS = 144;
constexpr int O_VT = 0;
constexpr int O_QB = 18432;
constexpr int O_KB = 27648;
constexpr int O_KT = 36864;
constexpr int O_P = 46080;
constexpr int O_OUT = O_QB, OUT_LD = 132;
constexpr int O_ST = 55296;
constexpr int O_DEC = 73728;
constexpr int O_CS = 74240, O_CSB = 76288;
constexpr int O_ALS = 78336;
constexpr int O_RK = 86528, O_RQ = 95744;
constexpr int O_RV = 104960, RVS = 272;
static_assert(64 * OUT_LD * 4 <= 4 * 9216 && O_RV + 64 * RVS <= MISC_OFF, "gla LDS map");

__device__ __forceinline__ unsigned bfr(float f) { return f2bf(f); }

__device__ __forceinline__ f32x16 mm_tile(const lds_t* A, const lds_t* B, f32x16 acc, int lane) {
    const int off = (lane & 31) * LS + (lane >> 5) * 16;
#pragma unroll
    for (int s = 0; s < 4; ++s) {
        const bf16x8 a = *(const __attribute__((address_space(3))) bf16x8*)(A + off + s * 32);
        const bf16x8 b = *(const __attribute__((address_space(3))) bf16x8*)(B + off + s * 32);
        acc = __builtin_amdgcn_mfma_f32_32x32x16_bf16(a, b, acc, 0, 0, 0);
    }
    return acc;
}

struct Raw { v4u k, q, v0, v1; f32x4 al; };
template <bool NEEDQ, bool BOTH>
__device__ __forceinline__ void raw_load(Raw& R, const bf16* PROJ, const float* ALOW, int r0, int h, int dir, int tid) {
    const size_t row = (size_t)(r0 + (tid >> 3));
    R.k = *(const v4u*)(PROJ + row * NPROJ + PK + h * 64 + (tid & 7) * 8);
    if (NEEDQ) R.q = *(const v4u*)(PROJ + row * NPROJ + PQ + h * 64 + (tid & 7) * 8);
    R.v0 = *(const v4u*)(PROJ + row * NPROJ + PV + h * 128 + (tid & 7) * 16);
    R.v1 = *(const v4u*)(PROJ + row * NPROJ + PV + h * 128 + (tid & 7) * 16 + 8);
    if (BOTH) R.al = *(const f32x4*)(ALOW + row * 32 + (tid & 7) * 4);
    else if (tid < 256) R.al = *(const f32x4*)(ALOW + (size_t)(r0 + (tid >> 2)) * 32 + dir * 16 + (tid & 3) * 4);
}
template <bool NEEDQ, bool BOTH>
__device__ __forceinline__ void raw_stage(lds_t* L, const Raw& R, int tid) {
    const int j = tid >> 3, c = tid & 7;
    *(lv4*)(L + O_RK + j * LS + c * 16) = R.k;
    if (NEEDQ) *(lv4*)(L + O_RQ + j * LS + c * 16) = R.q;
    *(lv4*)(L + O_RV + j * RVS + c * 32) = R.v0;
    *(lv4*)(L + O_RV + j * RVS + c * 32 + 16) = R.v1;
    if (BOTH) *(__attribute__((address_space(3))) f32x4*)((lf*)(L + O_ALS) + j * 32 + c * 4) = R.al;
    else if (tid < 256) *(__attribute__((address_space(3))) f32x4*)((lf*)(L + O_ALS) + tid * 4) = R.al;
}
__device__ __forceinline__ void v_transpose(lds_t* L, int tid) {
    const int e = tid & 127, tg = tid >> 7;
    unsigned vr[16];
#pragma unroll
    for (int jj = 0; jj < 16; ++jj) vr[jj] = *(const lus*)(L + O_RV + (16 * tg + jj) * RVS + e * 2);
    v4u w0, w1;
    w0.x = vr[0] | (vr[1] << 16); w0.y = vr[2] | (vr[3] << 16); w0.z = vr[4] | (vr[5] << 16); w0.w = vr[6] | (vr[7] << 16);
    w1.x = vr[8] | (vr[9] << 16); w1.y = vr[10] | (vr[11] << 16); w1.z = vr[12] | (vr[13] << 16); w1.w = vr[14] | (vr[15] << 16);
    *(lv4*)(L + O_VT + e * LS + tg * 32) = w0;
    *(lv4*)(L + O_VT + e * LS + tg * 32 + 16) = w1;
}
template <int ALD>
__device__ __forceinline__ float la_cum(const lds_t* L, int to, int dir, int aoff, const float (&wd)[16], float bd, float (&bl)[8]) {
    const lf* ALS = (const lf*)(L + O_ALS);
    float cum = 0.f;
#pragma unroll
    for (int s2 = 0; s2 < 8; ++s2) {
        const int jj = dir ? 7 - s2 : s2, j = 8 * to + jj;
        float z = bd;
#pragma unroll
        for (int r4 = 0; r4 < 4; ++r4) { const f32x4 a = *(const __attribute__((address_space(3))) f32x4*)(ALS + j * ALD + aoff + r4 * 4);
            z += a.x * wd[r4 * 4] + a.y * wd[r4 * 4 + 1] + a.z * wd[r4 * 4 + 2] + a.w * wd[r4 * 4 + 3]; }
        const float la = (fminf(z, 0.f) - __logf(1.f + __expf(-fabsf(z)))) * (1.f / 16.f);
        cum += la; bl[jj] = cum;
    }
    return cum;
}
__device__ __forceinline__ void cs_combine(const lf* CS, int d, int to, int dir, float& offs, float& tot) {
    offs = 0.f; tot = 0.f;
#pragma unroll
    for (int o = 0; o < 8; ++o) { const float c = CS[o * 64 + d]; tot += c; if (dir ? (o > to) : (o < to)) offs += c; }
}

__device__ __forceinline__ void write_st(lds_t* L, const f32x16& S, int db, int eb, int lane) {
    const int e = 32 * eb + (lane & 31), hh = lane >> 5;
#pragma unroll
    for (int g = 0; g < 4; ++g) {
        const unsigned lo = pk2(S[4 * g], S[4 * g + 1]), hi = pk2(S[4 * g + 2], S[4 * g + 3]);
        *(__attribute__((address_space(3))) unsigned long long*)(L + O_ST + e * LS + (32 * db + 8 * g + 4 * hh) * 2) = (unsigned long long)lo | ((unsigned long long)hi << 32);
    }
}
__device__ __forceinline__ void scale_rows(lds_t* L, f32x16& S, int db, int lane) {
    const int hh = lane >> 5;
#pragma unroll
    for (int g = 0; g < 4; ++g) { const f32x4 dv = *(const __attribute__((address_space(3))) f32x4*)(L + O_DEC + (32 * db + 8 * g + 4 * hh) * 4);
        S[4 * g] *= dv.x; S[4 * g + 1] *= dv.y; S[4 * g + 2] *= dv.z; S[4 * g + 3] *= dv.w; }
}

__device__ __forceinline__ void state_unit(const Params& p, lds_t* L, int b, int si, int h) {
    const int tid = ltid(), lane = tid & 63, w = tid >> 6, hh = lane >> 5, d = lane, to = w;
    const bf16* PROJ = (const bf16*)(p.ws + WS_PROJ); const float* ALOW = (const float*)(p.ws + WS_ALOW);
    float* DST = (float*)(p.ws + WS_DST); float* DEC = (float*)(p.ws + WS_DEC);
    const float* w_dec = p.in[8]; const float* b_dec = p.in[9];
    const int db = w >> 2, eb = w & 3, base = si < 4 ? T + b * CTXL + 64 * si : b * SEQ + (si - 4) * 256, nch = si < 4 ? 1 : 4;
    float wf[16], wb[16];
#pragma unroll
    for (int r = 0; r < 16; ++r) { wf[r] = w_dec[r * 256 + h * 64 + d]; wb[r] = w_dec[4096 + r * 256 + h * 64 + d]; }
    const float bdf = b_dec[h * 64 + d], bdb = b_dec[256 + h * 64 + d];
    f32x16 Sf, Sb;
#pragma unroll
    for (int q = 0; q < 16; ++q) { Sf[q] = 0.f; Sb[q] = 0.f; }
    float pf = 1.f, pb = 1.f;
    Raw R;
    __syncthreads();
    raw_load<false, true>(R, PROJ, ALOW, base, h, 0, tid);
    raw_stage<false, true>(L, R, tid);
    __syncthreads();
#pragma unroll 1
    for (int c = 0; c < nch; ++c) {
        if (c + 1 < nch) raw_load<false, true>(R, PROJ, ALOW, base + 64 * (c + 1), h, 0, tid);
        float blf[8], blb[8];
        const float cf = la_cum<32>(L, to, 0, 0, wf, bdf, blf), cb = la_cum<32>(L, to, 1, 16, wb, bdb, blb);
        ((lf*)(L + O_CS))[to * 64 + d] = cf; ((lf*)(L + O_CSB))[to * 64 + d] = cb;
        __syncthreads();
        float of, tf, ob, tb;
        cs_combine((const lf*)(L + O_CS), d, to, 0, of, tf); cs_combine((const lf*)(L + O_CSB), d, to, 1, ob, tb);
        if (to == 0) ((lf*)(L + O_DEC))[d] = __expf(tf);
        float kf[8], kb[8];
#pragma unroll
        for (int jj = 0; jj < 8; ++jj) {
            const float k = bf2f(*(const lus*)(L + O_RK + (8 * to + jj) * LS + d * 2));
            kf[jj] = k * __expf(tf - (blf[jj] + of));
            kb[jj] = k * __expf(tb - (blb[jj] + ob)) * pb;
        }
        { v4u x; x.x = pk2(kf[0], kf[1]); x.y = pk2(kf[2], kf[3]); x.z = pk2(kf[4], kf[5]); x.w = pk2(kf[6], kf[7]); *(lv4*)(L + O_KT + d * LS + to * 16) = x; }
        { v4u x; x.x = pk2(kb[0], kb[1]); x.y = pk2(kb[2], kb[3]); x.z = pk2(kb[4], kb[5]); x.w = pk2(kb[6], kb[7]); *(lv4*)(L + O_KB + d * LS + to * 16) = x; }
        pf *= __expf(tf); pb *= __expf(tb);
        v_transpose(L, tid);
        __syncthreads();
        scale_rows(L, Sf, db, lane);
        Sf = mm_tile(L + O_KT + 32 * db * LS, L + O_VT + 32 * eb * LS, Sf, lane);
        Sb = mm_tile(L + O_KB + 32 * db * LS, L + O_VT + 32 * eb * LS, Sb, lane);
        if (c + 1 < nch) raw_stage<false, true>(L, R, tid);
        __syncthreads();
    }
    const int uf = ((0 * NB + b) * NSI + si) * 4 + h, ub = ((1 * NB + b) * NSI + si) * 4 + h;
#pragma unroll
    for (int q = 0; q < 16; ++q) { const int dl = (q & 3) + 8 * (q >> 2) + 4 * hh; const size_t o = (size_t)(32 * db + dl) * 128 + 32 * eb + (lane & 31);
        DST[(size_t)uf * 8192 + o] = Sf[q]; DST[(size_t)ub * 8192 + o] = Sb[q]; }
    if (to == 0) { DEC[uf * 64 + d] = pf; DEC[ub * 64 + d] = pb; }
}

template <int DIR>
__device__ __forceinline__ void out_pass(const Params& p, lds_t* L, int b, int sc, int h) {
    const int tid = ltid(), lane = tid & 63, w = tid >> 6, hh = lane >> 5, d = lane, to = w;
    const bf16* PROJ = (const bf16*)(p.ws + WS_PROJ); const float* ALOW = (const float*)(p.ws + WS_ALOW);
    const float* SPREV = (const float*)(p.ws + WS_SPREV); bf16* MIX = (bf16*)(p.ws + WS_MIX); float* OACC = (float*)(p.ws + WS_H);
    const float* w_dec = p.in[8]; const float* b_dec = p.in[9]; const float* gng = p.in[10];
    const int ib = w >> 2, eb = w & 3, base = b * SEQ + sc * 256;
    float wd[16];
#pragma unroll
    for (int r = 0; r < 16; ++r) wd[r] = w_dec[DIR * 4096 + r * 256 + h * 64 + d];
    const float bd = b_dec[DIR * 256 + h * 64 + d];
    const int u = ((DIR * NB + b) * 32 + sc) * 4 + h;
    f32x16 S;
#pragma unroll
    for (int q = 0; q < 16; ++q) { const int dl = (q & 3) + 8 * (q >> 2) + 4 * hh; S[q] = SPREV[(size_t)u * 8192 + (32 * ib + dl) * 128 + 32 * eb + (lane & 31)]; }
    float gnv[16];
    if (DIR == 0) {
#pragma unroll
        for (int q = 0; q < 16; ++q) gnv[q] = gng[(tid & 7) * 16 + q];
    }
    Raw R;
    __syncthreads();
    raw_load<true, false>(R, PROJ, ALOW, base + (DIR ? 192 : 0), h, DIR, tid);
    write_st(L, S, ib, eb, lane);
    raw_stage<true, false>(L, R, tid);
    __syncthreads();
#pragma unroll 1
    for (int cc = 0; cc < 4; ++cc) {
        const int c = DIR ? 3 - cc : cc, r0 = base + 64 * c;
        if (cc < 3) raw_load<true, false>(R, PROJ, ALOW, base + 64 * (DIR ? 2 - cc : cc + 1), h, DIR, tid);
        float* oa = OACC + (size_t)(r0 + 32 * ib + 4 * hh) * 512 + h * 128 + 32 * eb + (lane & 31);
        float ob[16]; v4u g0, g1;
        if (DIR == 0) {
#pragma unroll
            for (int q = 0; q < 16; ++q) ob[q] = oa[(size_t)((q & 3) + 8 * (q >> 2)) * 512];
            const size_t grow = (size_t)(r0 + (tid >> 3));
            g0 = *(const v4u*)(PROJ + grow * NPROJ + PG + h * 128 + (tid & 7) * 16); g1 = *(const v4u*)(PROJ + grow * NPROJ + PG + h * 128 + (tid & 7) * 16 + 8);
        }
        float bl[8];
        const float cum = la_cum<16>(L, to, DIR, 0, wd, bd, bl);
        ((lf*)(L + O_CS))[to * 64 + d] = cum;
        __syncthreads();
        float offs, tot; cs_combine((const lf*)(L + O_CS), d, to, DIR, offs, tot);
        const float dec = __expf(tot);
        if (to == 0) ((lf*)(L + O_DEC))[d] = dec;
        float kt[8];
#pragma unroll
        for (int jj = 0; jj < 8; ++jj) {
            const int j = 8 * to + jj;
            const float bq = bl[jj] + offs, E = __expf(bq), Einv = frcp(E);
            const float kf = bf2f(*(const lus*)(L + O_RK + j * LS + d * 2)) * Einv;
            const unsigned kq = pk2(kf, bf2f(*(const lus*)(L + O_RQ + j * LS + d * 2)) * 0.125f * E);
            *(lus*)(L + O_KB + j * LS + d * 2) = (unsigned short)kq;
            *(lus*)(L + O_QB + j * LS + d * 2) = (unsigned short)(kq >> 16);
            kt[jj] = kf * dec;
        }
        { v4u x; x.x = pk2(kt[0], kt[1]); x.y = pk2(kt[2], kt[3]); x.z = pk2(kt[4], kt[5]); x.w = pk2(kt[6], kt[7]); *(lv4*)(L + O_KT + d * LS + to * 16) = x; }
        v_transpose(L, tid);
        __syncthreads();
        if (w < 4) {
            const int pi = w >> 1, pj = w & 1;
            f32x16 pa;
#pragma unroll
            for (int q = 0; q < 16; ++q) pa[q] = 0.f;
            const bool dead = DIR ? (pj < pi) : (pj > pi);
            if (!dead) pa = mm_tile(L + O_QB + 32 * pi * LS, L + O_KB + 32 * pj * LS, pa, lane);
            const int jl = lane & 31;
#pragma unroll
            for (int q = 0; q < 16; q += 2) {
                const int il = (q & 3) + 8 * (q >> 2) + 4 * hh;
                float v0 = pa[q], v1 = pa[q + 1];
                if (pi == pj) { if (DIR ? (jl < il) : (jl > il)) v0 = 0.f; if (DIR ? (jl < il + 1) : (jl > il + 1)) v1 = 0.f; }
                const unsigned pw = pk2(v0, v1);
                *(lus*)(L + O_P + (32 * pi + il) * LS + (32 * pj + jl) * 2) = (unsigned short)pw;
                *(lus*)(L + O_P + (32 * pi + il + 1) * LS + (32 * pj + jl) * 2) = (unsigned short)(pw >> 16);
            }
        }
        __syncthreads();
        f32x16 o;
#pragma unroll
        for (int q = 0; q < 16; ++q) o[q] = 0.f;
        o = mm_tile(L + O_P + 32 * ib * LS, L + O_VT + 32 * eb * LS, o, lane);
        o = mm_tile(L + O_QB + 32 * ib * LS, L + O_ST + 32 * eb * LS, o, lane);
        scale_rows(L, S, ib, lane);
        S = mm_tile(L + O_KT + 32 * ib * LS, L + O_VT + 32 * eb * LS, S, lane);
        __syncthreads();
        write_st(L, S, ib, eb, lane);
        if (cc < 3) raw_stage<true, false>(L, R, tid);
        if (DIR == 1) {
#pragma unroll
            for (int q = 0; q < 16; ++q) oa[(size_t)((q & 3) + 8 * (q >> 2)) * 512] = o[q];
            __syncthreads();
        } else {
            lf* OUT = (lf*)(L + O_OUT);
#pragma unroll
            for (int q = 0; q < 16; ++q) { const int il = (q & 3) + 8 * (q >> 2) + 4 * hh; OUT[(32 * ib + il) * OUT_LD + 32 * eb + (lane & 31)] = o[q] + ob[q]; }
            __syncthreads();
            const int i = tid >> 3, e0 = (tid & 7) * 16;
            float v[16]; float ss = 0.f;
#pragma unroll
            for (int q4 = 0; q4 < 4; ++q4) { const f32x4 t = *(const __attribute__((address_space(3))) f32x4*)(OUT + i * OUT_LD + e0 + q4 * 4);
                v[q4 * 4] = t.x; v[q4 * 4 + 1] = t.y; v[q4 * 4 + 2] = t.z; v[q4 * 4 + 3] = t.w; ss += t.x * t.x + t.y * t.y + t.z * t.z + t.w * t.w; }
            ss += __shfl_xor(ss, 1); ss += __shfl_xor(ss, 2); ss += __shfl_xor(ss, 4);
            const float r = frsq(ss * (1.f / 128.f) + EPS);
            const size_t row = (size_t)(r0 + i);
            unsigned ow[8];
#pragma unroll
            for (int q = 0; q < 8; ++q) {
                const unsigned gw = q < 4 ? g0[q] : g1[q - 4];
                const float ga = __uint_as_float(gw << 16), gb = __uint_as_float(gw & 0xffff0000u);
                const float ya = v[2 * q] * r * gnv[2 * q] * (ga * frcp(1.f + __expf(-ga))), yb = v[2 * q + 1] * r * gnv[2 * q + 1] * (gb * frcp(1.f + __expf(-gb)));
                ow[q] = pk2(ya, yb);
            }
            v4u o0, o1; o0.x = ow[0]; o0.y = ow[1]; o0.z = ow[2]; o0.w = ow[3]; o1.x = ow[4]; o1.y = ow[5]; o1.z = ow[6]; o1.w = ow[7];
            *(v4u*)(MIX + row * 1024 + h * 128 + e0) = o0; *(v4u*)(MIX + row * 1024 + h * 128 + e0 + 8) = o1;
        }
    }
}
}

namespace pool {
typedef __attribute__((address_space(3))) unsigned char lds_t;
typedef __attribute__((address_space(3))) float lf;
constexpr int V_LD = 132, O_V0 = 0, O_V1 = 33792;
constexpr int PD_LS = 272;
constexpr int O_XG = 67584;
constexpr int O_PD = 102400;
static_assert(O_PD + 128 * PD_LS <= MISC_OFF, "pool LDS map");

template <int GI> struct PX { v4u x[2][(2 << GI) + 1]; };
template <int GI>
__device__ __forceinline__ void gload(PX<GI>& X, const Params& p, int b, int r0) {
    const int tid = ltid(), lane = tid & 63, wv = tid >> 6, co = lane & 15;
    const bf16* PROJ = (const bf16*)(p.ws + WS_PROJ);
    constexpr int w = 2 << GI, lo = w >> 1;
#pragma unroll
    for (int h2 = 0; h2 < 2; ++h2) {
        const int c = 8 * wv + 4 * h2 + (lane >> 4);
        const bf16* src = PROJ + (size_t)(b * SEQ + c) * NPROJ + PP + GI * 128 + 8 * co;
#pragma unroll
        for (int t = 0; t <= w; ++t) { const int r2 = min(max(r0 - lo + t, 0), 127); X.x[h2][t] = *(const v4u*)(src + (size_t)r2 * 64 * NPROJ); }
    }
}
template <int GI, class NX>
__device__ __forceinline__ void group(const Params& p, lds_t* L, int b, int r0, int tok0, PX<GI>& X, NX* nxt) {
    const int tid = ltid(), lane = tid & 63, wv = tid >> 6, hh = lane >> 5;
    const bf16* PROJ = (const bf16*)(p.ws + WS_PROJ); bf16* MIX = (bf16*)(p.ws + WS_MIX); const bf16* WPT = (const bf16*)(p.ws + WS_WPOOL);
    const float* pscale = p.in[12];
    constexpr int gi = GI, w = 2 << GI, lo = w >> 1, hi = w - 1 - lo;
    gla::bf16x8 bfr_[8];
    const int dcol = gi * 128 + 32 * (wv & 3) + (lane & 31);
    { const bf16* Bp = WPT + (size_t)gi * 16384 + (size_t)(32 * (wv & 3) + (lane & 31)) * 128 + hh * 8;
#pragma unroll
      for (int s2 = 0; s2 < 8; ++s2) bfr_[s2] = *(const gla::bf16x8*)(Bp + s2 * 16); }
    const float ps = pscale[dcol];
    {
        const int co = lane & 15;
        v4u (&x)[2][w + 1] = X.x;
#pragma unroll
        for (int h2 = 0; h2 < 2; ++h2) {
            const int c = 8 * wv + 4 * h2 + (lane >> 4);
            float a0[8], a1[8];
#pragma unroll
            for (int q = 0; q < 8; ++q) { a0[q] = 0.f; a1[q] = 0.f; }
#pragma unroll
            for (int t = 0; t <= w; ++t) { const int r2 = r0 - lo + t; const float m = (r2 >= 0 && r2 < 128) ? 1.f : 0.f;
#pragma unroll
                for (int q = 0; q < 4; ++q) { const float xl = m * __uint_as_float(x[h2][t][q] << 16), xh = m * __uint_as_float(x[h2][t][q] & 0xffff0000u);
                    if (t < w) { a0[2 * q] += xl; a0[2 * q + 1] += xh; }
                    if (t > 0) { a1[2 * q] += xl; a1[2 * q + 1] += xh; } } }
            lf* v0 = (lf*)(L + O_V0) + c * V_LD + 8 * co; lf* v1 = (lf*)(L + O_V1) + c * V_LD + 8 * co;
            *(__attribute__((address_space(3))) f32x4*)v0 = (f32x4){a0[0], a0[1], a0[2], a0[3]}; *(__attribute__((address_space(3))) f32x4*)(v0 + 4) = (f32x4){a0[4], a0[5], a0[6], a0[7]};
            *(__attribute__((address_space(3))) f32x4*)v1 = (f32x4){a1[0], a1[1], a1[2], a1[3]}; *(__attribute__((address_space(3))) f32x4*)(v1 + 4) = (f32x4){a1[4], a1[5], a1[6], a1[7]};
            *(__attribute__((address_space(3))) v4u*)(L + O_XG + c * PD_LS + co * 16) = x[h2][lo];
            *(__attribute__((address_space(3))) v4u*)(L + O_XG + (64 + c) * PD_LS + co * 16) = x[h2][lo + 1];
        }
    }
    __syncthreads();
    if constexpr (GI < 3) gload<GI + 1>(*nxt, p, b, r0);
#pragma unroll
    for (int rr = 0; rr < 2; ++rr) {
        const int r = r0 + rr, rs = max(r - lo, 0), re = min(r + hi + 1, 128);
        const int ch = tid & 127, c0 = 16 * (tid >> 7);
        const lf* V = (const lf*)(L + (rr ? O_V1 : O_V0)) + ch;
        const float invr = 1.f / (float)(re - rs);
        float sacc = 0.f;
        for (int c2 = max(c0 - lo, 0); c2 <= min(c0 + hi, 63); ++c2) sacc += V[c2 * V_LD];
#pragma unroll 4
        for (int ci = 0; ci < 16; ++ci) {
            const int c = c0 + ci;
            if (ci > 0) { const int ad = c + hi, rm = c - lo - 1; if (ad < 64) sacc += V[ad * V_LD]; if (rm >= 0) sacc -= V[rm * V_LD]; }
            const int cs = max(c - lo, 0), ce = min(c + hi + 1, 64);
            const float m = sacc * invr / (float)(ce - cs);
            const float x = bf2f(*(const __attribute__((address_space(3))) unsigned short*)(L + O_XG + (64 * rr + c) * PD_LS + ch * 2));
            *(__attribute__((address_space(3))) unsigned short*)(L + O_PD + (64 * rr + c) * PD_LS + ch * 2) = (unsigned short)f2bf(m - x);
        }
    }
    __syncthreads();
    {
        const int tb0 = wv >> 2, nb = wv & 3;
        gla::f32x16 acc0, acc1;
#pragma unroll
        for (int q = 0; q < 16; ++q) { acc0[q] = 0.f; acc1[q] = 0.f; }
        const lds_t* A0 = L + O_PD + (32 * tb0 + (lane & 31)) * PD_LS + hh * 16; const lds_t* A1 = A0 + 64 * PD_LS;
#pragma unroll
        for (int s2 = 0; s2 < 8; ++s2) {
            const gla::bf16x8 bb = bfr_[s2];
            acc0 = __builtin_amdgcn_mfma_f32_32x32x16_bf16(*(const __attribute__((address_space(3))) gla::bf16x8*)(A0 + s2 * 32), bb, acc0, 0, 0, 0);
            acc1 = __builtin_amdgcn_mfma_f32_32x32x16_bf16(*(const __attribute__((address_space(3))) gla::bf16x8*)(A1 + s2 * 32), bb, acc1, 0, 0, 0);
        }
#pragma unroll
        for (int q = 0; q < 16; ++q) { const int tl = (q & 3) + 8 * (q >> 2) + 4 * hh;
            MIX[(size_t)(tok0 + 32 * tb0 + tl) * 1024 + 512 + dcol] = (bf16)f2bf(acc0[q] * ps);
            MIX[(size_t)(tok0 + 64 + 32 * tb0 + tl) * 1024 + 512 + dcol] = (bf16)f2bf(acc1[q] * ps); }
    }
}
__device__ __forceinline__ void unit(const Params& p, lds_t* L, int b, int rp) {
    const int r0 = 2 * rp, tok0 = b * SEQ + r0 * 64;
    PX<0> x0; gload<0>(x0, p, b, r0);
    __syncthreads();
    PX<1> x1; group<0>(p, L, b, r0, tok0, x0, &x1);
    PX<2> x2; group<1>(p, L, b, r0, tok0, x1, &x2);
    PX<3> x3; group<2>(p, L, b, r0, tok0, x2, &x3);
    group<3>(p, L, b, r0, tok0, x3, (PX<3>*)nullptr);
}
}

__device__ __forceinline__ void phase0(const Params& p, unsigned char* lds) {
    const int tid = ltid(), lane = tid & 63, wave = tid >> 6, G = gridDim.x;
    const int gtid = blockIdx.x * 512 + tid, gthreads = G * 512;
    float* MOD = (float*)(p.ws + WS_MOD);
    const float* c = p.in[1]; const float* cctx = p.in[3]; const float* w_ada = p.in[4]; const float* b_ada = p.in[5];
    {
        float* SIL = (float*)lds;
        float* RED = (float*)(lds + 20480);
        for (int i = tid; i < 5 * 1024; i += 512) { const float v = i < 4096 ? c[i] : cctx[i - 4096]; SIL[i] = silu(v); }
        __syncthreads();
        for (int task = blockIdx.x; task < 192; task += G) {
            const int kg = tid >> 5, col = tid & 31;
            float wv[64];
#pragma unroll
            for (int k = 0; k < 64; ++k) wv[k] = w_ada[(size_t)(64 * kg + k) * 6144 + 32 * task + col];
            float a[5] = {0.f, 0.f, 0.f, 0.f, 0.f};
#pragma unroll
            for (int k = 0; k < 64; ++k)
#pragma unroll
                for (int v = 0; v < 5; ++v) a[v] += SIL[v * 1024 + 64 * kg + k] * wv[k];
#pragma unroll
            for (int v = 0; v < 5; ++v) RED[(kg * 5 + v) * 32 + col] = a[v];
            __syncthreads();
            if (tid < 160) { const int v = tid >> 5; float sacc = b_ada[32 * task + col];
#pragma unroll
                for (int g = 0; g < 16; ++g) sacc += RED[(g * 5 + v) * 32 + col];
                MOD[v * 6144 + 32 * task + col] = sacc; }
            __syncthreads();
        }
    }
    const float* w_in = p.in[7];
    bf16* WA = (bf16*)(p.ws + WS_WA);
    for (int idx = gtid; idx < 32 * 1024; idx += gthreads) { const int jj = idx >> 10, k = idx & 1023; WA[idx] = (bf16)f2bf(w_in[(size_t)k * IN_COLS + OFF_A + jj]); }
    const float* w_rg = p.in[15]; const float* w_re = p.in[16];
    bf16* WRH = (bf16*)(p.ws + WS_WR); bf16* WRL = WRH + 48 * 1024;
    for (int idx = gtid; idx < 48 * 1024; idx += gthreads) { const int r = idx >> 10, k = idx & 1023;
        const float v = r < 32 ? w_re[k * 32 + r] : (r < 36 ? w_rg[k * 4 + (r - 32)] : 0.f);
        const unsigned hi = f2bf(v); WRH[idx] = (bf16)hi; WRL[idx] = (bf16)f2bf(v - bf2f(hi)); }
    float* scr = (float*)(lds + wave * 8448);
    const int gw = blockIdx.x * 8 + wave, NGW = G * 8;
    bf16* WIN = (bf16*)(p.ws + WS_WIN); bf16* WOUT = (bf16*)(p.ws + WS_WOUT); bf16* WE1 = (bf16*)(p.ws + WS_WE1); bf16* WE2 = (bf16*)(p.ws + WS_WE2);
    const float* w_out = p.in[13]; const float* w_e_in = p.in[17]; const float* w_e_out = p.in[18];
    constexpr int I_A = 16 * 48, I_P = 16 * 16, I_O = 16 * 32, I_E1 = 32 * 256, I_E2 = 32 * 128, I_W = 32;
    auto desc_of = [&](int it) -> TDesc {
        int r = it;
        if (r >= I_A + I_P + I_O + I_E1 + I_E2) { r -= I_A + I_P + I_O + I_E1 + I_E2; const int g = r >> 3; return tdesc(p.in[11] + g * 16384, 128, 4, (bf16*)(p.ws + WS_WPOOL) + g * 16384, 128, r & 7); }
        if (r < I_A) return tdesc(w_in, IN_COLS, 48, WIN, 1024, r); r -= I_A;
        if (r < I_P) return tdesc(w_in + OFF_P, IN_COLS, 16, WIN + (size_t)1536 * 1024, 1024, r); r -= I_P;
        if (r < I_O) return tdesc(w_out, 1024, 32, WOUT, 1024, r); r -= I_O;
        if (r < I_E1) { const int e = r >> 8, sub = (r >> 6) & 3, item = r & 63, pn = sub >> 1, half = sub & 1;
            return tdesc(w_e_in + (size_t)e * 1024 * 512 + half * 256 + 128 * pn, 512, 4, WE1 + (size_t)e * 512 * 1024 + (size_t)(256 * pn + 128 * half) * 1024, 1024, item); } r -= I_E1;
        { const int e = r >> 7, item = r & 127; return tdesc(w_e_out + (size_t)e * 256 * 1024, 1024, 32, WE2 + (size_t)e * 1024 * 256, 256, item); }
    };
    constexpr int NIT = I_A + I_P + I_O + I_E1 + I_E2 + I_W;
    if (gw < NIT) {
        TDesc d = desc_of(gw); float tv[32]; titem_load(d, tv, lane);
        for (int it = gw; it < NIT; it += NGW) {
            const bool has = it + NGW < NIT;
            TDesc dn = d; float tn[32];
            if (has) { dn = desc_of(it + NGW); titem_load(dn, tn, lane); }
            titem_store(d, tv, scr, lane);
            if (has) { d = dn;
#pragma unroll
                for (int i = 0; i < 32; ++i) tv[i] = tn[i]; }
        }
    }
}

namespace skinny {
typedef __attribute__((address_space(3))) unsigned char lds_t;
typedef short bf16x8 __attribute__((ext_vector_type(8)));
constexpr int TLS = 2064;
constexpr int O_THI = 0, O_TLO = 16 * TLS, O_PART = 2 * 16 * TLS, O_LOG = O_PART + 8 * 16 * 48 * 4, O_RT = O_LOG + 16 * 48 * 4;
template <int NT, bool SPLIT>
__device__ __forceinline__ void mma_part(lds_t* L, const bf16* WH, const bf16* WL, int wv, int lane) {
    const int fr = lane & 15, fq = lane >> 4;
    f32x4 acc[NT];
#pragma unroll
    for (int t = 0; t < NT; ++t) acc[t] = (f32x4){0.f, 0.f, 0.f, 0.f};
#pragma unroll
    for (int s2 = 0; s2 < 4; ++s2) {
        const int k = 128 * wv + 32 * s2 + 8 * fq;
        const bf16x8 ah = *(const __attribute__((address_space(3))) bf16x8*)(L + O_THI + fr * TLS + k * 2);
        bf16x8 al; if (SPLIT) al = *(const __attribute__((address_space(3))) bf16x8*)(L + O_TLO + fr * TLS + k * 2);
#pragma unroll
        for (int t = 0; t < NT; ++t) {
            const bf16x8 bh = *(const bf16x8*)(WH + (size_t)(16 * t + fr) * 1024 + k);
            acc[t] = __builtin_amdgcn_mfma_f32_16x16x32_bf16(ah, bh, acc[t], 0, 0, 0);
            if (SPLIT) { const bf16x8 bl = *(const bf16x8*)(WL + (size_t)(16 * t + fr) * 1024 + k);
                acc[t] = __builtin_amdgcn_mfma_f32_16x16x32_bf16(al, bh, acc[t], 0, 0, 0);
                acc[t] = __builtin_amdgcn_mfma_f32_16x16x32_bf16(ah, bl, acc[t], 0, 0, 0); }
        }
    }
    __attribute__((address_space(3))) float* P = (__attribute__((address_space(3))) float*)(L + O_PART) + wv * 16 * 16 * NT;
#pragma unroll
    for (int t = 0; t < NT; ++t)
#pragma unroll
        for (int q = 0; q < 4; ++q) P[(4 * fq + q) * 16 * NT + 16 * t + fr] = acc[t][q];
}
template <int NT>
__device__ __forceinline__ void load_bfrags(bf16x8 (&bh)[NT][4], const bf16* W, int wv, int lane) {
    const int fr = lane & 15, fq = lane >> 4;
#pragma unroll
    for (int t = 0; t < NT; ++t)
#pragma unroll
        for (int s2 = 0; s2 < 4; ++s2) bh[t][s2] = *(const bf16x8*)(W + (size_t)(16 * t + fr) * 1024 + 128 * wv + 32 * s2 + 8 * fq);
}
template <int NT, bool SPLIT>
__device__ __forceinline__ void mma_part_reg(lds_t* L, const bf16x8 (&bh)[NT][4], int wv, int lane) {
    const int fr = lane & 15, fq = lane >> 4;
    f32x4 acc[NT];
#pragma unroll
    for (int t = 0; t < NT; ++t) acc[t] = (f32x4){0.f, 0.f, 0.f, 0.f};
#pragma unroll
    for (int s2 = 0; s2 < 4; ++s2) {
        const int k = 128 * wv + 32 * s2 + 8 * fq;
        const bf16x8 ah = *(const __attribute__((address_space(3))) bf16x8*)(L + O_THI + fr * TLS + k * 2);
        bf16x8 al; if (SPLIT) al = *(const __attribute__((address_space(3))) bf16x8*)(L + O_TLO + fr * TLS + k * 2);
#pragma unroll
        for (int t = 0; t < NT; ++t) {
            acc[t] = __builtin_amdgcn_mfma_f32_16x16x32_bf16(ah, bh[t][s2], acc[t], 0, 0, 0);
            if (SPLIT) acc[t] = __builtin_amdgcn_mfma_f32_16x16x32_bf16(al, bh[t][s2], acc[t], 0, 0, 0);
        }
    }
    __attribute__((address_space(3))) float* P = (__attribute__((address_space(3))) float*)(L + O_PART) + wv * 16 * 16 * NT;
#pragma unroll
    for (int t = 0; t < NT; ++t)
#pragma unroll
        for (int q = 0; q < 4; ++q) P[(4 * fq + q) * 16 * NT + 16 * t + fr] = acc[t][q];
}
template <int NT>
__device__ __forceinline__ float part_sum(const lds_t* L, int idx) {
    const __attribute__((address_space(3))) float* P = (const __attribute__((address_space(3))) float*)(L + O_PART);
    float s = 0.f;
#pragma unroll
    for (int w = 0; w < 8; ++w) s += P[w * 16 * 16 * NT + idx];
    return s;
}
}

struct P1Iters {
    int G, b;
    __device__ __forceinline__ int count() const { if (G != 256) return (TT / 16 - b + G - 1) / G; return 9; }
    __device__ __forceinline__ int at(int li) const {
        if (G != 256) return b + li * G;
        return li == 0 ? T / 16 + (b >> 2) : b * 8 + (li - 1);
    }
    __device__ __forceinline__ int quarter() const { return G != 256 ? -1 : (b & 3); }
};
__device__ __forceinline__ void phase1(const Params& p, unsigned char* lds) {
    using namespace skinny;
    lds_t* L = (lds_t*)lds;
    const int tid = ltid(), lane = tid & 63, wave = tid >> 6, G = gridDim.x;
    const float* MOD = (const float*)(p.ws + WS_MOD); const bf16* WA = (const bf16*)(p.ws + WS_WA); const bf16* WIN = (const bf16*)(p.ws + WS_WIN);
    bf16* H = (bf16*)(p.ws + WS_H); float* ALOW = (float*)(p.ws + WS_ALOW); bf16* PROJ = (bf16*)(p.ws + WS_PROJ);
    const float* g1 = p.in[6];
    const P1Iters I{G, (int)blockIdx.x};
    const int nit = I.count();
    bf16x8 bw[2][4]; load_bfrags<2>(bw, WA, wave, lane);
    f32x4 nx[2][4], nx2[2][4];
#pragma unroll
    for (int rr = 0; rr < 2; ++rr)
#pragma unroll
        for (int j = 0; j < 4; ++j) { nx[rr][j] = (f32x4){0.f, 0.f, 0.f, 0.f}; nx2[rr][j] = (f32x4){0.f, 0.f, 0.f, 0.f}; }
    auto xrow = [&](int it, int rr) -> const float* { const int row = it * 16 + wave * 2 + rr; return row < T ? p.in[0] + (size_t)row * D : p.in[2] + (size_t)(row - T) * D; };
    if (nit > 0) {
#pragma unroll
        for (int rr = 0; rr < 2; ++rr)
#pragma unroll
            for (int j = 0; j < 4; ++j) nx[rr][j] = ((const f32x4*)xrow(I.at(0), rr))[lane + 64 * j]; }
    if (nit > 1) {
#pragma unroll
        for (int rr = 0; rr < 2; ++rr)
#pragma unroll
            for (int j = 0; j < 4; ++j) nx2[rr][j] = ((const f32x4*)xrow(I.at(1), rr))[lane + 64 * j]; }
#pragma unroll 1
    for (int li = 0; li < nit; ++li) {
        const int it = I.at(li);
        f32x4 v[2][4];
#pragma unroll
        for (int rr = 0; rr < 2; ++rr)
#pragma unroll
            for (int j = 0; j < 4; ++j) { v[rr][j] = nx[rr][j]; nx[rr][j] = nx2[rr][j]; }
        if (li + 2 < nit) {
#pragma unroll
            for (int rr = 0; rr < 2; ++rr)
#pragma unroll
                for (int j = 0; j < 4; ++j) nx2[rr][j] = ((const f32x4*)xrow(I.at(li + 2), rr))[lane + 64 * j]; }
        f32x4 gm1[4], sh1[4];
        { const float* md = MOD + (it * 16 < T ? ((it * 16) >> 13) : 4) * 6144;
#pragma unroll
          for (int j = 0; j < 4; ++j) { gm1[j] = ((const f32x4*)g1)[lane + 64 * j] * (((const f32x4*)(md + 1024))[lane + 64 * j] + 1.f); sh1[j] = ((const f32x4*)md)[lane + 64 * j]; } }
        __syncthreads();
#pragma unroll
        for (int rr = 0; rr < 2; ++rr) {
            const int lr = wave * 2 + rr, row = it * 16 + lr;
            float ss = 0.f;
#pragma unroll
            for (int j = 0; j < 4; ++j) ss += v[rr][j].x * v[rr][j].x + v[rr][j].y * v[rr][j].y + v[rr][j].z * v[rr][j].z + v[rr][j].w * v[rr][j].w;
            const float r = frsq(wave_sum(ss) * (1.f / D) + EPS);
#pragma unroll
            for (int j = 0; j < 4; ++j) {
                const f32x4 hv = v[rr][j] * r * gm1[j] + sh1[j];
                const unsigned long long o = (unsigned long long)pk2(hv.x, hv.y) | ((unsigned long long)pk2(hv.z, hv.w) << 32);
                if (row < T) ((unsigned long long*)(H + (size_t)row * D))[lane + 64 * j] = o;
                *(__attribute__((address_space(3))) unsigned long long*)(L + O_THI + lr * TLS + (lane + 64 * j) * 8) = o;
            }
        }
        __syncthreads();
        mma_part_reg<2, false>(L, bw, wave, lane);
        if (it >= T / 16) {
            const int fr = lane & 15, fq = lane >> 4, q0 = I.quarter() < 0 ? 0 : I.quarter(), q1 = I.quarter() < 0 ? 4 : I.quarter() + 1;
            for (int qt = q0; qt < q1; ++qt) {
                f32x4 acc[3];
#pragma unroll
                for (int t = 0; t < 3; ++t) acc[t] = (f32x4){0.f, 0.f, 0.f, 0.f};
                const int c0 = PK + 192 * qt + 48 * (wave & 3), kh = wave >> 2;
                const bf16* wb = WIN + (size_t)(c0 + fr) * 1024 + 512 * kh + 8 * fq;
#pragma unroll 1
                for (int sb = 0; sb < 4; ++sb) {
                    bf16x8 bq[4][3];
#pragma unroll
                    for (int s2 = 0; s2 < 4; ++s2)
#pragma unroll
                        for (int t = 0; t < 3; ++t) bq[s2][t] = *(const bf16x8*)(wb + (size_t)t * 16 * 1024 + 32 * (4 * sb + s2));
#pragma unroll
                    for (int s2 = 0; s2 < 4; ++s2) {
                        const bf16x8 a = *(const __attribute__((address_space(3))) bf16x8*)(L + O_THI + fr * TLS + (512 * kh + 32 * (4 * sb + s2) + 8 * fq) * 2);
#pragma unroll
                        for (int t = 0; t < 3; ++t) acc[t] = __builtin_amdgcn_mfma_f32_16x16x32_bf16(a, bq[s2][t], acc[t], 0, 0, 0);
                    }
                }
                __attribute__((address_space(3))) float* CP = (__attribute__((address_space(3))) float*)(L + O_LOG);
#pragma unroll
                for (int t = 0; t < 3; ++t)
#pragma unroll
                    for (int q = 0; q < 4; ++q) CP[(kh * 16 + 4 * fq + q) * 192 + 48 * (wave & 3) + 16 * t + fr] = acc[t][q];
                __syncthreads();
                for (int idx = tid; idx < 16 * 96; idx += 512) { const int r = idx / 96, c2 = (idx - r * 96) * 2;
                    const float v0 = CP[r * 192 + c2] + CP[(16 + r) * 192 + c2], v1 = CP[r * 192 + c2 + 1] + CP[(16 + r) * 192 + c2 + 1];
                    *(unsigned*)(PROJ + (size_t)(it * 16 + r) * NPROJ + PK + 192 * qt + c2) = pk2(v0, v1); }
                __syncthreads();
            }
        }
        __syncthreads();
        ALOW[(size_t)it * 16 * 32 + tid] = part_sum<2>(L, tid);
    }
}

__device__ __forceinline__ void phase2(const Params& p, unsigned char* lds) {
    const bf16* H = (const bf16*)(p.ws + WS_H); const bf16* WIN = (const bf16*)(p.ws + WS_WIN); bf16* PROJ = (bf16*)(p.ws + WS_PROJ);
    pg8::SchedDense S; S.init(T, NPROJ, D, WIN, (int)gridDim.x, (int)blockIdx.x);
    pg8::EpiProj E{PROJ, NPROJ};
    pg8::gemm_phase<pg8::EpiProj, pg8::SchedDense, true>((PG8_LAS unsigned char*)lds, H, D, S, E);
}

__device__ __forceinline__ void phase4(const Params& p, unsigned char* lds) {
    for (int u = blockIdx.x; u < NB * 32 * 4 + NB * 4 * 4; u += gridDim.x) {
        if (u < NB * 32 * 4) gla::state_unit(p, (gla::lds_t*)lds, u >> 7, 4 + ((u >> 2) & 31), u & 3);
        else { const int v = u - NB * 32 * 4; gla::state_unit(p, (gla::lds_t*)lds, v >> 4, (v >> 2) & 3, v & 3); }
    }
    __syncthreads();
}

__device__ __forceinline__ void phase5(const Params& p) {
    const int gtid = blockIdx.x * 512 + threadIdx.x, gthreads = gridDim.x * 512;
    const float* DST = (const float*)(p.ws + WS_DST); const float* DEC = (const float*)(p.ws + WS_DEC); float* SPREV = (float*)(p.ws + WS_SPREV);
    typedef float f32x2 __attribute__((ext_vector_type(2)));
    for (int idx = gtid; idx < 2 * NB * 4 * 4096; idx += gthreads) {
        const int de = (idx & 4095) * 2, h = (idx >> 12) & 3, b = (idx >> 14) & 3, dir = idx >> 16, d = de >> 7;
        const int ub = ((dir * NB + b) * NSI) * 4 + h, us = ((dir * NB + b) * 32) * 4 + h;
        f32x2 ds[NSI]; float dc[NSI];
#pragma unroll
        for (int si = 0; si < NSI; ++si) { ds[si] = *(const f32x2*)(DST + (size_t)(ub + 4 * si) * 8192 + de); dc[si] = DEC[(ub + 4 * si) * 64 + d]; }
        if (dir == 0) {
            f32x2 S = ds[0];
#pragma unroll
            for (int si = 1; si < 4; ++si) S = S * dc[si] + ds[si];
#pragma unroll
            for (int si = 4; si < NSI; ++si) { *(f32x2*)(SPREV + (size_t)(us + 4 * (si - 4)) * 8192 + de) = S; S = S * dc[si] + ds[si]; }
        } else {
            f32x2 S = ds[3];
#pragma unroll
            for (int si = 2; si >= 0; --si) S = S * dc[si] + ds[si];
#pragma unroll
            for (int si = NSI - 1; si >= 4; --si) { *(f32x2*)(SPREV + (size_t)(us + 4 * (si - 4)) * 8192 + de) = S; S = S * dc[si] + ds[si]; }
        }
    }
}

__device__ __forceinline__ void phase6(const Params& p, unsigned char* lds) {
    gla::lds_t* L = (gla::lds_t*)lds;
    for (int unit = blockIdx.x; unit < NB * 32 * 4; unit += gridDim.x) {
        const int h = unit & 3, sc = (unit >> 2) & 31, b = unit >> 7;
        gla::out_pass<1>(p, L, b, sc, h);
        gla::out_pass<0>(p, L, b, sc, h);
    }
    __syncthreads();
}

__device__ __forceinline__ void phase7(const Params& p, unsigned char* lds) {
    const int G = gridDim.x, vcu = (G % 8 == 0) ? (int)(blockIdx.x % 8) * (G / 8) + (int)(blockIdx.x / 8) : (int)blockIdx.x;
    for (int u = vcu; u < NB * 64; u += G) pool::unit(p, (pool::lds_t*)lds, u >> 6, u & 63);
    __syncthreads();
}

__device__ __forceinline__ void phase8(const Params& p, unsigned char* lds) {
    const bf16* MIX = (const bf16*)(p.ws + WS_MIX); const bf16* WOUT = (const bf16*)(p.ws + WS_WOUT); const float* MOD = (const float*)(p.ws + WS_MOD);
    pg8::SchedDense S; S.init(T, D, D, WOUT, (int)gridDim.x, (int)blockIdx.x);
    pg8::EpiOut E{(bf16*)(p.ws + WS_OUTP), MOD};
    pg8::gemm_phase<pg8::EpiOut, pg8::SchedDense, true>((PG8_LAS unsigned char*)lds, MIX, D, S, E);
}

__device__ __forceinline__ void phase9(const Params& p, unsigned char* lds) {
    using namespace skinny;
    lds_t* L = (lds_t*)lds;
    typedef __attribute__((address_space(3))) float lf; typedef __attribute__((address_space(3))) int li;
    const int tid = ltid(), lane = tid & 63, wave = tid >> 6, G = gridDim.x;
    const float* MOD = (const float*)(p.ws + WS_MOD); const bf16* WRH = (const bf16*)(p.ws + WS_WR); const bf16* WRL = WRH + 48 * 1024;
    bf16* H2 = (bf16*)(p.ws + WS_H); int* LIST = (int*)(p.ws + WS_LIST);
    unsigned* CNT = (unsigned*)(p.ws + WS_CTL) + CW_CNT;
    const float* g2 = p.in[14];
    lf* LOG = (lf*)(L + O_LOG);
    li* EID = (li*)(L + O_RT);
    lf* EWT = (lf*)(L + O_RT + 1024);
    li* RNK = (li*)(L + O_RT + 2048);
    li* LCN = (li*)(L + O_RT + 3072);
    bf16x8 bwh[3][4]; load_bfrags<3>(bwh, WRH, wave, lane);
    for (int blk = blockIdx.x; blk < T / 128; blk += G) {
        __syncthreads();
        if (tid < 32) LCN[tid] = 0;
        f32x4 gm9[4], sh9[4];
        { const float* md = MOD + ((blk * 128) >> 13) * 6144;
#pragma unroll
          for (int j = 0; j < 4; ++j) { gm9[j] = ((const f32x4*)g2)[lane + 64 * j] * (((const f32x4*)(md + 4096))[lane + 64 * j] + 1.f); sh9[j] = ((const f32x4*)(md + 3072))[lane + 64 * j]; } }
        unsigned long long nx[2][4]; f32x4 nf[2][4];
#pragma unroll
        for (int rr = 0; rr < 2; ++rr)
#pragma unroll
            for (int j = 0; j < 4; ++j) { const size_t ro = (size_t)(blk * 128 + wave * 2 + rr) * D;
                nx[rr][j] = ((const unsigned long long*)((const bf16*)(p.ws + WS_OUTP) + ro))[lane + 64 * j]; nf[rr][j] = ((const f32x4*)(p.in[0] + ro))[lane + 64 * j]; }
#pragma unroll 1
        for (int it8 = 0; it8 < 8; ++it8) {
            const int row0 = blk * 128 + it8 * 16;
            unsigned long long cx[2][4]; f32x4 cf[2][4];
#pragma unroll
            for (int rr = 0; rr < 2; ++rr)
#pragma unroll
                for (int j = 0; j < 4; ++j) { cx[rr][j] = nx[rr][j]; cf[rr][j] = nf[rr][j]; }
            if (it8 < 7) {
#pragma unroll
                for (int rr = 0; rr < 2; ++rr)
#pragma unroll
                    for (int j = 0; j < 4; ++j) { const size_t ro = (size_t)(row0 + 16 + wave * 2 + rr) * D;
                        nx[rr][j] = ((const unsigned long long*)((const bf16*)(p.ws + WS_OUTP) + ro))[lane + 64 * j]; nf[rr][j] = ((const f32x4*)(p.in[0] + ro))[lane + 64 * j]; }
            }
            __syncthreads();
#pragma unroll
            for (int rr = 0; rr < 2; ++rr) {
                const int lr = wave * 2 + rr, row = row0 + lr;
                const float* md = MOD + (row >> 13) * 6144;
                f32x4 v[4]; float ss = 0.f;
#pragma unroll
                for (int j = 0; j < 4; ++j) { const unsigned long long xw = cx[rr][j];
                    v[j].x = cf[rr][j].x + bf2f((unsigned)(xw & 0xffff)); v[j].y = cf[rr][j].y + bf2f((unsigned)((xw >> 16) & 0xffff)); v[j].z = cf[rr][j].z + bf2f((unsigned)((xw >> 32) & 0xffff)); v[j].w = cf[rr][j].w + bf2f((unsigned)(xw >> 48));
                    ((unsigned long long*)((bf16*)(p.ws + WS_XMID) + (size_t)row * D))[lane + 64 * j] = (unsigned long long)pk2(v[j].x, v[j].y) | ((unsigned long long)pk2(v[j].z, v[j].w) << 32);
                    ss += v[j].x * v[j].x + v[j].y * v[j].y + v[j].z * v[j].z + v[j].w * v[j].w; }
                const float r = frsq(wave_sum(ss) * (1.f / D) + EPS);
#pragma unroll
                for (int j = 0; j < 4; ++j) {
                    v[j] = v[j] * r * gm9[j] + sh9[j];
                    const unsigned h0 = f2bf(v[j].x), h1 = f2bf(v[j].y), h2 = f2bf(v[j].z), h3 = f2bf(v[j].w);
                    const unsigned long long o = (unsigned long long)(h0 | (h1 << 16)) | ((unsigned long long)(h2 | (h3 << 16)) << 32);
                    const unsigned long long ol = (unsigned long long)pk2(v[j].x - bf2f(h0), v[j].y - bf2f(h1)) | ((unsigned long long)pk2(v[j].z - bf2f(h2), v[j].w - bf2f(h3)) << 32);
                    ((unsigned long long*)(H2 + (size_t)row * D))[lane + 64 * j] = o;
                    *(__attribute__((address_space(3))) unsigned long long*)(L + O_THI + lr * TLS + (lane + 64 * j) * 8) = o;
                    *(__attribute__((address_space(3))) unsigned long long*)(L + O_TLO + lr * TLS + (lane + 64 * j) * 8) = ol;
                }
            }
            __syncthreads();
            mma_part_reg<3, true>(L, bwh, wave, lane);
            __syncthreads();
            LOG[tid] = part_sum<3>(L, tid);
            if (tid < 256) LOG[512 + tid] = part_sum<3>(L, 512 + tid);
            __syncthreads();
            if (tid < 16) {
                const lf* lg = LOG + tid * 48;
                int gi = 0; float gm = lg[32];
#pragma unroll
                for (int q = 1; q < 4; ++q) if (lg[32 + q] > gm) { gm = lg[32 + q]; gi = q; }
                float gs = 0.f;
#pragma unroll
                for (int q = 0; q < 4; ++q) gs += __expf(lg[32 + q] - gm);
                const float gp = 1.f / gs;
                float le[8];
#pragma unroll
                for (int q = 0; q < 8; ++q) le[q] = lg[gi * 8 + q];
                int i0 = 0; float m0 = le[0];
#pragma unroll
                for (int q = 1; q < 8; ++q) if (le[q] > m0) { m0 = le[q]; i0 = q; }
                int i1 = -1; float m1 = -3.0e38f;
#pragma unroll
                for (int q = 0; q < 8; ++q) if (q != i0 && le[q] > m1) { m1 = le[q]; i1 = q; }
                const float e1 = __expf(m1 - m0), w0 = gp / (1.f + e1), w1 = gp * e1 / (1.f + e1);
                const int pr = (it8 * 16 + tid) * 2;
                EID[pr] = gi * 8 + i0; EWT[pr] = w0; EID[pr + 1] = gi * 8 + i1; EWT[pr + 1] = w1;
            }
        }
        __syncthreads();
        if (tid < 256) RNK[tid] = __hip_atomic_fetch_add((int*)(LCN + EID[tid]), 1, __ATOMIC_RELAXED, __HIP_MEMORY_SCOPE_WORKGROUP);
        __syncthreads();
        if (tid < 32) { const int c = LCN[tid]; LCN[tid] = c ? (int)atomicAdd(CNT + tid, (unsigned)c) : 0; }
        __syncthreads();
        if (tid < 256) { const int e = EID[tid], tok2 = blk * 256 + tid; const size_t sl = (size_t)(e * T + LCN[e] + RNK[tid]); LIST[2 * sl] = tok2; LIST[2 * sl + 1] = __float_as_int(EWT[tid]); }
    }
}

__device__ __forceinline__ void moe_tables(const Params& p, unsigned char* lds) {
    PG8_LAS int* tp = (PG8_LAS int*)((PG8_LAS unsigned char*)lds + MISC_OFF) + 32; PG8_LAS int* cn = tp + 64;
    const unsigned* CNT = (const unsigned*)(p.ws + WS_CTL) + CW_CNT;
    __syncthreads();
    if (threadIdx.x < 32) cn[threadIdx.x] = (int)CNT[threadIdx.x];
    __syncthreads();
    if (threadIdx.x == 0) { int a = 0; for (int e = 0; e < 32; ++e) { tp[e] = a; a += (cn[e] + 255) >> 8; } tp[32] = a; }
    __syncthreads();
    {
        PG8_LAS unsigned char* r2e = (PG8_LAS unsigned char*)(tp + 96);
        for (int rt = threadIdx.x; rt < 288; rt += 512) { int e = 0; while (e < 31 && tp[e + 1] <= rt) ++e; r2e[rt] = (unsigned char)e; }
    }
    __syncthreads();
}
__device__ __forceinline__ void phase10(const Params& p, unsigned char* lds) {
    moe_tables(p, lds);
    const PG8_LAS int* tp = (const PG8_LAS int*)((PG8_LAS unsigned char*)lds + MISC_OFF) + 32; const PG8_LAS int* cn = tp + 64;
    pg8::SchedMoE1 S{tp, cn, (const int*)(p.ws + WS_LIST), (const bf16*)(p.ws + WS_WE1), (int)gridDim.x, (int)blockIdx.x};
    pg8::EpiSwiglu E{(bf16*)(p.ws + WS_HID)};
    pg8::gemm_phase<pg8::EpiSwiglu, pg8::SchedMoE1, true>((PG8_LAS unsigned char*)lds, (const bf16*)(p.ws + WS_H), D, S, E);
}
__device__ __forceinline__ void phase11(const Params& p, unsigned char* lds) {
    const PG8_LAS int* tp = (const PG8_LAS int*)((PG8_LAS unsigned char*)lds + MISC_OFF) + 32; const PG8_LAS int* cn = tp + 64;
    pg8::SchedMoE2 S{tp, (const bf16*)(p.ws + WS_WE2), (int)gridDim.x, (int)blockIdx.x};
    pg8::EpiScatter E{(bf16*)(p.ws + WS_PROJ), cn, (const int*)(p.ws + WS_LIST)};
    pg8::gemm_phase<pg8::EpiScatter, pg8::SchedMoE2, true>((PG8_LAS unsigned char*)lds, (const bf16*)(p.ws + WS_HID), DE, S, E);
}

__device__ __forceinline__ void phase12(const Params& p) {
    const int tid = ltid(), lane = tid & 63, wave = tid >> 6, G = gridDim.x;
    const int gw = blockIdx.x * 8 + wave, NGW = G * 8;
    const float* MOD = (const float*)(p.ws + WS_MOD); const bf16* Y = (const bf16*)(p.ws + WS_PROJ); const bf16* XM = (const bf16*)(p.ws + WS_XMID);
    f32x4 gfin[4];
#pragma unroll
    for (int j = 0; j < 4; ++j) gfin[j] = ((const f32x4*)p.in[19])[lane + 64 * j];
    for (int row = gw; row < T; row += 2 * NGW) {
        unsigned long long xw[2][4], y0[2][4], y1[2][4]; f32x4 gt[2][4];
#pragma unroll
        for (int rr = 0; rr < 2; ++rr) {
            const int r = min(row + rr * NGW, T - 1);
#pragma unroll
            for (int j = 0; j < 4; ++j) {
                xw[rr][j] = ((const unsigned long long*)(XM + (size_t)r * D))[lane + 64 * j];
                y0[rr][j] = ((const unsigned long long*)(Y + (size_t)(2 * r) * 1024))[lane + 64 * j];
                y1[rr][j] = ((const unsigned long long*)(Y + (size_t)(2 * r + 1) * 1024))[lane + 64 * j];
                gt[rr][j] = ((const f32x4*)(MOD + (r >> 13) * 6144 + 5120))[lane + 64 * j];
            }
        }
#pragma unroll
        for (int rr = 0; rr < 2; ++rr) {
            const int r = row + rr * NGW;
            f32x4 v[4]; float ss = 0.f;
#pragma unroll
            for (int j = 0; j < 4; ++j) {
                const unsigned long long a = xw[rr][j], b0 = y0[rr][j], b1 = y1[rr][j];
                f32x4 xv, ys;
                xv.x = bf2f((unsigned)(a & 0xffff)); xv.y = bf2f((unsigned)((a >> 16) & 0xffff)); xv.z = bf2f((unsigned)((a >> 32) & 0xffff)); xv.w = bf2f((unsigned)(a >> 48));
                ys.x = bf2f((unsigned)(b0 & 0xffff)) + bf2f((unsigned)(b1 & 0xffff));
                ys.y = bf2f((unsigned)((b0 >> 16) & 0xffff)) + bf2f((unsigned)((b1 >> 16) & 0xffff));
                ys.z = bf2f((unsigned)((b0 >> 32) & 0xffff)) + bf2f((unsigned)((b1 >> 32) & 0xffff));
                ys.w = bf2f((unsigned)(b0 >> 48)) + bf2f((unsigned)(b1 >> 48));
                v[j] = xv + gt[rr][j] * ys;
                ss += v[j].x * v[j].x + v[j].y * v[j].y + v[j].z * v[j].z + v[j].w * v[j].w;
            }
            const float rn = frsq(wave_sum(ss) * (1.f / D) + EPS);
            if (r < T) {
#pragma unroll
                for (int j = 0; j < 4; ++j) ((f32x4*)(p.out + (size_t)r * D))[lane + 64 * j] = v[j] * rn * gfin[j];
            }
        }
    }
}

#define LAS __attribute__((address_space(3)))
#define XB_TMO      128
#define XB_XCNT(j)  (256  + 64 * (j))
#define XB_XSUB(j)  (1280 + 64 * (j))
#define XB_XGEN(j)  (2304 + 64 * (j))
#define XB_TOP      3328
#define XB_TOPGEN   3392
#define XCD_BAR_WORDS 3456
#define XB_SPIN_CAP (1u << 18)
__device__ __forceinline__ unsigned xb_ld(unsigned* p)              { return __hip_atomic_load(p, __ATOMIC_RELAXED, __HIP_MEMORY_SCOPE_AGENT); }
__device__ __forceinline__ unsigned xb_add(unsigned* p, unsigned v) { return __hip_atomic_fetch_add(p, v, __ATOMIC_RELAXED, __HIP_MEMORY_SCOPE_AGENT); }
__device__ __forceinline__ unsigned xb_xcc_id() { return (unsigned)__builtin_amdgcn_s_getreg((3 << 11) | 20) & 0xFu; }
#define XB_SPIN(cond, bar) do { unsigned _sp = 0; while (cond) { __builtin_amdgcn_s_sleep(1); \
    if ((++_sp & 255u) == 0u) { if (xb_ld(&(bar)[XB_TMO])) break; if (_sp > XB_SPIN_CAP) { atomicAdd(&(bar)[XB_TMO], 1u); break; } } } } while (0)
struct XcdBarrier { unsigned* bar; unsigned x; volatile LAS unsigned* st; };
__device__ __forceinline__ XcdBarrier xcd_barrier_post(unsigned* bar, volatile LAS unsigned* st) {
    XcdBarrier b; b.bar = bar; b.x = xb_xcc_id(); b.st = st;
    if (threadIdx.x == 0) (void)xb_add(&bar[XB_XCNT(b.x)], 1u);
    return b;
}
__device__ __forceinline__ void xcd_barrier_complete(unsigned* bar, unsigned x, unsigned& nloc, unsigned& nx) {
    const unsigned G = gridDim.x * gridDim.y * gridDim.z;
    unsigned sum, cnt, mine, sp = 0u;
    for (;;) {
        sum = 0u; cnt = 0u; mine = 0u;
#pragma unroll
        for (unsigned j = 0; j < 16; ++j) { const unsigned c = xb_ld(&bar[XB_XCNT(j)]); sum += c; cnt += (c > 0u) ? 1u : 0u; mine = (j == x) ? c : mine; }
        if (sum == G) break;
        __builtin_amdgcn_s_sleep(1);
        if ((++sp & 255u) == 0u) { if (xb_ld(&bar[XB_TMO])) break; if (sp > XB_SPIN_CAP) { atomicAdd(&bar[XB_TMO], 1u); break; } }
    }
    nloc = mine > 0u ? mine : 1u; nx = cnt > 0u ? cnt : 1u;
}
__device__ __forceinline__ void xcd_barrier(const XcdBarrier& b) {
    asm volatile("s_waitcnt vmcnt(0)" ::: "memory");
    __syncthreads();
    if (threadIdx.x == 0) {
        unsigned* bar = b.bar;
        __builtin_amdgcn_s_waitcnt(0);
        unsigned nloc = b.st[0], nx = b.st[1];
        if (nloc == 0u) { xcd_barrier_complete(bar, b.x, nloc, nx); b.st[0] = nloc; b.st[1] = nx; }
        const unsigned old = xb_add(&bar[XB_XSUB(b.x)], 1u);
        const unsigned gen = old / nloc;
        if (old + 1u == (gen + 1u) * nloc) {
            __builtin_amdgcn_fence(__ATOMIC_RELEASE, "agent");
            asm volatile("s_waitcnt vmcnt(0)" ::: "memory");
            const unsigned og = xb_add(&bar[XB_TOP], 1u);
            const unsigned tg = og / nx;
            if (og + 1u == (tg + 1u) * nx) xb_add(&bar[XB_TOPGEN], 1u);
            else XB_SPIN(xb_ld(&bar[XB_TOPGEN]) == tg, bar);
            __builtin_amdgcn_fence(__ATOMIC_ACQUIRE, "agent");
            xb_add(&bar[XB_XGEN(b.x)], 1u);
            asm volatile("s_waitcnt vmcnt(0)" ::: "memory");
        } else {
            XB_SPIN(xb_ld(&bar[XB_XGEN(b.x)]) == gen, bar);
            __builtin_amdgcn_fence(__ATOMIC_ACQUIRE, "agent");
            asm volatile("s_waitcnt vmcnt(0)" ::: "memory");
        }
    }
    __syncthreads();
}

constexpr int MISC_OFF_UNUSED = 0;
__global__ void __launch_bounds__(512, 2) mk_fwd(Params p) {
    extern __shared__ __attribute__((aligned(16))) unsigned char lds[];
    volatile LAS unsigned* MISC = (volatile LAS unsigned*)((LAS unsigned char*)lds + MISC_OFF);
    if (threadIdx.x < 256) MISC[threadIdx.x] = 0u;
    __syncthreads();
    XcdBarrier bar = xcd_barrier_post((unsigned*)(p.ws + WS_CTL) + CW_BAR, MISC + 8);
#ifndef REPEAT_PHASE
#define REPEAT_PHASE -1
#endif
#define PHASE(k, call) { call; xcd_barrier(bar); if ((k) == REPEAT_PHASE) { call; xcd_barrier(bar); call; xcd_barrier(bar); } }
    PHASE(0, phase0(p, lds))
    PHASE(1, phase1(p, lds))
    PHASE(2, phase2(p, lds))
    PHASE(4, phase4(p, lds))
    PHASE(5, phase5(p))
    PHASE(6, phase6(p, lds); phase7(p, lds))
    PHASE(8, phase8(p, lds))
    PHASE(9, phase9(p, lds))
    PHASE(10, phase10(p, lds))
    PHASE(11, phase11(p, lds))
    phase12(p);
}

extern "C" void kernel_launch(void* const* d_in, const int* in_sizes, int n_in, void* d_out, int out_size, void* d_ws, size_t ws_size, hipStream_t stream) {
    static int grid = 0;
    if (grid == 0) {
        if (n_in != 20 || in_sizes[0] != T * D || in_sizes[7] != D * IN_COLS || out_size != T * D || ws_size < WS_END) {
            fprintf(stderr, "kernel_launch: unexpected shapes (n_in %d in0 %d in7 %d out %d ws %zu)\n", n_in, n_in > 0 ? in_sizes[0] : -1, n_in > 7 ? in_sizes[7] : -1, out_size, ws_size); grid = -1; return; }
        int dev = 0, cus = 0;
        if (hipGetDevice(&dev) != hipSuccess || hipDeviceGetAttribute(&cus, hipDeviceAttributeMultiprocessorCount, dev) != hipSuccess) { grid = -1; return; }
        if (hipFuncSetAttribute((const void*)mk_fwd, hipFuncAttributeMaxDynamicSharedMemorySize, LDS_BYTES) != hipSuccess) { grid = -1; return; }
        grid = cus;
    }
    if (grid < 0) return;
    (void)hipMemsetAsync((char*)d_ws + WS_CTL, 0, CTL_BYTES, stream);
    Params a{};
    for (int i = 0; i < 20; ++i) a.in[i] = (const float*)d_in[i];
    a.out = (float*)d_out; a.ws = (unsigned char*)d_ws;
    hipLaunchKernelGGL(mk_fwd, dim3(grid), dim3(512), LDS_BYTES, stream, a);
}
```

```cpp
#include <hip/hip_runtime.h>
#include <cstdint>
#include <cstdio>

typedef unsigned short bf16;
typedef unsigned v4u __attribute__((ext_vector_type(4)));
typedef float f32x4 __attribute__((ext_vector_type(4)));

constexpr int D = 1024, NB = 4, SEQ = 8192, T = NB * SEQ, CTXL = 256, TC = NB * CTXL, TT = T + TC;
constexpr int IN_COLS = 2080, OFF_A = 1536, OFF_P = 1568;
constexpr int NPROJ = 2048;
constexpr int PQ = 0, PK = 256, PV = 512, PG = 1024, PP = 1536;
constexpr int NSI = 36;
constexpr int NE = 32, DE = 256;
constexpr float EPS = 1e-6f;

constexpr size_t MiB = 1u << 20;
constexpr size_t WS_CTL = 0, CTL_BYTES = 65536;
constexpr size_t WS_MOD = 1 * MiB;
constexpr size_t WS_WIN = 2 * MiB;
constexpr size_t WS_WA = 6 * MiB;
constexpr size_t WS_WOUT = 7 * MiB;
constexpr size_t WS_WPOOL = 9 * MiB;
constexpr size_t WS_WR = 10 * MiB;
constexpr size_t WS_DEC = 11 * MiB;
constexpr size_t WS_LIST = 502 * MiB;
constexpr size_t WS_WE1 = 18 * MiB;
constexpr size_t WS_WE2 = 50 * MiB;
constexpr size_t WS_H = 66 * MiB;
constexpr size_t WS_ALOW = 132 * MiB;
constexpr size_t WS_PROJ = 138 * MiB;
constexpr size_t WS_DST = 270 * MiB;
constexpr size_t WS_XMID = 270 * MiB;
constexpr size_t WS_OUTP = 438 * MiB;
constexpr size_t WS_SPREV = 306 * MiB;
constexpr size_t WS_MIX = 338 * MiB;
constexpr size_t WS_HID = 402 * MiB;
constexpr size_t WS_END = 510 * MiB;
constexpr int CW_CNT = 1024;
constexpr int CW_BAR = 4096;

constexpr int LDS_BYTES = 147456;
constexpr int MISC_OFF = LDS_BYTES - 1024;
constexpr int NPHASE = 12;

struct Params { const float* in[20]; float* out; unsigned char* ws; int ph_lo, ph_hi; };

__device__ __forceinline__ float bf2f(unsigned b) { return __uint_as_float(b << 16); }
typedef float f32x2_t __attribute__((ext_vector_type(2)));
typedef __bf16 bf16x2_t __attribute__((ext_vector_type(2)));
__device__ __forceinline__ unsigned pk2(float lo, float hi) { const f32x2_t v = {lo, hi}; return __builtin_bit_cast(unsigned, __builtin_convertvector(v, bf16x2_t)); }
__device__ __forceinline__ unsigned f2bf(float f) { return pk2(f, 0.f) & 0xffffu; }
__device__ __forceinline__ float frcp(float x) { return __builtin_amdgcn_rcpf(x); }
__device__ __forceinline__ float frsq(float x) { return __builtin_amdgcn_rsqf(x); }
template <int CTRL> __device__ __forceinline__ float dppf(float v) { return __int_as_float(__builtin_amdgcn_update_dpp(0, __float_as_int(v), CTRL, 0xf, 0xf, false)); }
__device__ __forceinline__ float wave_sum(float v) {
    v += dppf<0xB1>(v);
    v += dppf<0x4E>(v);
    v += dppf<0x141>(v);
    v += dppf<0x140>(v);
    const int iv = __float_as_int(v);
    return (__int_as_float(__builtin_amdgcn_readlane(iv, 0)) + __int_as_float(__builtin_amdgcn_readlane(iv, 16))) + (__int_as_float(__builtin_amdgcn_readlane(iv, 32)) + __int_as_float(__builtin_amdgcn_readlane(iv, 48)));
}
__device__ __forceinline__ int ltid() { int t = threadIdx.x; asm volatile("" : "+v"(t)); return t; }
__device__ __forceinline__ float silu(float s) { return s * frcp(1.f + __expf(-s)); }
struct TDesc { const float* W; int ldw; bf16* WT; int ldt; };
__device__ __forceinline__ void titem_load(const TDesc& d, float (&tv)[32], int lane) {
#pragma unroll
    for (int i = 0; i < 32; ++i) tv[i] = d.W[(size_t)(2 * i + (lane >> 5)) * d.ldw + (lane & 31)];
}
__device__ __forceinline__ void titem_store(const TDesc& d, const float (&tv)[32], float* scr, int lane) {
#pragma unroll
    for (int i = 0; i < 32; ++i) scr[(2 * i + (lane >> 5)) * 33 + (lane & 31)] = tv[i];
    asm volatile("s_waitcnt lgkmcnt(0)" ::: "memory");
    const int c = lane & 7;
#pragma unroll
    for (int j = 0; j < 4; ++j) { const int n = (lane >> 3) + 8 * j; const float* s = scr + (8 * c) * 33 + n;
        v4u o; o.x = pk2(s[0 * 33], s[1 * 33]); o.y = pk2(s[2 * 33], s[3 * 33]); o.z = pk2(s[4 * 33], s[5 * 33]); o.w = pk2(s[6 * 33], s[7 * 33]);
        *(v4u*)(d.WT + (size_t)n * d.ldt + 8 * c) = o; }
    asm volatile("s_waitcnt lgkmcnt(0)" ::: "memory");
}
__device__ __forceinline__ TDesc tdesc(const float* W, int ldw, int nblk, bf16* WT, int ldt, int item) {
    const int kb = item / nblk, nb = item - kb * nblk, k0 = 64 * kb, n0 = 32 * nb;
    return TDesc{W + (size_t)k0 * ldw + n0, ldw, WT + (size_t)n0 * ldt + k0, ldt};
}


namespace pg8 {
#define PG8_LAS __attribute__((address_space(3)))
typedef short bf16x8 __attribute__((ext_vector_type(8)));
typedef unsigned u32x4 __attribute__((ext_vector_type(4)));
constexpr int BM = 256, BK = 64, HALF = 128, HTB = HALF * BK * 2, STAGE_BYTES = 8 * HTB, NXCD = 8, WGM = 8;
__device__ __forceinline__ int lds_byte(int r, int c) { const int st = (r >> 4) * 2 + (c >> 5), rr = r & 15, cc = c & 31, ob = rr * 64 + cc * 2; return st * 1024 + (ob ^ (((ob >> 9) & 1) << 5)); }
__device__ __forceinline__ void stage_rc(int b, int& R, int& C) { const int st = b / 1024, sb = b % 1024, swz = sb ^ (((sb >> 9) & 1) << 5); R = (st >> 1) * 16 + swz / 64; C = (st & 1) * 32 + (swz % 64) / 2; }
__device__ __forceinline__ int perm32(int rho) { const int n = rho >> 4, i = rho & 15; return 8 * (i >> 2) + 4 * n + (i & 3); }
__device__ __forceinline__ unsigned cvt_pk_bf16(float lo, float hi) { return pk2(lo, hi); }

struct Unit { int pm, pn, e, ti; };

struct SchedDense {
    int nM, nN, nwg, G, c, K; const bf16* Bt;
    __device__ __forceinline__ void init(int M, int N, int K_, const bf16* Bt_, int G_, int c_) { nM = M / BM; nN = N / BM; nwg = nM * nN; G = G_; c = c_; K = K_; Bt = Bt_; }
    __device__ __forceinline__ bool next(int i, Unit& u) const {
        const long L = (long)i * G + c; if (L >= nwg) return false;
        int wgid = (int)L; { const int q = nwg / NXCD, r = nwg % NXCD, xcd = wgid % NXCD, off = wgid / NXCD; wgid = (xcd < r ? xcd * (q + 1) : r * (q + 1) + (xcd - r) * q) + off; }
        const int nig = WGM * nN, gid = wgid / nig, fm = gid * WGM, gsz = (nM - fm) < WGM ? (nM - fm) : WGM;
        u.pm = fm + ((wgid % nig) % gsz); u.pn = (wgid % nig) / gsz; u.e = 0; u.ti = 0; return true;
    }
    __device__ __forceinline__ unsigned arow(const Unit& u, int r) const { return (unsigned)(u.pm * BM + r) * (unsigned)(K * 2); }
    __device__ __forceinline__ const char* bbase(const Unit& u) const { return (const char*)Bt + (size_t)u.pn * BM * K * 2; }
};

template <class Epi, class Sched, bool ALIGN_EPI>
__device__ __forceinline__ void gemm_phase(PG8_LAS unsigned char* lds, const bf16* Aptr, const int K, const Sched& S, const Epi& E) {
    const int tid = ltid(), wid = __builtin_amdgcn_readfirstlane(tid >> 6), lane = tid & 63, wr = wid >> 2, wc = wid & 3, fr = lane & 15, fq = lane >> 4;
    const int nt = K / BK;
    const char* Abase = (const char*)Aptr;
    int sR[2]; unsigned sC[2]; unsigned voffB[2];
#pragma unroll
    for (int i = 0; i < 2; ++i) { int R, C; stage_rc(tid * 16 + i * 8192, R, C); const int Rb = Epi::PERM ? ((R & ~31) + perm32(R & 31)) : R;
        sR[i] = R; sC[i] = (unsigned)C * 2u; voffB[i] = (unsigned)(Rb * K + C) * 2u; }
    const unsigned kstep = (unsigned)(BK * 2);
    const size_t hstep = (size_t)HALF * K * 2;
    const unsigned ldsw = (unsigned)wid * 1024u;
    const int aoff = lds_byte(wr * 64 + fr, fq * 8), boff = lds_byte(wc * 32 + fr, fq * 8);
#define PG8_SA(b, h) (((b) * 2 + (h)) * HTB)
#define PG8_SB(b, h) ((4 + (b) * 2 + (h)) * HTB)
#define PG8_STAGE(bufoff, gbase, voff) do { _Pragma("unroll") for (int _i = 0; _i < 2; ++_i) \
        __builtin_amdgcn_global_load_lds((const unsigned*)((const char*)(gbase) + (voff)[_i]), (PG8_LAS unsigned*)(lds + (bufoff) + ldsw + _i * 8192), 16, 0, 0); } while (0)
#define PG8_STAGE_A(bufoff, AO, h, kb) do { _Pragma("unroll") for (int _i = 0; _i < 2; ++_i) \
        __builtin_amdgcn_global_load_lds((const unsigned*)(Abase + (AO)[h][_i] + (kb)), (PG8_LAS unsigned*)(lds + (bufoff) + ldsw + _i * 8192), 16, 0, 0); } while (0)
#define PG8_LDA(dst, b, h) do { _Pragma("unroll") for (int m = 0; m < 4; ++m) _Pragma("unroll") for (int k = 0; k < 2; ++k) dst[m][k] = *(const PG8_LAS bf16x8*)(lds + PG8_SA(b, h) + aoff + m * 2048 + k * 1024); } while (0)
#define PG8_LDB(dst, b, h) do { _Pragma("unroll") for (int n = 0; n < 2; ++n) _Pragma("unroll") for (int k = 0; k < 2; ++k) dst[n][k] = *(const PG8_LAS bf16x8*)(lds + PG8_SB(b, h) + boff + n * 2048 + k * 1024); } while (0)
#define PG8_MMA(ai, bj, At, Bt) do { __builtin_amdgcn_s_setprio(1); _Pragma("unroll") for (int m = 0; m < 4; ++m) _Pragma("unroll") for (int n = 0; n < 2; ++n) _Pragma("unroll") for (int k = 0; k < 2; ++k) \
        acc[ai][bj][m][n] = __builtin_amdgcn_mfma_f32_16x16x32_bf16(Bt[n][k], At[m][k], acc[ai][bj][m][n], 0, 0, 0); __builtin_amdgcn_s_setprio(0); } while (0)
#define PG8_WAIT_V(n) asm volatile("s_waitcnt vmcnt(" #n ")" ::: "memory")
#define PG8_WAIT_L(n) asm volatile("s_waitcnt lgkmcnt(" #n ")" ::: "memory")
#define PG8_BAR __builtin_amdgcn_s_barrier()
#define PG8_SCHED __builtin_amdgcn_sched_barrier(0)
#define PG8_AOFFS(dst, u) do { _Pragma("unroll") for (int _h = 0; _h < 2; ++_h) _Pragma("unroll") for (int _i = 0; _i < 2; ++_i) dst[_h][_i] = S.arow(u, _h * HALF + sR[_i]) + sC[_i]; } while (0)
    Unit cur, nxt; int ui = 0;
    if (!S.next(0, cur)) return;
    E.prefetch(cur, wr, fr);
    f32x4 acc[2][2][4][2];
#pragma unroll
    for (int a = 0; a < 2; ++a)
#pragma unroll
        for (int b = 0; b < 2; ++b)
#pragma unroll
            for (int m = 0; m < 4; ++m)
#pragma unroll
                for (int n = 0; n < 2; ++n) acc[a][b][m][n] = (f32x4){0.f, 0.f, 0.f, 0.f};
    bf16x8 At[4][2], B0[2][2], B1[2][2];
    unsigned cAo[2][2], nAo[2][2];
    PG8_AOFFS(cAo, cur);
    const char* cB = S.bbase(cur);
    PG8_STAGE(PG8_SB(0, 0), cB, voffB); PG8_STAGE(PG8_SB(0, 1), cB + hstep, voffB); PG8_STAGE_A(PG8_SA(0, 0), cAo, 0, 0u); PG8_STAGE_A(PG8_SA(0, 1), cAo, 1, 0u);
    if (wr == 1) PG8_BAR;
    PG8_WAIT_V(2); PG8_BAR;
    PG8_STAGE(PG8_SB(1, 0), cB + kstep, voffB); PG8_STAGE_A(PG8_SA(1, 0), cAo, 0, kstep); PG8_STAGE(PG8_SB(1, 1), cB + hstep + kstep, voffB);
    PG8_WAIT_V(6); PG8_BAR;
    for (;;) {
        const bool has_next = S.next(ui + 1, nxt);
        const char* nB = cB;
        if (has_next) { PG8_AOFFS(nAo, nxt); nB = S.bbase(nxt); }
        else {
#pragma unroll
            for (int _h = 0; _h < 2; ++_h)
#pragma unroll
                for (int _i = 0; _i < 2; ++_i) nAo[_h][_i] = cAo[_h][_i];
        }
#pragma unroll 1
        for (int t = 0; t < nt; t += 2) {
            const bool last = (t == nt - 2);
            const unsigned k1 = (unsigned)(t + 1) * kstep, k2 = last ? 0u : (unsigned)(t + 2) * kstep, k3 = k2 + kstep;
            unsigned xAo[2][2];
#pragma unroll
            for (int _h = 0; _h < 2; ++_h)
#pragma unroll
                for (int _i = 0; _i < 2; ++_i) xAo[_h][_i] = last ? nAo[_h][_i] : cAo[_h][_i];
            const char* b2 = last ? nB : cB + (size_t)(t + 2) * kstep; const char* b3 = b2 + kstep;
            PG8_LDB(B0, 0, 0); PG8_LDB(B1, 0, 1); PG8_SCHED; PG8_LDA(At, 0, 0); PG8_STAGE_A(PG8_SA(1, 1), cAo, 1, k1);
            PG8_WAIT_V(8); PG8_WAIT_L(0); PG8_BAR; PG8_MMA(0, 0, At, B0); PG8_MMA(0, 1, At, B1); PG8_BAR; PG8_SCHED;
            PG8_LDA(At, 0, 1); PG8_STAGE(PG8_SB(0, 0), b2, voffB); PG8_STAGE(PG8_SB(0, 1), b2 + hstep, voffB); PG8_STAGE_A(PG8_SA(0, 0), xAo, 0, k2);
            PG8_WAIT_V(8); PG8_WAIT_L(0); PG8_BAR; PG8_MMA(1, 0, At, B0); PG8_MMA(1, 1, At, B1); PG8_BAR; PG8_SCHED;
            PG8_LDB(B0, 1, 0); PG8_LDB(B1, 1, 1); PG8_SCHED; PG8_LDA(At, 1, 0); PG8_STAGE_A(PG8_SA(0, 1), xAo, 1, k2);
            PG8_WAIT_V(8); PG8_WAIT_L(0); PG8_BAR; PG8_MMA(0, 0, At, B0); PG8_MMA(0, 1, At, B1); PG8_BAR; PG8_SCHED;
            PG8_LDA(At, 1, 1); PG8_STAGE(PG8_SB(1, 0), b3, voffB); PG8_STAGE(PG8_SB(1, 1), b3 + hstep, voffB); PG8_STAGE_A(PG8_SA(1, 0), xAo, 0, k3);
            PG8_WAIT_V(8); PG8_WAIT_L(0); PG8_BAR; PG8_MMA(1, 0, At, B0); PG8_MMA(1, 1, At, B1); PG8_BAR; PG8_SCHED;
        }
        if constexpr (ALIGN_EPI) { if (wr == 0) PG8_BAR; }
        E(acc, cur, wr, wc, fr, fq);
        if (!has_next) break;
        E.prefetch(nxt, wr, fr);
#pragma unroll
        for (int a = 0; a < 2; ++a)
#pragma unroll
            for (int b = 0; b < 2; ++b)
#pragma unroll
                for (int m = 0; m < 4; ++m)
#pragma unroll
                    for (int n = 0; n < 2; ++n) acc[a][b][m][n] = (f32x4){0.f, 0.f, 0.f, 0.f};
        cur = nxt; cB = nB; ++ui;
#pragma unroll
        for (int _h = 0; _h < 2; ++_h)
#pragma unroll
            for (int _i = 0; _i < 2; ++_i) cAo[_h][_i] = nAo[_h][_i];
        if constexpr (ALIGN_EPI) { if (wr == 1) PG8_BAR; }
    }
    PG8_WAIT_V(0);
    if constexpr (!ALIGN_EPI) { if (wr == 0) PG8_BAR; }
    PG8_BAR;
#undef PG8_SA
#undef PG8_SB
#undef PG8_STAGE
#undef PG8_STAGE_A
#undef PG8_LDA
#undef PG8_LDB
#undef PG8_MMA
#undef PG8_WAIT_V
#undef PG8_WAIT_L
#undef PG8_BAR
#undef PG8_SCHED
#undef PG8_AOFFS
}

struct EpiProj {
    static constexpr bool PERM = true;
    __device__ __forceinline__ void prefetch(const Unit&, int, int) const {}
    __device__ __forceinline__ void rotate() const {}
    bf16* O; int ldc;
    __device__ __forceinline__ void operator()(const f32x4 (&acc)[2][2][4][2], const Unit& u, int wr, int wc, int fr, int fq) const {
        const int row0 = u.pm * BM + wr * 64 + fr, col0 = u.pn * BM + wc * 32 + 8 * fq;
#pragma unroll
        for (int ai = 0; ai < 2; ++ai)
#pragma unroll
            for (int m = 0; m < 4; ++m) { bf16* rowp = O + (size_t)(row0 + ai * HALF + m * 16) * ldc + col0;
#pragma unroll
                for (int bj = 0; bj < 2; ++bj) { const f32x4 v0 = acc[ai][bj][m][0], v1 = acc[ai][bj][m][1];
                    u32x4 w; w.x = cvt_pk_bf16(v0[0], v0[1]); w.y = cvt_pk_bf16(v0[2], v0[3]); w.z = cvt_pk_bf16(v1[0], v1[1]); w.w = cvt_pk_bf16(v1[2], v1[3]);
                    *(u32x4*)(rowp + bj * HALF) = w; } }
    }
};
struct EpiOut {
    static constexpr bool PERM = true;
    __device__ __forceinline__ void prefetch(const Unit&, int, int) const {}
    __device__ __forceinline__ void rotate() const {}
    bf16* xm; const float* MOD;
    __device__ __forceinline__ void operator()(const f32x4 (&acc)[2][2][4][2], const Unit& u, int wr, int wc, int fr, int fq) const {
        const int row0 = u.pm * BM + wr * 64 + fr, col0 = u.pn * BM + wc * 32 + 8 * fq;
        const float* gt = MOD + ((u.pm * BM) >> 13) * 6144 + 2048 + col0;
        f32x4 gv[2][2];
#pragma unroll
        for (int bj = 0; bj < 2; ++bj)
#pragma unroll
            for (int n = 0; n < 2; ++n) gv[bj][n] = *(const f32x4*)(gt + bj * HALF + n * 4);
#pragma unroll
        for (int ai = 0; ai < 2; ++ai)
#pragma unroll
            for (int m = 0; m < 4; ++m) { const size_t off = (size_t)(row0 + ai * HALF + m * 16) * 1024 + col0;
#pragma unroll
                for (int bj = 0; bj < 2; ++bj) {
                    const f32x4 v0 = gv[bj][0] * acc[ai][bj][m][0], v1 = gv[bj][1] * acc[ai][bj][m][1];
                    u32x4 w; w.x = cvt_pk_bf16(v0[0], v0[1]); w.y = cvt_pk_bf16(v0[2], v0[3]); w.z = cvt_pk_bf16(v1[0], v1[1]); w.w = cvt_pk_bf16(v1[2], v1[3]);
                    *(u32x4*)(xm + off + bj * HALF) = w; } }
    }
};

struct SchedMoE1 {
    const PG8_LAS int* tp; const PG8_LAS int* cnt; const int* LIST; const bf16* W; int G, c;
    __device__ __forceinline__ bool next(int i, Unit& u) const {
        const int NU = 2 * tp[32]; int L;
        if (G % 8 == 0) { const int per = (NU + 7) >> 3, x = c & 7; L = x * per + (c >> 3) + (G >> 3) * i; if (L >= min((x + 1) * per, NU)) return false; }
        else { L = i * G + c; if (L >= NU) return false; }
        const int rt = L >> 1; const int e = ((const PG8_LAS unsigned char*)(tp + 96))[rt];
        u.pm = rt; u.pn = L & 1; u.e = e; u.ti = rt - tp[e]; return true;
    }
    __device__ __forceinline__ unsigned arow(const Unit& u, int r) const { const int i = u.ti * 256 + r, ii = i < cnt[u.e] ? i : 0; return (unsigned)(LIST[2 * (u.e * T + ii)] >> 1) * 2048u; }
    __device__ __forceinline__ const char* bbase(const Unit& u) const { return (const char*)(W + ((size_t)u.e * 512 + u.pn * 256) * 1024); }
};
struct EpiSwiglu {
    static constexpr bool PERM = true;
    __device__ __forceinline__ void prefetch(const Unit&, int, int) const {}
    __device__ __forceinline__ void rotate() const {}
    bf16* HID;
    __device__ __forceinline__ void operator()(const f32x4 (&acc)[2][2][4][2], const Unit& u, int wr, int wc, int fr, int fq) const {
#pragma unroll
        for (int ai = 0; ai < 2; ++ai)
#pragma unroll
            for (int m = 0; m < 4; ++m) {
                float h[8];
#pragma unroll
                for (int n = 0; n < 2; ++n)
#pragma unroll
                    for (int q = 0; q < 4; ++q) { const float a = acc[ai][0][m][n][q], uu = acc[ai][1][m][n][q]; h[n * 4 + q] = a * frcp(1.f + __expf(-a)) * uu; }
                u32x4 w; w.x = cvt_pk_bf16(h[0], h[1]); w.y = cvt_pk_bf16(h[2], h[3]); w.z = cvt_pk_bf16(h[4], h[5]); w.w = cvt_pk_bf16(h[6], h[7]);
                *(u32x4*)(HID + (size_t)(u.pm * BM + ai * HALF + wr * 64 + m * 16 + fr) * 256 + u.pn * 128 + wc * 32 + 8 * fq) = w;
            }
    }
};
struct SchedMoE2 {
    const PG8_LAS int* tp; const bf16* W; int G, c;
    __device__ __forceinline__ bool next(int i, Unit& u) const {
        const int NU = 4 * tp[32]; int L;
        if (G % 8 == 0) { const int per = (NU + 7) >> 3, x = c & 7; L = x * per + (c >> 3) + (G >> 3) * i; if (L >= min((x + 1) * per, NU)) return false; }
        else { L = i * G + c; if (L >= NU) return false; }
        const int rt = L >> 2; const int e = ((const PG8_LAS unsigned char*)(tp + 96))[rt];
        u.pm = rt; u.pn = L & 3; u.e = e; u.ti = rt - tp[e]; return true;
    }
    __device__ __forceinline__ unsigned arow(const Unit& u, int r) const { return (unsigned)(u.pm * BM + r) * 512u; }
    __device__ __forceinline__ const char* bbase(const Unit& u) const { return (const char*)(W + ((size_t)u.e * 1024 + u.pn * 256) * 256); }
};
struct EpiScatter {
    static constexpr bool PERM = true;
    bf16* Y; const PG8_LAS int* cnt; const int* LIST;
    typedef int i32x2 __attribute__((ext_vector_type(2)));
    mutable i32x2 cu[8];
    __device__ __forceinline__ void prefetch(const Unit& u, int wr, int fr) const {
        const int ce = cnt[u.e];
#pragma unroll
        for (int q = 0; q < 8; ++q) { const int i = u.ti * 256 + (q >> 2) * HALF + wr * 64 + (q & 3) * 16 + fr;
            cu[q] = *(const i32x2*)(LIST + 2 * (size_t)(u.e * T + (i < ce ? i : 0))); if (i >= ce) cu[q].x = -1; }
    }
    __device__ __forceinline__ void rotate() const {}
    __device__ __forceinline__ void operator()(const f32x4 (&acc)[2][2][4][2], const Unit& u, int wr, int wc, int fr, int fq) const {
#pragma unroll
        for (int ai = 0; ai < 2; ++ai)
#pragma unroll
            for (int m = 0; m < 4; ++m) {
                const int tok2 = cu[ai * 4 + m].x; const float r = __int_as_float(cu[ai * 4 + m].y);
                if (tok2 >= 0) {
                    bf16* rowp = Y + (size_t)tok2 * 1024 + u.pn * BM + wc * 32 + 8 * fq;
#pragma unroll
                    for (int bj = 0; bj < 2; ++bj) { const f32x4 v0 = acc[ai][bj][m][0] * r, v1 = acc[ai][bj][m][1] * r;
                        u32x4 w; w.x = cvt_pk_bf16(v0[0], v0[1]); w.y = cvt_pk_bf16(v0[2], v0[3]); w.z = cvt_pk_bf16(v1[0], v1[1]); w.w = cvt_pk_bf16(v1[2], v1[3]);
                        *(u32x4*)(rowp + bj * HALF) = w; }
                }
            }
    }
};
}


namespace gla {
typedef short bf16x8 __attribute__((ext_vector_type(8)));
typedef float f32x16 __attribute__((ext_vector_type(16)));
typedef __attribute__((address_space(3))) unsigned char lds_t;
typedef __attribute__((address_space(3))) float lf;
typedef __attribute__((address_space(3))) unsigned short lus;
typedef __attribute__((address_space(3))) v4u lv4;
constexpr int LS = 144;
constexpr int O_VT = 0;
constexpr int O_QB = 18432;
constexpr int O_KB = 27648;
constexpr int O_KT = 36864;
constexpr int O_P = 46080;
constexpr int O_OUT = O_QB, OUT_LD = 132;
constexpr int O_ST = 55296;
constexpr int O_DEC = 73728;
constexpr int O_CS = 74240, O_CSB = 76288;
constexpr int O_ALS = 78336;
constexpr int O_RK = 86528, O_RQ = 95744;
constexpr int O_RV = 104960, RVS = 272;
static_assert(64 * OUT_LD * 4 <= 4 * 9216 && O_RV + 64 * RVS <= MISC_OFF, "gla LDS map");

__device__ __forceinline__ unsigned bfr(float f) { return f2bf(f); }

__device__ __forceinline__ f32x16 mm_tile(const lds_t* A, const lds_t* B, f32x16 acc, int lane) {
    const int off = (lane & 31) * LS + (lane >> 5) * 16;
#pragma unroll
    for (int s = 0; s < 4; ++s) {
        const bf16x8 a = *(const __attribute__((address_space(3))) bf16x8*)(A + off + s * 32);
        const bf16x8 b = *(const __attribute__((address_space(3))) bf16x8*)(B + off + s * 32);
        acc = __builtin_amdgcn_mfma_f32_32x32x16_bf16(a, b, acc, 0, 0, 0);
    }
    return acc;
}

struct Raw { v4u k, q, v0, v1; f32x4 al; };
template <bool NEEDQ, bool BOTH>
__device__ __forceinline__ void raw_load(Raw& R, const bf16* PROJ, const float* ALOW, int r0, int h, int dir, int tid) {
    const size_t row = (size_t)(r0 + (tid >> 3));
    R.k = *(const v4u*)(PROJ + row * NPROJ + PK + h * 64 + (tid & 7) * 8);
    if (NEEDQ) R.q = *(const v4u*)(PROJ + row * NPROJ + PQ + h * 64 + (tid & 7) * 8);
    R.v0 = *(const v4u*)(PROJ + row * NPROJ + PV + h * 128 + (tid & 7) * 16);
    R.v1 = *(const v4u*)(PROJ + row * NPROJ + PV + h * 128 + (tid & 7) * 16 + 8);
    if (BOTH) R.al = *(const f32x4*)(ALOW + row * 32 + (tid & 7) * 4);
    else if (tid < 256) R.al = *(const f32x4*)(ALOW + (size_t)(r0 + (tid >> 2)) * 32 + dir * 16 + (tid & 3) * 4);
}
template <bool NEEDQ, bool BOTH>
__device__ __forceinline__ void raw_stage(lds_t* L, const Raw& R, int tid) {
    const int j = tid >> 3, c = tid & 7;
    *(lv4*)(L + O_RK + j * LS + c * 16) = R.k;
    if (NEEDQ) *(lv4*)(L + O_RQ + j * LS + c * 16) = R.q;
    *(lv4*)(L + O_RV + j * RVS + c * 32) = R.v0;
    *(lv4*)(L + O_RV + j * RVS + c * 32 + 16) = R.v1;
    if (BOTH) *(__attribute__((address_space(3))) f32x4*)((lf*)(L + O_ALS) + j * 32 + c * 4) = R.al;
    else if (tid < 256) *(__attribute__((address_space(3))) f32x4*)((lf*)(L + O_ALS) + tid * 4) = R.al;
}
__device__ __forceinline__ void v_transpose(lds_t* L, int tid) {
    const int e = tid & 127, tg = tid >> 7;
    unsigned vr[16];
#pragma unroll
    for (int jj = 0; jj < 16; ++jj) vr[jj] = *(const lus*)(L + O_RV + (16 * tg + jj) * RVS + e * 2);
    v4u w0, w1;
    w0.x = vr[0] | (vr[1] << 16); w0.y = vr[2] | (vr[3] << 16); w0.z = vr[4] | (vr[5] << 16); w0.w = vr[6] | (vr[7] << 16);
    w1.x = vr[8] | (vr[9] << 16); w1.y = vr[10] | (vr[11] << 16); w1.z = vr[12] | (vr[13] << 16); w1.w = vr[14] | (vr[15] << 16);
    *(lv4*)(L + O_VT + e * LS + tg * 32) = w0;
    *(lv4*)(L + O_VT + e * LS + tg * 32 + 16) = w1;
}
template <int ALD>
__device__ __forceinline__ float la_cum(const lds_t* L, int to, int dir, int aoff, const float (&wd)[16], float bd, float (&bl)[8]) {
    const lf* ALS = (const lf*)(L + O_ALS);
    float cum = 0.f;
#pragma unroll
    for (int s2 = 0; s2 < 8; ++s2) {
        const int jj = dir ? 7 - s2 : s2, j = 8 * to + jj;
        float z = bd;
#pragma unroll
        for (int r4 = 0; r4 < 4; ++r4) { const f32x4 a = *(const __attribute__((address_space(3))) f32x4*)(ALS + j * ALD + aoff + r4 * 4);
            z += a.x * wd[r4 * 4] + a.y * wd[r4 * 4 + 1] + a.z * wd[r4 * 4 + 2] + a.w * wd[r4 * 4 + 3]; }
        const float la = (fminf(z, 0.f) - __logf(1.f + __expf(-fabsf(z)))) * (1.f / 16.f);
        cum += la; bl[jj] = cum;
    }
    return cum;
}
__device__ __forceinline__ void cs_combine(const lf* CS, int d, int to, int dir, float& offs, float& tot) {
    offs = 0.f; tot = 0.f;
#pragma unroll
    for (int o = 0; o < 8; ++o) { const float c = CS[o * 64 + d]; tot += c; if (dir ? (o > to) : (o < to)) offs += c; }
}

__device__ __forceinline__ void write_st(lds_t* L, const f32x16& S, int db, int eb, int lane) {
    const int e = 32 * eb + (lane & 31), hh = lane >> 5;
#pragma unroll
    for (int g = 0; g < 4; ++g) {
        const unsigned lo = pk2(S[4 * g], S[4 * g + 1]), hi = pk2(S[4 * g + 2], S[4 * g + 3]);
        *(__attribute__((address_space(3))) unsigned long long*)(L + O_ST + e * LS + (32 * db + 8 * g + 4 * hh) * 2) = (unsigned long long)lo | ((unsigned long long)hi << 32);
    }
}
__device__ __forceinline__ void scale_rows(lds_t* L, f32x16& S, int db, int lane) {
    const int hh = lane >> 5;
#pragma unroll
    for (int g = 0; g < 4; ++g) { const f32x4 dv = *(const __attribute__((address_space(3))) f32x4*)(L + O_DEC + (32 * db + 8 * g + 4 * hh) * 4);
        S[4 * g] *= dv.x; S[4 * g + 1] *= dv.y; S[4 * g + 2] *= dv.z; S[4 * g + 3] *= dv.w; }
}

__device__ __forceinline__ void state_unit(const Params& p, lds_t* L, int b, int si, int h) {
    const int tid = ltid(), lane = tid & 63, w = tid >> 6, hh = lane >> 5, d = lane, to = w;
    const bf16* PROJ = (const bf16*)(p.ws + WS_PROJ); const float* ALOW = (const float*)(p.ws + WS_ALOW);
    float* DST = (float*)(p.ws + WS_DST); float* DEC = (float*)(p.ws + WS_DEC);
    const float* w_dec = p.in[8]; const float* b_dec = p.in[9];
    const int db = w >> 2, eb = w & 3, base = si < 4 ? T + b * CTXL + 64 * si : b * SEQ + (si - 4) * 256, nch = si < 4 ? 1 : 4;
    float wf[16], wb[16];
#pragma unroll
    for (int r = 0; r < 16; ++r) { wf[r] = w_dec[r * 256 + h * 64 + d]; wb[r] = w_dec[4096 + r * 256 + h * 64 + d]; }
    const float bdf = b_dec[h * 64 + d], bdb = b_dec[256 + h * 64 + d];
    f32x16 Sf, Sb;
#pragma unroll
    for (int q = 0; q < 16; ++q) { Sf[q] = 0.f; Sb[q] = 0.f; }
    float pf = 1.f, pb = 1.f;
    Raw R;
    __syncthreads();
    raw_load<false, true>(R, PROJ, ALOW, base, h, 0, tid);
    raw_stage<false, true>(L, R, tid);
    __syncthreads();
#pragma unroll 1
    for (int c = 0; c < nch; ++c) {
        if (c + 1 < nch) raw_load<false, true>(R, PROJ, ALOW, base + 64 * (c + 1), h, 0, tid);
        float blf[8], blb[8];
        const float cf = la_cum<32>(L, to, 0, 0, wf, bdf, blf), cb = la_cum<32>(L, to, 1, 16, wb, bdb, blb);
        ((lf*)(L + O_CS))[to * 64 + d] = cf; ((lf*)(L + O_CSB))[to * 64 + d] = cb;
        __syncthreads();
        float of, tf, ob, tb;
        cs_combine((const lf*)(L + O_CS), d, to, 0, of, tf); cs_combine((const lf*)(L + O_CSB), d, to, 1, ob, tb);
        if (to == 0) ((lf*)(L + O_DEC))[d] = __expf(tf);
        float kf[8], kb[8];
#pragma unroll
        for (int jj = 0; jj < 8; ++jj) {
            const float k = bf2f(*(const lus*)(L + O_RK + (8 * to + jj) * LS + d * 2));
            kf[jj] = k * __expf(tf - (blf[jj] + of));
            kb[jj] = k * __expf(tb - (blb[jj] + ob)) * pb;
        }
        { v4u x; x.x = pk2(kf[0], kf[1]); x.y = pk2(kf[2], kf[3]); x.z = pk2(kf[4], kf[5]); x.w = pk2(kf[6], kf[7]); *(lv4*)(L + O_KT + d * LS + to * 16) = x; }
        { v4u x; x.x = pk2(kb[0], kb[1]); x.y = pk2(kb[2], kb[3]); x.z = pk2(kb[4], kb[5]); x.w = pk2(kb[6], kb[7]); *(lv4*)(L + O_KB + d * LS + to * 16) = x; }
        pf *= __expf(tf); pb *= __expf(tb);
        v_transpose(L, tid);
        __syncthreads();
        scale_rows(L, Sf, db, lane);
        Sf = mm_tile(L + O_KT + 32 * db * LS, L + O_VT + 32 * eb * LS, Sf, lane);
        Sb = mm_tile(L + O_KB + 32 * db * LS, L + O_VT + 32 * eb * LS, Sb, lane);
        if (c + 1 < nch) raw_stage<false, true>(L, R, tid);
        __syncthreads();
    }
    const int uf = ((0 * NB + b) * NSI + si) * 4 + h, ub = ((1 * NB + b) * NSI + si) * 4 + h;
#pragma unroll
    for (int q = 0; q < 16; ++q) { const int dl = (q & 3) + 8 * (q >> 2) + 4 * hh; const size_t o = (size_t)(32 * db + dl) * 128 + 32 * eb + (lane & 31);
        DST[(size_t)uf * 8192 + o] = Sf[q]; DST[(size_t)ub * 8192 + o] = Sb[q]; }
    if (to == 0) { DEC[uf * 64 + d] = pf; DEC[ub * 64 + d] = pb; }
}

template <int DIR>
__device__ __forceinline__ void out_pass(const Params& p, lds_t* L, int b, int sc, int h) {
    const int tid = ltid(), lane = tid & 63, w = tid >> 6, hh = lane >> 5, d = lane, to = w;
    const bf16* PROJ = (const bf16*)(p.ws + WS_PROJ); const float* ALOW = (const float*)(p.ws + WS_ALOW);
    const float* SPREV = (const float*)(p.ws + WS_SPREV); bf16* MIX = (bf16*)(p.ws + WS_MIX); float* OACC = (float*)(p.ws + WS_H);
    const float* w_dec = p.in[8]; const float* b_dec = p.in[9]; const float* gng = p.in[10];
    const int ib = w >> 2, eb = w & 3, base = b * SEQ + sc * 256;
    float wd[16];
#pragma unroll
    for (int r = 0; r < 16; ++r) wd[r] = w_dec[DIR * 4096 + r * 256 + h * 64 + d];
    const float bd = b_dec[DIR * 256 + h * 64 + d];
    const int u = ((DIR * NB + b) * 32 + sc) * 4 + h;
    f32x16 S;
#pragma unroll
    for (int q = 0; q < 16; ++q) { const int dl = (q & 3) + 8 * (q >> 2) + 4 * hh; S[q] = SPREV[(size_t)u * 8192 + (32 * ib + dl) * 128 + 32 * eb + (lane & 31)]; }
    float gnv[16];
    if (DIR == 0) {
#pragma unroll
        for (int q = 0; q < 16; ++q) gnv[q] = gng[(tid & 7) * 16 + q];
    }
    Raw R;
    __syncthreads();
    raw_load<true, false>(R, PROJ, ALOW, base + (DIR ? 192 : 0), h, DIR, tid);
    write_st(L, S, ib, eb, lane);
    raw_stage<true, false>(L, R, tid);
    __syncthreads();
#pragma unroll 1
    for (int cc = 0; cc < 4; ++cc) {
        const int c = DIR ? 3 - cc : cc, r0 = base + 64 * c;
        if (cc < 3) raw_load<true, false>(R, PROJ, ALOW, base + 64 * (DIR ? 2 - cc : cc + 1), h, DIR, tid);
        float* oa = OACC + (size_t)(r0 + 32 * ib + 4 * hh) * 512 + h * 128 + 32 * eb + (lane & 31);
        float ob[16]; v4u g0, g1;
        if (DIR == 0) {
#pragma unroll
            for (int q = 0; q < 16; ++q) ob[q] = oa[(size_t)((q & 3) + 8 * (q >> 2)) * 512];
            const size_t grow = (size_t)(r0 + (tid >> 3));
            g0 = *(const v4u*)(PROJ + grow * NPROJ + PG + h * 128 + (tid & 7) * 16); g1 = *(const v4u*)(PROJ + grow * NPROJ + PG + h * 128 + (tid & 7) * 16 + 8);
        }
        float bl[8];
        const float cum = la_cum<16>(L, to, DIR, 0, wd, bd, bl);
        ((lf*)(L + O_CS))[to * 64 + d] = cum;
        __syncthreads();
        float offs, tot; cs_combine((const lf*)(L + O_CS), d, to, DIR, offs, tot);
        const float dec = __expf(tot);
        if (to == 0) ((lf*)(L + O_DEC))[d] = dec;
        float kt[8];
#pragma unroll
        for (int jj = 0; jj < 8; ++jj) {
            const int j = 8 * to + jj;
            const float bq = bl[jj] + offs, E = __expf(bq), Einv = frcp(E);
            const float kf = bf2f(*(const lus*)(L + O_RK + j * LS + d * 2)) * Einv;
            const unsigned kq = pk2(kf, bf2f(*(const lus*)(L + O_RQ + j * LS + d * 2)) * 0.125f * E);
            *(lus*)(L + O_KB + j * LS + d * 2) = (unsigned short)kq;
            *(lus*)(L + O_QB + j * LS + d * 2) = (unsigned short)(kq >> 16);
            kt[jj] = kf * dec;
        }
        { v4u x; x.x = pk2(kt[0], kt[1]); x.y = pk2(kt[2], kt[3]); x.z = pk2(kt[4], kt[5]); x.w = pk2(kt[6], kt[7]); *(lv4*)(L + O_KT + d * LS + to * 16) = x; }
        v_transpose(L, tid);
        __syncthreads();
        if (w < 4) {
            const int pi = w >> 1, pj = w & 1;
            f32x16 pa;
#pragma unroll
            for (int q = 0; q < 16; ++q) pa[q] = 0.f;
            const bool dead = DIR ? (pj < pi) : (pj > pi);
            if (!dead) pa = mm_tile(L + O_QB + 32 * pi * LS, L + O_KB + 32 * pj * LS, pa, lane);
            const int jl = lane & 31;
#pragma unroll
            for (int q = 0; q < 16; q += 2) {
                const int il = (q & 3) + 8 * (q >> 2) + 4 * hh;
                float v0 = pa[q], v1 = pa[q + 1];
                if (pi == pj) { if (DIR ? (jl < il) : (jl > il)) v0 = 0.f; if (DIR ? (jl < il + 1) : (jl > il + 1)) v1 = 0.f; }
                const unsigned pw = pk2(v0, v1);
                *(lus*)(L + O_P + (32 * pi + il) * LS + (32 * pj + jl) * 2) = (unsigned short)pw;
                *(lus*)(L + O_P + (32 * pi + il + 1) * LS + (32 * pj + jl) * 2) = (unsigned short)(pw >> 16);
            }
        }
        __syncthreads();
        f32x16 o;
#pragma unroll
        for (int q = 0; q < 16; ++q) o[q] = 0.f;
        o = mm_tile(L + O_P + 32 * ib * LS, L + O_VT + 32 * eb * LS, o, lane);
        o = mm_tile(L + O_QB + 32 * ib * LS, L + O_ST + 32 * eb * LS, o, lane);
        scale_rows(L, S, ib, lane);
        S = mm_tile(L + O_KT + 32 * ib * LS, L + O_VT + 32 * eb * LS, S, lane);
        __syncthreads();
        write_st(L, S, ib, eb, lane);
        if (cc < 3) raw_stage<true, false>(L, R, tid);
        if (DIR == 1) {
#pragma unroll
            for (int q = 0; q < 16; ++q) oa[(size_t)((q & 3) + 8 * (q >> 2)) * 512] = o[q];
            __syncthreads();
        } else {
            lf* OUT = (lf*)(L + O_OUT);
#pragma unroll
            for (int q = 0; q < 16; ++q) { const int il = (q & 3) + 8 * (q >> 2) + 4 * hh; OUT[(32 * ib + il) * OUT_LD + 32 * eb + (lane & 31)] = o[q] + ob[q]; }
            __syncthreads();
            const int i = tid >> 3, e0 = (tid & 7) * 16;
            float v[16]; float ss = 0.f;
#pragma unroll
            for (int q4 = 0; q4 < 4; ++q4) { const f32x4 t = *(const __attribute__((address_space(3))) f32x4*)(OUT + i * OUT_LD + e0 + q4 * 4);
                v[q4 * 4] = t.x; v[q4 * 4 + 1] = t.y; v[q4 * 4 + 2] = t.z; v[q4 * 4 + 3] = t.w; ss += t.x * t.x + t.y * t.y + t.z * t.z + t.w * t.w; }
            ss += __shfl_xor(ss, 1); ss += __shfl_xor(ss, 2); ss += __shfl_xor(ss, 4);
            const float r = frsq(ss * (1.f / 128.f) + EPS);
            const size_t row = (size_t)(r0 + i);
            unsigned ow[8];
#pragma unroll
            for (int q = 0; q < 8; ++q) {
                const unsigned gw = q < 4 ? g0[q] : g1[q - 4];
                const float ga = __uint_as_float(gw << 16), gb = __uint_as_float(gw & 0xffff0000u);
                const float ya = v[2 * q] * r * gnv[2 * q] * (ga * frcp(1.f + __expf(-ga))), yb = v[2 * q + 1] * r * gnv[2 * q + 1] * (gb * frcp(1.f + __expf(-gb)));
                ow[q] = pk2(ya, yb);
            }
            v4u o0, o1; o0.x = ow[0]; o0.y = ow[1]; o0.z = ow[2]; o0.w = ow[3]; o1.x = ow[4]; o1.y = ow[5]; o1.z = ow[6]; o1.w = ow[7];
            *(v4u*)(MIX + row * 1024 + h * 128 + e0) = o0; *(v4u*)(MIX + row * 1024 + h * 128 + e0 + 8) = o1;
        }
    }
}
}

namespace pool {
typedef __attribute__((address_space(3))) unsigned char lds_t;
typedef __attribute__((address_space(3))) float lf;
constexpr int V_LD = 132, O_V0 = 0, O_V1 = 33792;
constexpr int PD_LS = 272;
constexpr int O_XG = 67584;
constexpr int O_PD = 102400;
static_assert(O_PD + 128 * PD_LS <= MISC_OFF, "pool LDS map");

template <int GI> struct PX { v4u x[2][(2 << GI) + 1]; };
template <int GI>
__device__ __forceinline__ void gload(PX<GI>& X, const Params& p, int b, int r0) {
    const int tid = ltid(), lane = tid & 63, wv = tid >> 6, co = lane & 15;
    const bf16* PROJ = (const bf16*)(p.ws + WS_PROJ);
    constexpr int w = 2 << GI, lo = w >> 1;
#pragma unroll
    for (int h2 = 0; h2 < 2; ++h2) {
        const int c = 8 * wv + 4 * h2 + (lane >> 4);
        const bf16* src = PROJ + (size_t)(b * SEQ + c) * NPROJ + PP + GI * 128 + 8 * co;
#pragma unroll
        for (int t = 0; t <= w; ++t) { const int r2 = min(max(r0 - lo + t, 0), 127); X.x[h2][t] = *(const v4u*)(src + (size_t)r2 * 64 * NPROJ); }
    }
}
template <int GI, class NX>
__device__ __forceinline__ void group(const Params& p, lds_t* L, int b, int r0, int tok0, PX<GI>& X, NX* nxt) {
    const int tid = ltid(), lane = tid & 63, wv = tid >> 6, hh = lane >> 5;
    const bf16* PROJ = (const bf16*)(p.ws + WS_PROJ); bf16* MIX = (bf16*)(p.ws + WS_MIX); const bf16* WPT = (const bf16*)(p.ws + WS_WPOOL);
    const float* pscale = p.in[12];
    constexpr int gi = GI, w = 2 << GI, lo = w >> 1, hi = w - 1 - lo;
    const float ps = pscale[gi * 128 + (tid & 127)];
    {
        const int co = lane & 15;
        v4u (&x)[2][w + 1] = X.x;
#pragma unroll
        for (int h2 = 0; h2 < 2; ++h2) {
            const int c = 8 * wv + 4 * h2 + (lane >> 4);
            float a0[8], a1[8];
#pragma unroll
            for (int q = 0; q < 8; ++q) { a0[q] = 0.f; a1[q] = 0.f; }
#pragma unroll
            for (int t = 0; t <= w; ++t) { const int r2 = r0 - lo + t; const float m = (r2 >= 0 && r2 < 128) ? 1.f : 0.f;
#pragma unroll
                for (int q = 0; q < 4; ++q) { const float xl = m * __uint_as_float(x[h2][t][q] << 16), xh = m * __uint_as_float(x[h2][t][q] & 0xffff0000u);
                    if (t < w) { a0[2 * q] += xl; a0[2 * q + 1] += xh; }
                    if (t > 0) { a1[2 * q] += xl; a1[2 * q + 1] += xh; } } }
            lf* v0 = (lf*)(L + O_V0) + c * V_LD + 8 * co; lf* v1 = (lf*)(L + O_V1) + c * V_LD + 8 * co;
            *(__attribute__((address_space(3))) f32x4*)v0 = (f32x4){a0[0], a0[1], a0[2], a0[3]}; *(__attribute__((address_space(3))) f32x4*)(v0 + 4) = (f32x4){a0[4], a0[5], a0[6], a0[7]};
            *(__attribute__((address_space(3))) f32x4*)v1 = (f32x4){a1[0], a1[1], a1[2], a1[3]}; *(__attribute__((address_space(3))) f32x4*)(v1 + 4) = (f32x4){a1[4], a1[5], a1[6], a1[7]};
            *(__attribute__((address_space(3))) v4u*)(L + O_XG + c * PD_LS + co * 16) = x[h2][lo];
            *(__attribute__((address_space(3))) v4u*)(L + O_XG + (64 + c) * PD_LS + co * 16) = x[h2][lo + 1];
        }
    }
    __syncthreads();
    if constexpr (GI < 3) gload<GI + 1>(*nxt, p, b, r0);
#pragma unroll
    for (int rr = 0; rr < 2; ++rr) {
        const int r = r0 + rr, rs = max(r - lo, 0), re = min(r + hi + 1, 128);
        const int ch = tid & 127, c0 = 16 * (tid >> 7);
        const lf* V = (const lf*)(L + (rr ? O_V1 : O_V0)) + ch;
        const float invr = 1.f / (float)(re - rs);
        float sacc = 0.f;
        for (int c2 = max(c0 - lo, 0); c2 <= min(c0 + hi, 63); ++c2) sacc += V[c2 * V_LD];
#pragma unroll 4
        for (int ci = 0; ci < 16; ++ci) {
            const int c = c0 + ci;
            if (ci > 0) { const int ad = c + hi, rm = c - lo - 1; if (ad < 64) sacc += V[ad * V_LD]; if (rm >= 0) sacc -= V[rm * V_LD]; }
            const int cs = max(c - lo, 0), ce = min(c + hi + 1, 64);
            const float m = sacc * invr / (float)(ce - cs);
            const float x = bf2f(*(const __attribute__((address_space(3))) unsigned short*)(L + O_XG + (64 * rr + c) * PD_LS + ch * 2));
            MIX[(size_t)(tok0 + 64 * rr + c) * 1024 + 512 + gi * 128 + ch] = (bf16)f2bf((m - x) * ps);
        }
    }
    __syncthreads();
}
__device__ __forceinline__ void unit(const Params& p, lds_t* L, int b, int rp) {
    const int r0 = 2 * rp, tok0 = b * SEQ + r0 * 64;
    PX<0> x0; gload<0>(x0, p, b, r0);
    __syncthreads();
    PX<1> x1; group<0>(p, L, b, r0, tok0, x0, &x1);
    PX<2> x2; group<1>(p, L, b, r0, tok0, x1, &x2);
    PX<3> x3; group<2>(p, L, b, r0, tok0, x2, &x3);
    group<3>(p, L, b, r0, tok0, x3, (PX<3>*)nullptr);
}
}

__device__ __forceinline__ void phase0(const Params& p, unsigned char* lds) {
    const int tid = ltid(), lane = tid & 63, wave = tid >> 6, G = gridDim.x;
    const int gtid = blockIdx.x * 512 + tid, gthreads = G * 512;
    float* MOD = (float*)(p.ws + WS_MOD);
    const float* c = p.in[1]; const float* cctx = p.in[3]; const float* w_ada = p.in[4]; const float* b_ada = p.in[5];
    {
        float* SIL = (float*)lds;
        float* RED = (float*)(lds + 20480);
        for (int i = tid; i < 5 * 1024; i += 512) { const float v = i < 4096 ? c[i] : cctx[i - 4096]; SIL[i] = silu(v); }
        __syncthreads();
        for (int task = blockIdx.x; task < 192; task += G) {
            const int kg = tid >> 5, col = tid & 31;
            float wv[64];
#pragma unroll
            for (int k = 0; k < 64; ++k) wv[k] = w_ada[(size_t)(64 * kg + k) * 6144 + 32 * task + col];
            float a[5] = {0.f, 0.f, 0.f, 0.f, 0.f};
#pragma unroll
            for (int k = 0; k < 64; ++k)
#pragma unroll
                for (int v = 0; v < 5; ++v) a[v] += SIL[v * 1024 + 64 * kg + k] * wv[k];
#pragma unroll
            for (int v = 0; v < 5; ++v) RED[(kg * 5 + v) * 32 + col] = a[v];
            __syncthreads();
            if (tid < 160) { const int v = tid >> 5; float sacc = b_ada[32 * task + col];
#pragma unroll
                for (int g = 0; g < 16; ++g) sacc += RED[(g * 5 + v) * 32 + col];
                MOD[v * 6144 + 32 * task + col] = sacc; }
            __syncthreads();
        }
    }
    const float* w_in = p.in[7];
    bf16* WA = (bf16*)(p.ws + WS_WA);
    for (int idx = gtid; idx < 32 * 1024; idx += gthreads) { const int jj = idx >> 10, k = idx & 1023; WA[idx] = (bf16)f2bf(w_in[(size_t)k * IN_COLS + OFF_A + jj]); }
    const float* w_rg = p.in[15]; const float* w_re = p.in[16];
    bf16* WRH = (bf16*)(p.ws + WS_WR); bf16* WRL = WRH + 48 * 1024;
    for (int idx = gtid; idx < 48 * 1024; idx += gthreads) { const int r = idx >> 10, k = idx & 1023;
        const float v = r < 32 ? w_re[k * 32 + r] : (r < 36 ? w_rg[k * 4 + (r - 32)] : 0.f);
        const unsigned hi = f2bf(v); WRH[idx] = (bf16)hi; WRL[idx] = (bf16)f2bf(v - bf2f(hi)); }
    {
        float* TA = (float*)lds;
        float* TB = (float*)(lds + 32768);
        bf16* WINp = (bf16*)(p.ws + WS_WIN);
        const int nfold = 64, fb = (G == 256) ? (int)blockIdx.x - 192 : (int)blockIdx.x, fs = (G == 256) ? 64 : G;
        for (int task = fb; task >= 0 && task < nfold; task += fs) {
            const int g = task >> 4, k0 = (task & 15) * 64;
            __syncthreads();
            for (int i = tid; i < 64 * 32; i += 512) { const int k = i >> 5, c4 = i & 31; *(f32x4*)(TA + k * 128 + 4 * c4) = *(const f32x4*)(p.in[7] + (size_t)(k0 + k) * IN_COLS + OFF_P + g * 128 + 4 * c4); }
            for (int i = tid; i < 128 * 32; i += 512) *(f32x4*)(TB + 4 * i) = *(const f32x4*)(p.in[11] + (size_t)g * 16384 + 4 * i);
            __syncthreads();
            const int d = tid & 127, kq = tid >> 7;
            float acc[16];
#pragma unroll
            for (int i = 0; i < 16; ++i) acc[i] = 0.f;
            for (int c = 0; c < 128; c += 4) {
                const float w0 = TB[c * 128 + d], w1 = TB[(c + 1) * 128 + d], w2 = TB[(c + 2) * 128 + d], w3 = TB[(c + 3) * 128 + d];
#pragma unroll
                for (int i = 0; i < 16; ++i) { const f32x4 a = *(const f32x4*)(TA + (kq * 16 + i) * 128 + c); acc[i] += a.x * w0 + a.y * w1 + a.z * w2 + a.w * w3; }
            }
            v4u o0, o1;
            o0.x = pk2(acc[0], acc[1]); o0.y = pk2(acc[2], acc[3]); o0.z = pk2(acc[4], acc[5]); o0.w = pk2(acc[6], acc[7]);
            o1.x = pk2(acc[8], acc[9]); o1.y = pk2(acc[10], acc[11]); o1.z = pk2(acc[12], acc[13]); o1.w = pk2(acc[14], acc[15]);
            bf16* dst = WINp + (size_t)(1536 + g * 128 + d) * 1024 + k0 + kq * 16;
            *(v4u*)dst = o0; *(v4u*)(dst + 8) = o1;
        }
        __syncthreads();
    }
    float* scr = (float*)(lds + wave * 8448);
    const int gw = blockIdx.x * 8 + wave, NGW = G * 8;
    bf16* WIN = (bf16*)(p.ws + WS_WIN); bf16* WOUT = (bf16*)(p.ws + WS_WOUT); bf16* WE1 = (bf16*)(p.ws + WS_WE1); bf16* WE2 = (bf16*)(p.ws + WS_WE2);
    const float* w_out = p.in[13]; const float* w_e_in = p.in[17]; const float* w_e_out = p.in[18];
    constexpr int I_A = 16 * 48, I_O = 16 * 32, I_E1 = 32 * 256, I_E2 = 32 * 128;
    auto desc_of = [&](int it) -> TDesc {
        int r = it;
        if (r < I_A) return tdesc(w_in, IN_COLS, 48, WIN, 1024, r); r -= I_A;
        if (r < I_O) return tdesc(w_out, 1024, 32, WOUT, 1024, r); r -= I_O;
        if (r < I_E1) { const int e = r >> 8, sub = (r >> 6) & 3, item = r & 63, pn = sub >> 1, half = sub & 1;
            return tdesc(w_e_in + (size_t)e * 1024 * 512 + half * 256 + 128 * pn, 512, 4, WE1 + (size_t)e * 512 * 1024 + (size_t)(256 * pn + 128 * half) * 1024, 1024, item); } r -= I_E1;
        { const int e = r >> 7, item = r & 127; return tdesc(w_e_out + (size_t)e * 256 * 1024, 1024, 32, WE2 + (size_t)e * 1024 * 256, 256, item); }
    };
    constexpr int NIT = I_A + I_O + I_E1 + I_E2;
    if (gw < NIT) {
        TDesc d = desc_of(gw); float tv[32]; titem_load(d, tv, lane);
        for (int it = gw; it < NIT; it += NGW) {
            const bool has = it + NGW < NIT;
            TDesc dn = d; float tn[32];
            if (has) { dn = desc_of(it + NGW); titem_load(dn, tn, lane); }
            titem_store(d, tv, scr, lane);
            if (has) { d = dn;
#pragma unroll
                for (int i = 0; i < 32; ++i) tv[i] = tn[i]; }
        }
    }
}

namespace skinny {
typedef __attribute__((address_space(3))) unsigned char lds_t;
typedef short bf16x8 __attribute__((ext_vector_type(8)));
constexpr int TLS = 2064;
constexpr int O_THI = 0, O_TLO = 16 * TLS, O_PART = 2 * 16 * TLS, O_LOG = O_PART + 8 * 16 * 48 * 4, O_RT = O_LOG + 16 * 48 * 4;
template <int NT, bool SPLIT>
__device__ __forceinline__ void mma_part(lds_t* L, const bf16* WH, const bf16* WL, int wv, int lane) {
    const int fr = lane & 15, fq = lane >> 4;
    f32x4 acc[NT];
#pragma unroll
    for (int t = 0; t < NT; ++t) acc[t] = (f32x4){0.f, 0.f, 0.f, 0.f};
#pragma unroll
    for (int s2 = 0; s2 < 4; ++s2) {
        const int k = 128 * wv + 32 * s2 + 8 * fq;
        const bf16x8 ah = *(const __attribute__((address_space(3))) bf16x8*)(L + O_THI + fr * TLS + k * 2);
        bf16x8 al; if (SPLIT) al = *(const __attribute__((address_space(3))) bf16x8*)(L + O_TLO + fr * TLS + k * 2);
#pragma unroll
        for (int t = 0; t < NT; ++t) {
            const bf16x8 bh = *(const bf16x8*)(WH + (size_t)(16 * t + fr) * 1024 + k);
            acc[t] = __builtin_amdgcn_mfma_f32_16x16x32_bf16(ah, bh, acc[t], 0, 0, 0);
            if (SPLIT) { const bf16x8 bl = *(const bf16x8*)(WL + (size_t)(16 * t + fr) * 1024 + k);
                acc[t] = __builtin_amdgcn_mfma_f32_16x16x32_bf16(al, bh, acc[t], 0, 0, 0);
                acc[t] = __builtin_amdgcn_mfma_f32_16x16x32_bf16(ah, bl, acc[t], 0, 0, 0); }
        }
    }
    __attribute__((address_space(3))) float* P = (__attribute__((address_space(3))) float*)(L + O_PART) + wv * 16 * 16 * NT;
#pragma unroll
    for (int t = 0; t < NT; ++t)
#pragma unroll
        for (int q = 0; q < 4; ++q) P[(4 * fq + q) * 16 * NT + 16 * t + fr] = acc[t][q];
}
template <int NT>
__device__ __forceinline__ void load_bfrags(bf16x8 (&bh)[NT][4], const bf16* W, int wv, int lane) {
    const int fr = lane & 15, fq = lane >> 4;
#pragma unroll
    for (int t = 0; t < NT; ++t)
#pragma unroll
        for (int s2 = 0; s2 < 4; ++s2) bh[t][s2] = *(const bf16x8*)(W + (size_t)(16 * t + fr) * 1024 + 128 * wv + 32 * s2 + 8 * fq);
}
template <int NT, bool SPLIT>
__device__ __forceinline__ void mma_part_reg(lds_t* L, const bf16x8 (&bh)[NT][4], int wv, int lane) {
    const int fr = lane & 15, fq = lane >> 4;
    f32x4 acc[NT];
#pragma unroll
    for (int t = 0; t < NT; ++t) acc[t] = (f32x4){0.f, 0.f, 0.f, 0.f};
#pragma unroll
    for (int s2 = 0; s2 < 4; ++s2) {
        const int k = 128 * wv + 32 * s2 + 8 * fq;
        const bf16x8 ah = *(const __attribute__((address_space(3))) bf16x8*)(L + O_THI + fr * TLS + k * 2);
        bf16x8 al; if (SPLIT) al = *(const __attribute__((address_space(3))) bf16x8*)(L + O_TLO + fr * TLS + k * 2);
#pragma unroll
        for (int t = 0; t < NT; ++t) {
            acc[t] = __builtin_amdgcn_mfma_f32_16x16x32_bf16(ah, bh[t][s2], acc[t], 0, 0, 0);
            if (SPLIT) acc[t] = __builtin_amdgcn_mfma_f32_16x16x32_bf16(al, bh[t][s2], acc[t], 0, 0, 0);
        }
    }
    __attribute__((address_space(3))) float* P = (__attribute__((address_space(3))) float*)(L + O_PART) + wv * 16 * 16 * NT;
#pragma unroll
    for (int t = 0; t < NT; ++t)
#pragma unroll
        for (int q = 0; q < 4; ++q) P[(4 * fq + q) * 16 * NT + 16 * t + fr] = acc[t][q];
}
template <int NT>
__device__ __forceinline__ float part_sum(const lds_t* L, int idx) {
    const __attribute__((address_space(3))) float* P = (const __attribute__((address_space(3))) float*)(L + O_PART);
    float s = 0.f;
#pragma unroll
    for (int w = 0; w < 8; ++w) s += P[w * 16 * 16 * NT + idx];
    return s;
}
}

struct P1Iters {
    int G, b;
    __device__ __forceinline__ int count() const { if (G != 256) return (TT / 16 - b + G - 1) / G; return 9; }
    __device__ __forceinline__ int at(int li) const {
        if (G != 256) return b + li * G;
        return li == 0 ? T / 16 + (b >> 2) : b * 8 + (li - 1);
    }
    __device__ __forceinline__ int quarter() const { return G != 256 ? -1 : (b & 3); }
};
__device__ __forceinline__ void phase1(const Params& p, unsigned char* lds) {
    using namespace skinny;
    lds_t* L = (lds_t*)lds;
    const int tid = ltid(), lane = tid & 63, wave = tid >> 6, G = gridDim.x;
    const float* MOD = (const float*)(p.ws + WS_MOD); const bf16* WA = (const bf16*)(p.ws + WS_WA); const bf16* WIN = (const bf16*)(p.ws + WS_WIN);
    bf16* H = (bf16*)(p.ws + WS_H); float* ALOW = (float*)(p.ws + WS_ALOW); bf16* PROJ = (bf16*)(p.ws + WS_PROJ);
    const float* g1 = p.in[6];
    const P1Iters I{G, (int)blockIdx.x};
    const int nit = I.count();
    bf16x8 bw[2][4]; load_bfrags<2>(bw, WA, wave, lane);
    f32x4 nx[2][4], nx2[2][4];
#pragma unroll
    for (int rr = 0; rr < 2; ++rr)
#pragma unroll
        for (int j = 0; j < 4; ++j) { nx[rr][j] = (f32x4){0.f, 0.f, 0.f, 0.f}; nx2[rr][j] = (f32x4){0.f, 0.f, 0.f, 0.f}; }
    auto xrow = [&](int it, int rr) -> const float* { const int row = it * 16 + wave * 2 + rr; return row < T ? p.in[0] + (size_t)row * D : p.in[2] + (size_t)(row - T) * D; };
    if (nit > 0) {
#pragma unroll
        for (int rr = 0; rr < 2; ++rr)
#pragma unroll
            for (int j = 0; j < 4; ++j) nx[rr][j] = ((const f32x4*)xrow(I.at(0), rr))[lane + 64 * j]; }
    if (nit > 1) {
#pragma unroll
        for (int rr = 0; rr < 2; ++rr)
#pragma unroll
            for (int j = 0; j < 4; ++j) nx2[rr][j] = ((const f32x4*)xrow(I.at(1), rr))[lane + 64 * j]; }
#pragma unroll 1
    for (int li = 0; li < nit; ++li) {
        const int it = I.at(li);
        f32x4 v[2][4];
#pragma unroll
        for (int rr = 0; rr < 2; ++rr)
#pragma unroll
            for (int j = 0; j < 4; ++j) { v[rr][j] = nx[rr][j]; nx[rr][j] = nx2[rr][j]; }
        if (li + 2 < nit) {
#pragma unroll
            for (int rr = 0; rr < 2; ++rr)
#pragma unroll
                for (int j = 0; j < 4; ++j) nx2[rr][j] = ((const f32x4*)xrow(I.at(li + 2), rr))[lane + 64 * j]; }
        f32x4 gm1[4], sh1[4];
        { const float* md = MOD + (it * 16 < T ? ((it * 16) >> 13) : 4) * 6144;
#pragma unroll
          for (int j = 0; j < 4; ++j) { gm1[j] = ((const f32x4*)g1)[lane + 64 * j] * (((const f32x4*)(md + 1024))[lane + 64 * j] + 1.f); sh1[j] = ((const f32x4*)md)[lane + 64 * j]; } }
        __syncthreads();
#pragma unroll
        for (int rr = 0; rr < 2; ++rr) {
            const int lr = wave * 2 + rr, row = it * 16 + lr;
            float ss = 0.f;
#pragma unroll
            for (int j = 0; j < 4; ++j) ss += v[rr][j].x * v[rr][j].x + v[rr][j].y * v[rr][j].y + v[rr][j].z * v[rr][j].z + v[rr][j].w * v[rr][j].w;
            const float r = frsq(wave_sum(ss) * (1.f / D) + EPS);
#pragma unroll
            for (int j = 0; j < 4; ++j) {
                const f32x4 hv = v[rr][j] * r * gm1[j] + sh1[j];
                const unsigned long long o = (unsigned long long)pk2(hv.x, hv.y) | ((unsigned long long)pk2(hv.z, hv.w) << 32);
                if (row < T) ((unsigned long long*)(H + (size_t)row * D))[lane + 64 * j] = o;
                *(__attribute__((address_space(3))) unsigned long long*)(L + O_THI + lr * TLS + (lane + 64 * j) * 8) = o;
            }
        }
        __syncthreads();
        mma_part_reg<2, false>(L, bw, wave, lane);
        if (it >= T / 16) {
            const int fr = lane & 15, fq = lane >> 4, q0 = I.quarter() < 0 ? 0 : I.quarter(), q1 = I.quarter() < 0 ? 4 : I.quarter() + 1;
            for (int qt = q0; qt < q1; ++qt) {
                f32x4 acc[3];
#pragma unroll
                for (int t = 0; t < 3; ++t) acc[t] = (f32x4){0.f, 0.f, 0.f, 0.f};
                const int c0 = PK + 192 * qt + 48 * (wave & 3), kh = wave >> 2;
                const bf16* wb = WIN + (size_t)(c0 + fr) * 1024 + 512 * kh + 8 * fq;
#pragma unroll 1
                for (int sb = 0; sb < 4; ++sb) {
                    bf16x8 bq[4][3];
#pragma unroll
                    for (int s2 = 0; s2 < 4; ++s2)
#pragma unroll
                        for (int t = 0; t < 3; ++t) bq[s2][t] = *(const bf16x8*)(wb + (size_t)t * 16 * 1024 + 32 * (4 * sb + s2));
#pragma unroll
                    for (int s2 = 0; s2 < 4; ++s2) {
                        const bf16x8 a = *(const __attribute__((address_space(3))) bf16x8*)(L + O_THI + fr * TLS + (512 * kh + 32 * (4 * sb + s2) + 8 * fq) * 2);
#pragma unroll
                        for (int t = 0; t < 3; ++t) acc[t] = __builtin_amdgcn_mfma_f32_16x16x32_bf16(a, bq[s2][t], acc[t], 0, 0, 0);
                    }
                }
                __attribute__((address_space(3))) float* CP = (__attribute__((address_space(3))) float*)(L + O_LOG);
#pragma unroll
                for (int t = 0; t < 3; ++t)
#pragma unroll
                    for (int q = 0; q < 4; ++q) CP[(kh * 16 + 4 * fq + q) * 192 + 48 * (wave & 3) + 16 * t + fr] = acc[t][q];
                __syncthreads();
                for (int idx = tid; idx < 16 * 96; idx += 512) { const int r = idx / 96, c2 = (idx - r * 96) * 2;
                    const float v0 = CP[r * 192 + c2] + CP[(16 + r) * 192 + c2], v1 = CP[r * 192 + c2 + 1] + CP[(16 + r) * 192 + c2 + 1];
                    *(unsigned*)(PROJ + (size_t)(it * 16 + r) * NPROJ + PK + 192 * qt + c2) = pk2(v0, v1); }
                __syncthreads();
            }
        }
        __syncthreads();
        ALOW[(size_t)it * 16 * 32 + tid] = part_sum<2>(L, tid);
    }
}

__device__ __forceinline__ void phase2(const Params& p, unsigned char* lds) {
    const bf16* H = (const bf16*)(p.ws + WS_H); const bf16* WIN = (const bf16*)(p.ws + WS_WIN); bf16* PROJ = (bf16*)(p.ws + WS_PROJ);
    pg8::SchedDense S; S.init(T, NPROJ, D, WIN, (int)gridDim.x, (int)blockIdx.x);
    pg8::EpiProj E{PROJ, NPROJ};
    pg8::gemm_phase<pg8::EpiProj, pg8::SchedDense, true>((PG8_LAS unsigned char*)lds, H, D, S, E);
}

__device__ __forceinline__ void phase4(const Params& p, unsigned char* lds) {
    for (int u = blockIdx.x; u < NB * 32 * 4 + NB * 4 * 4; u += gridDim.x) {
        if (u < NB * 32 * 4) gla::state_unit(p, (gla::lds_t*)lds, u >> 7, 4 + ((u >> 2) & 31), u & 3);
        else { const int v = u - NB * 32 * 4; gla::state_unit(p, (gla::lds_t*)lds, v >> 4, (v >> 2) & 3, v & 3); }
    }
    __syncthreads();
}

__device__ __forceinline__ void phase5(const Params& p) {
    const int gtid = blockIdx.x * 512 + threadIdx.x, gthreads = gridDim.x * 512;
    const float* DST = (const float*)(p.ws + WS_DST); const float* DEC = (const float*)(p.ws + WS_DEC); float* SPREV = (float*)(p.ws + WS_SPREV);
    typedef float f32x2 __attribute__((ext_vector_type(2)));
    for (int idx = gtid; idx < 2 * NB * 4 * 4096; idx += gthreads) {
        const int de = (idx & 4095) * 2, h = (idx >> 12) & 3, b = (idx >> 14) & 3, dir = idx >> 16, d = de >> 7;
        const int ub = ((dir * NB + b) * NSI) * 4 + h, us = ((dir * NB + b) * 32) * 4 + h;
        f32x2 ds[NSI]; float dc[NSI];
#pragma unroll
        for (int si = 0; si < NSI; ++si) { ds[si] = *(const f32x2*)(DST + (size_t)(ub + 4 * si) * 8192 + de); dc[si] = DEC[(ub + 4 * si) * 64 + d]; }
        if (dir == 0) {
            f32x2 S = ds[0];
#pragma unroll
            for (int si = 1; si < 4; ++si) S = S * dc[si] + ds[si];
#pragma unroll
            for (int si = 4; si < NSI; ++si) { *(f32x2*)(SPREV + (size_t)(us + 4 * (si - 4)) * 8192 + de) = S; S = S * dc[si] + ds[si]; }
        } else {
            f32x2 S = ds[3];
#pragma unroll
            for (int si = 2; si >= 0; --si) S = S * dc[si] + ds[si];
#pragma unroll
            for (int si = NSI - 1; si >= 4; --si) { *(f32x2*)(SPREV + (size_t)(us + 4 * (si - 4)) * 8192 + de) = S; S = S * dc[si] + ds[si]; }
        }
    }
}

__device__ __forceinline__ void phase6(const Params& p, unsigned char* lds) {
    gla::lds_t* L = (gla::lds_t*)lds;
    for (int unit = blockIdx.x; unit < NB * 32 * 4; unit += gridDim.x) {
        const int h = unit & 3, sc = (unit >> 2) & 31, b = unit >> 7;
        gla::out_pass<1>(p, L, b, sc, h);
        gla::out_pass<0>(p, L, b, sc, h);
    }
    __syncthreads();
}

__device__ __forceinline__ void phase7(const Params& p, unsigned char* lds) {
    const int G = gridDim.x, vcu = (G % 8 == 0) ? (int)(blockIdx.x % 8) * (G / 8) + (int)(blockIdx.x / 8) : (int)blockIdx.x;
    for (int u = vcu; u < NB * 64; u += G) pool::unit(p, (pool::lds_t*)lds, u >> 6, u & 63);
    __syncthreads();
}

__device__ __forceinline__ void phase8(const Params& p, unsigned char* lds) {
    const bf16* MIX = (const bf16*)(p.ws + WS_MIX); const bf16* WOUT = (const bf16*)(p.ws + WS_WOUT); const float* MOD = (const float*)(p.ws + WS_MOD);
    pg8::SchedDense S; S.init(T, D, D, WOUT, (int)gridDim.x, (int)blockIdx.x);
    pg8::EpiOut E{(bf16*)(p.ws + WS_OUTP), MOD};
    pg8::gemm_phase<pg8::EpiOut, pg8::SchedDense, true>((PG8_LAS unsigned char*)lds, MIX, D, S, E);
}

__device__ __forceinline__ void phase9(const Params& p, unsigned char* lds) {
    using namespace skinny;
    lds_t* L = (lds_t*)lds;
    typedef __attribute__((address_space(3))) float lf; typedef __attribute__((address_space(3))) int li;
    const int tid = ltid(), lane = tid & 63, wave = tid >> 6, G = gridDim.x;
    const float* MOD = (const float*)(p.ws + WS_MOD); const bf16* WRH = (const bf16*)(p.ws + WS_WR); const bf16* WRL = WRH + 48 * 1024;
    bf16* H2 = (bf16*)(p.ws + WS_H); int* LIST = (int*)(p.ws + WS_LIST);
    unsigned* CNT = (unsigned*)(p.ws + WS_CTL) + CW_CNT;
    const float* g2 = p.in[14];
    lf* LOG = (lf*)(L + O_LOG);
    li* EID = (li*)(L + O_RT);
    lf* EWT = (lf*)(L + O_RT + 1024);
    li* RNK = (li*)(L + O_RT + 2048);
    li* LCN = (li*)(L + O_RT + 3072);
    bf16x8 bwh[3][4]; load_bfrags<3>(bwh, WRH, wave, lane);
    for (int blk = blockIdx.x; blk < T / 128; blk += G) {
        __syncthreads();
        if (tid < 32) LCN[tid] = 0;
        f32x4 gm9[4], sh9[4];
        { const float* md = MOD + ((blk * 128) >> 13) * 6144;
#pragma unroll
          for (int j = 0; j < 4; ++j) { gm9[j] = ((const f32x4*)g2)[lane + 64 * j] * (((const f32x4*)(md + 4096))[lane + 64 * j] + 1.f); sh9[j] = ((const f32x4*)(md + 3072))[lane + 64 * j]; } }
        unsigned long long nx[2][4]; f32x4 nf[2][4];
#pragma unroll
        for (int rr = 0; rr < 2; ++rr)
#pragma unroll
            for (int j = 0; j < 4; ++j) { const size_t ro = (size_t)(blk * 128 + wave * 2 + rr) * D;
                nx[rr][j] = ((const unsigned long long*)((const bf16*)(p.ws + WS_OUTP) + ro))[lane + 64 * j]; nf[rr][j] = ((const f32x4*)(p.in[0] + ro))[lane + 64 * j]; }
#pragma unroll 1
        for (int it8 = 0; it8 < 8; ++it8) {
            const int row0 = blk * 128 + it8 * 16;
            unsigned long long cx[2][4]; f32x4 cf[2][4];
#pragma unroll
            for (int rr = 0; rr < 2; ++rr)
#pragma unroll
                for (int j = 0; j < 4; ++j) { cx[rr][j] = nx[rr][j]; cf[rr][j] = nf[rr][j]; }
            if (it8 < 7) {
#pragma unroll
                for (int rr = 0; rr < 2; ++rr)
#pragma unroll
                    for (int j = 0; j < 4; ++j) { const size_t ro = (size_t)(row0 + 16 + wave * 2 + rr) * D;
                        nx[rr][j] = ((const unsigned long long*)((const bf16*)(p.ws + WS_OUTP) + ro))[lane + 64 * j]; nf[rr][j] = ((const f32x4*)(p.in[0] + ro))[lane + 64 * j]; }
            }
            __syncthreads();
#pragma unroll
            for (int rr = 0; rr < 2; ++rr) {
                const int lr = wave * 2 + rr, row = row0 + lr;
                const float* md = MOD + (row >> 13) * 6144;
                f32x4 v[4]; float ss = 0.f;
#pragma unroll
                for (int j = 0; j < 4; ++j) { const unsigned long long xw = cx[rr][j];
                    v[j].x = cf[rr][j].x + bf2f((unsigned)(xw & 0xffff)); v[j].y = cf[rr][j].y + bf2f((unsigned)((xw >> 16) & 0xffff)); v[j].z = cf[rr][j].z + bf2f((unsigned)((xw >> 32) & 0xffff)); v[j].w = cf[rr][j].w + bf2f((unsigned)(xw >> 48));
                    ((unsigned long long*)((bf16*)(p.ws + WS_XMID) + (size_t)row * D))[lane + 64 * j] = (unsigned long long)pk2(v[j].x, v[j].y) | ((unsigned long long)pk2(v[j].z, v[j].w) << 32);
                    ss += v[j].x * v[j].x + v[j].y * v[j].y + v[j].z * v[j].z + v[j].w * v[j].w; }
                const float r = frsq(wave_sum(ss) * (1.f / D) + EPS);
#pragma unroll
                for (int j = 0; j < 4; ++j) {
                    v[j] = v[j] * r * gm9[j] + sh9[j];
                    const unsigned h0 = f2bf(v[j].x), h1 = f2bf(v[j].y), h2 = f2bf(v[j].z), h3 = f2bf(v[j].w);
                    const unsigned long long o = (unsigned long long)(h0 | (h1 << 16)) | ((unsigned long long)(h2 | (h3 << 16)) << 32);
                    const unsigned long long ol = (unsigned long long)pk2(v[j].x - bf2f(h0), v[j].y - bf2f(h1)) | ((unsigned long long)pk2(v[j].z - bf2f(h2), v[j].w - bf2f(h3)) << 32);
                    ((unsigned long long*)(H2 + (size_t)row * D))[lane + 64 * j] = o;
                    *(__attribute__((address_space(3))) unsigned long long*)(L + O_THI + lr * TLS + (lane + 64 * j) * 8) = o;
                    *(__attribute__((address_space(3))) unsigned long long*)(L + O_TLO + lr * TLS + (lane + 64 * j) * 8) = ol;
                }
            }
            __syncthreads();
            mma_part_reg<3, true>(L, bwh, wave, lane);
            __syncthreads();
            LOG[tid] = part_sum<3>(L, tid);
            if (tid < 256) LOG[512 + tid] = part_sum<3>(L, 512 + tid);
            __syncthreads();
            if (tid < 16) {
                const lf* lg = LOG + tid * 48;
                int gi = 0; float gm = lg[32];
#pragma unroll
                for (int q = 1; q < 4; ++q) if (lg[32 + q] > gm) { gm = lg[32 + q]; gi = q; }
                float gs = 0.f;
#pragma unroll
                for (int q = 0; q < 4; ++q) gs += __expf(lg[32 + q] - gm);
                const float gp = 1.f / gs;
                float le[8];
#pragma unroll
                for (int q = 0; q < 8; ++q) le[q] = lg[gi * 8 + q];
                int i0 = 0; float m0 = le[0];
#pragma unroll
                for (int q = 1; q < 8; ++q) if (le[q] > m0) { m0 = le[q]; i0 = q; }
                int i1 = -1; float m1 = -3.0e38f;
#pragma unroll
                for (int q = 0; q < 8; ++q) if (q != i0 && le[q] > m1) { m1 = le[q]; i1 = q; }
                const float e1 = __expf(m1 - m0), w0 = gp / (1.f + e1), w1 = gp * e1 / (1.f + e1);
                const int pr = (it8 * 16 + tid) * 2;
                EID[pr] = gi * 8 + i0; EWT[pr] = w0; EID[pr + 1] = gi * 8 + i1; EWT[pr + 1] = w1;
            }
        }
        __syncthreads();
        if (tid < 256) RNK[tid] = __hip_atomic_fetch_add((int*)(LCN + EID[tid]), 1, __ATOMIC_RELAXED, __HIP_MEMORY_SCOPE_WORKGROUP);
        __syncthreads();
        if (tid < 32) { const int c = LCN[tid]; LCN[tid] = c ? (int)atomicAdd(CNT + tid, (unsigned)c) : 0; }
        __syncthreads();
        if (tid < 256) { const int e = EID[tid], tok2 = blk * 256 + tid; const size_t sl = (size_t)(e * T + LCN[e] + RNK[tid]); LIST[2 * sl] = tok2; LIST[2 * sl + 1] = __float_as_int(EWT[tid]); }
    }
}

__device__ __forceinline__ void moe_tables(const Params& p, unsigned char* lds) {
    PG8_LAS int* tp = (PG8_LAS int*)((PG8_LAS unsigned char*)lds + MISC_OFF) + 32; PG8_LAS int* cn = tp + 64;
    const unsigned* CNT = (const unsigned*)(p.ws + WS_CTL) + CW_CNT;
    __syncthreads();
    if (threadIdx.x < 32) cn[threadIdx.x] = (int)CNT[threadIdx.x];
    __syncthreads();
    if (threadIdx.x == 0) { int a = 0; for (int e = 0; e < 32; ++e) { tp[e] = a; a += (cn[e] + 255) >> 8; } tp[32] = a; }
    __syncthreads();
    {
        PG8_LAS unsigned char* r2e = (PG8_LAS unsigned char*)(tp + 96);
        for (int rt = threadIdx.x; rt < 288; rt += 512) { int e = 0; while (e < 31 && tp[e + 1] <= rt) ++e; r2e[rt] = (unsigned char)e; }
    }
    __syncthreads();
}
__device__ __forceinline__ void phase10(const Params& p, unsigned char* lds) {
    moe_tables(p, lds);
    const PG8_LAS int* tp = (const PG8_LAS int*)((PG8_LAS unsigned char*)lds + MISC_OFF) + 32; const PG8_LAS int* cn = tp + 64;
    pg8::SchedMoE1 S{tp, cn, (const int*)(p.ws + WS_LIST), (const bf16*)(p.ws + WS_WE1), (int)gridDim.x, (int)blockIdx.x};
    pg8::EpiSwiglu E{(bf16*)(p.ws + WS_HID)};
    pg8::gemm_phase<pg8::EpiSwiglu, pg8::SchedMoE1, true>((PG8_LAS unsigned char*)lds, (const bf16*)(p.ws + WS_H), D, S, E);
}
__device__ __forceinline__ void phase11(const Params& p, unsigned char* lds) {
    const PG8_LAS int* tp = (const PG8_LAS int*)((PG8_LAS unsigned char*)lds + MISC_OFF) + 32; const PG8_LAS int* cn = tp + 64;
    pg8::SchedMoE2 S{tp, (const bf16*)(p.ws + WS_WE2), (int)gridDim.x, (int)blockIdx.x};
    pg8::EpiScatter E{(bf16*)(p.ws + WS_PROJ), cn, (const int*)(p.ws + WS_LIST)};
    pg8::gemm_phase<pg8::EpiScatter, pg8::SchedMoE2, true>((PG8_LAS unsigned char*)lds, (const bf16*)(p.ws + WS_HID), DE, S, E);
}

__device__ __forceinline__ void phase12(const Params& p) {
    const int tid = ltid(), lane = tid & 63, wave = tid >> 6, G = gridDim.x;
    const int gw = blockIdx.x * 8 + wave, NGW = G * 8;
    const float* MOD = (const float*)(p.ws + WS_MOD); const bf16* Y = (const bf16*)(p.ws + WS_PROJ); const bf16* XM = (const bf16*)(p.ws + WS_XMID);
    f32x4 gfin[4];
#pragma unroll
    for (int j = 0; j < 4; ++j) gfin[j] = ((const f32x4*)p.in[19])[lane + 64 * j];
    for (int row = gw; row < T; row += 2 * NGW) {
        unsigned long long xw[2][4], y0[2][4], y1[2][4]; f32x4 gt[2][4];
#pragma unroll
        for (int rr = 0; rr < 2; ++rr) {
            const int r = min(row + rr * NGW, T - 1);
#pragma unroll
            for (int j = 0; j < 4; ++j) {
                xw[rr][j] = ((const unsigned long long*)(XM + (size_t)r * D))[lane + 64 * j];
                y0[rr][j] = ((const unsigned long long*)(Y + (size_t)(2 * r) * 1024))[lane + 64 * j];
                y1[rr][j] = ((const unsigned long long*)(Y + (size_t)(2 * r + 1) * 1024))[lane + 64 * j];
                gt[rr][j] = ((const f32x4*)(MOD + (r >> 13) * 6144 + 5120))[lane + 64 * j];
            }
        }
#pragma unroll
        for (int rr = 0; rr < 2; ++rr) {
            const int r = row + rr * NGW;
            f32x4 v[4]; float ss = 0.f;
#pragma unroll
            for (int j = 0; j < 4; ++j) {
                const unsigned long long a = xw[rr][j], b0 = y0[rr][j], b1 = y1[rr][j];
                f32x4 xv, ys;
                xv.x = bf2f((unsigned)(a & 0xffff)); xv.y = bf2f((unsigned)((a >> 16) & 0xffff)); xv.z = bf2f((unsigned)((a >> 32) & 0xffff)); xv.w = bf2f((unsigned)(a >> 48));
                ys.x = bf2f((unsigned)(b0 & 0xffff)) + bf2f((unsigned)(b1 & 0xffff));
                ys.y = bf2f((unsigned)((b0 >> 16) & 0xffff)) + bf2f((unsigned)((b1 >> 16) & 0xffff));
                ys.z = bf2f((unsigned)((b0 >> 32) & 0xffff)) + bf2f((unsigned)((b1 >> 32) & 0xffff));
                ys.w = bf2f((unsigned)(b0 >> 48)) + bf2f((unsigned)(b1 >> 48));
                v[j] = xv + gt[rr][j] * ys;
                ss += v[j].x * v[j].x + v[j].y * v[j].y + v[j].z * v[j].z + v[j].w * v[j].w;
            }
            const float rn = frsq(wave_sum(ss) * (1.f / D) + EPS);
            if (r < T) {
#pragma unroll
                for (int j = 0; j < 4; ++j) ((f32x4*)(p.out + (size_t)r * D))[lane + 64 * j] = v[j] * rn * gfin[j];
            }
        }
    }
}

#define LAS __attribute__((address_space(3)))
#define XB_TMO      128
#define XB_XCNT(j)  (256  + 64 * (j))
#define XB_XSUB(j)  (1280 + 64 * (j))
#define XB_XGEN(j)  (2304 + 64 * (j))
#define XB_TOP      3328
#define XB_TOPGEN   3392
#define XCD_BAR_WORDS 3456
#define XB_SPIN_CAP (1u << 18)
__device__ __forceinline__ unsigned xb_ld(unsigned* p)              { return __hip_atomic_load(p, __ATOMIC_RELAXED, __HIP_MEMORY_SCOPE_AGENT); }
__device__ __forceinline__ unsigned xb_add(unsigned* p, unsigned v) { return __hip_atomic_fetch_add(p, v, __ATOMIC_RELAXED, __HIP_MEMORY_SCOPE_AGENT); }
__device__ __forceinline__ unsigned xb_xcc_id() { return (unsigned)__builtin_amdgcn_s_getreg((3 << 11) | 20) & 0xFu; }
#define XB_SPIN(cond, bar) do { unsigned _sp = 0; while (cond) { __builtin_amdgcn_s_sleep(1); \
    if ((++_sp & 255u) == 0u) { if (xb_ld(&(bar)[XB_TMO])) break; if (_sp > XB_SPIN_CAP) { atomicAdd(&(bar)[XB_TMO], 1u); break; } } } } while (0)
struct XcdBarrier { unsigned* bar; unsigned x; volatile LAS unsigned* st; };
__device__ __forceinline__ XcdBarrier xcd_barrier_post(unsigned* bar, volatile LAS unsigned* st) {
    XcdBarrier b; b.bar = bar; b.x = xb_xcc_id(); b.st = st;
    if (threadIdx.x == 0) (void)xb_add(&bar[XB_XCNT(b.x)], 1u);
    return b;
}
__device__ __forceinline__ void xcd_barrier_complete(unsigned* bar, unsigned x, unsigned& nloc, unsigned& nx) {
    const unsigned G = gridDim.x * gridDim.y * gridDim.z;
    unsigned sum, cnt, mine, sp = 0u;
    for (;;) {
        sum = 0u; cnt = 0u; mine = 0u;
#pragma unroll
        for (unsigned j = 0; j < 16; ++j) { const unsigned c = xb_ld(&bar[XB_XCNT(j)]); sum += c; cnt += (c > 0u) ? 1u : 0u; mine = (j == x) ? c : mine; }
        if (sum == G) break;
        __builtin_amdgcn_s_sleep(1);
        if ((++sp & 255u) == 0u) { if (xb_ld(&bar[XB_TMO])) break; if (sp > XB_SPIN_CAP) { atomicAdd(&bar[XB_TMO], 1u); break; } }
    }
    nloc = mine > 0u ? mine : 1u; nx = cnt > 0u ? cnt : 1u;
}
__device__ __forceinline__ void xcd_barrier(const XcdBarrier& b) {
    asm volatile("s_waitcnt vmcnt(0)" ::: "memory");
    __syncthreads();
    if (threadIdx.x == 0) {
        unsigned* bar = b.bar;
        __builtin_amdgcn_s_waitcnt(0);
        unsigned nloc = b.st[0], nx = b.st[1];
        if (nloc == 0u) { xcd_barrier_complete(bar, b.x, nloc, nx); b.st[0] = nloc; b.st[1] = nx; }
        const unsigned old = xb_add(&bar[XB_XSUB(b.x)], 1u);
        const unsigned gen = old / nloc;
        if (old + 1u == (gen + 1u) * nloc) {
            __builtin_amdgcn_fence(__ATOMIC_RELEASE, "agent");
            asm volatile("s_waitcnt vmcnt(0)" ::: "memory");
            const unsigned og = xb_add(&bar[XB_TOP], 1u);
            const unsigned tg = og / nx;
            if (og + 1u == (tg + 1u) * nx) xb_add(&bar[XB_TOPGEN], 1u);
            else XB_SPIN(xb_ld(&bar[XB_TOPGEN]) == tg, bar);
            __builtin_amdgcn_fence(__ATOMIC_ACQUIRE, "agent");
            xb_add(&bar[XB_XGEN(b.x)], 1u);
            asm volatile("s_waitcnt vmcnt(0)" ::: "memory");
        } else {
            XB_SPIN(xb_ld(&bar[XB_XGEN(b.x)]) == gen, bar);
            __builtin_amdgcn_fence(__ATOMIC_ACQUIRE, "agent");
            asm volatile("s_waitcnt vmcnt(0)" ::: "memory");
        }
    }
    __syncthreads();
}

constexpr int MISC_OFF_UNUSED = 0;
__global__ void __launch_bounds__(512, 2) mk_fwd(Params p) {
    extern __shared__ __attribute__((aligned(16))) unsigned char lds[];
    volatile LAS unsigned* MISC = (volatile LAS unsigned*)((LAS unsigned char*)lds + MISC_OFF);
    if (threadIdx.x < 256) MISC[threadIdx.x] = 0u;
    __syncthreads();
    XcdBarrier bar = xcd_barrier_post((unsigned*)(p.ws + WS_CTL) + CW_BAR, MISC + 8);
#ifndef REPEAT_PHASE
#define REPEAT_PHASE -1
#endif
#define PHASE(k, call) { call; xcd_barrier(bar); if ((k) == REPEAT_PHASE) { call; xcd_barrier(bar); call; xcd_barrier(bar); } }
    PHASE(0, phase0(p, lds))
    PHASE(1, phase1(p, lds))
    PHASE(2, phase2(p, lds))
    PHASE(4, phase4(p, lds))
    PHASE(5, phase5(p))
    PHASE(6, phase6(p, lds); phase7(p, lds))
    PHASE(8, phase8(p, lds))
    PHASE(9, phase9(p, lds))
    PHASE(10, phase10(p, lds))
    PHASE(11, phase11(p, lds))
    phase12(p);
}

extern "C" void kernel_launch(void* const* d_in, const int* in_sizes, int n_in, void* d_out, int out_size, void* d_ws, size_t ws_size, hipStream_t stream) {
    static int grid = 0;
    if (grid == 0) {
        if (n_in != 20 || in_sizes[0] != T * D || in_sizes[7] != D * IN_COLS || out_size != T * D || ws_size < WS_END) {
            fprintf(stderr, "kernel_launch: unexpected shapes (n_in %d in0 %d in7 %d out %d ws %zu)\n", n_in, n_in > 0 ? in_sizes[0] : -1, n_in > 7 ? in_sizes[7] : -1, out_size, ws_size); grid = -1; return; }
        int dev = 0, cus = 0;
        if (hipGetDevice(&dev) != hipSuccess || hipDeviceGetAttribute(&cus, hipDeviceAttributeMultiprocessorCount, dev) != hipSuccess) { grid = -1; return; }
        if (hipFuncSetAttribute((const void*)mk_fwd, hipFuncAttributeMaxDynamicSharedMemorySize, LDS_BYTES) != hipSuccess) { grid = -1; return; }
        grid = cus;
    }
    if (grid < 0) return;
    (void)hipMemsetAsync((char*)d_ws + WS_CTL, 0, CTL_BYTES, stream);
    Params a{};
    for (int i = 0; i < 20; ++i) a.in[i] = (const float*)d_in[i];
    a.out = (float*)d_out; a.ws = (unsigned char*)d_ws;
    hipLaunchKernelGGL(mk_fwd, dim3(grid), dim3(512), LDS_BYTES, stream, a);
}
```

```cpp
#include <hip/hip_runtime.h>
#include <cstdint>
#include <cstdio>

typedef unsigned short bf16;
typedef unsigned v4u __attribute__((ext_vector_type(4)));
typedef float f32x4 __attribute__((ext_vector_type(4)));

constexpr int D = 1024, NB = 4, SEQ = 8192, T = NB * SEQ, CTXL = 256, TC = NB * CTXL, TT = T + TC;
constexpr int IN_COLS = 2080, OFF_A = 1536, OFF_P = 1568;
constexpr int NPROJ = 2048;
constexpr int PQ = 0, PK = 256, PV = 512, PG = 1024, PP = 1536;
constexpr int NSI = 36;
constexpr int NE = 32, DE = 256;
constexpr float EPS = 1e-6f;

constexpr size_t MiB = 1u << 20;
constexpr size_t WS_CTL = 0, CTL_BYTES = 65536;
constexpr size_t WS_MOD = 1 * MiB;
constexpr size_t WS_WIN = 2 * MiB;
constexpr size_t WS_WA = 6 * MiB;
constexpr size_t WS_WOUT = 7 * MiB;
constexpr size_t WS_WPOOL = 9 * MiB;
constexpr size_t WS_WR = 10 * MiB;
constexpr size_t WS_DEC = 11 * MiB;
constexpr size_t WS_LIST = 502 * MiB;
constexpr size_t WS_WE1 = 18 * MiB;
constexpr size_t WS_WE2 = 50 * MiB;
constexpr size_t WS_H = 66 * MiB;
constexpr size_t WS_ALOW = 132 * MiB;
constexpr size_t WS_PROJ = 138 * MiB;
constexpr size_t WS_DST = 270 * MiB;
constexpr size_t WS_XMID = 270 * MiB;
constexpr size_t WS_OUTP = 438 * MiB;
constexpr size_t WS_SPREV = 306 * MiB;
constexpr size_t WS_MIX = 338 * MiB;
constexpr size_t WS_HID = 402 * MiB;
constexpr size_t WS_END = 510 * MiB;
constexpr int CW_CNT = 1024;
constexpr int CW_BAR = 4096;

constexpr int LDS_BYTES = 147456;
constexpr int MISC_OFF = LDS_BYTES - 1024;
constexpr int NPHASE = 12;

struct Params { const float* in[20]; float* out; unsigned char* ws; int ph_lo, ph_hi; };

__device__ __forceinline__ float bf2f(unsigned b) { return __uint_as_float(b << 16); }
typedef float f32x2_t __attribute__((ext_vector_type(2)));
typedef __bf16 bf16x2_t __attribute__((ext_vector_type(2)));
__device__ __forceinline__ unsigned pk2(float lo, float hi) { const f32x2_t v = {lo, hi}; return __builtin_bit_cast(unsigned, __builtin_convertvector(v, bf16x2_t)); }
__device__ __forceinline__ unsigned f2bf(float f) { return pk2(f, 0.f) & 0xffffu; }
__device__ __forceinline__ float frcp(float x) { return __builtin_amdgcn_rcpf(x); }
__device__ __forceinline__ float frsq(float x) { return __builtin_amdgcn_rsqf(x); }
template <int CTRL> __device__ __forceinline__ float dppf(float v) { return __int_as_float(__builtin_amdgcn_update_dpp(0, __float_as_int(v), CTRL, 0xf, 0xf, false)); }
__device__ __forceinline__ float wave_sum(float v) {
    v += dppf<0xB1>(v);
    v += dppf<0x4E>(v);
    v += dppf<0x141>(v);
    v += dppf<0x140>(v);
    const int iv = __float_as_int(v);
    return (__int_as_float(__builtin_amdgcn_readlane(iv, 0)) + __int_as_float(__builtin_amdgcn_readlane(iv, 16))) + (__int_as_float(__builtin_amdgcn_readlane(iv, 32)) + __int_as_float(__builtin_amdgcn_readlane(iv, 48)));
}
__device__ __forceinline__ int ltid() { int t = threadIdx.x; asm volatile("" : "+v"(t)); return t; }
__device__ __forceinline__ float silu(float s) { return s * frcp(1.f + __expf(-s)); }
struct TDesc { const float* W; int ldw; bf16* WT; int ldt; int f8; };
__device__ __forceinline__ void titem_load(const TDesc& d, float (&tv)[32], int lane) {
#pragma unroll
    for (int i = 0; i < 32; ++i) tv[i] = d.W[(size_t)(2 * i + (lane >> 5)) * d.ldw + (lane & 31)];
}
__device__ __forceinline__ void titem_store(const TDesc& d, const float (&tv)[32], float* scr, int lane) {
#pragma unroll
    for (int i = 0; i < 32; ++i) scr[(2 * i + (lane >> 5)) * 33 + (lane & 31)] = tv[i];
    asm volatile("s_waitcnt lgkmcnt(0)" ::: "memory");
    const int c = lane & 7;
#pragma unroll
    for (int j = 0; j < 4; ++j) { const int n = (lane >> 3) + 8 * j; const float* s = scr + (8 * c) * 33 + n;
        if (d.f8) {
            unsigned w0 = 0, w1 = 0; const float sc8 = (float)d.f8;
            w0 = __builtin_amdgcn_cvt_pk_fp8_f32(sc8 * s[0 * 33], sc8 * s[1 * 33], w0, false); w0 = __builtin_amdgcn_cvt_pk_fp8_f32(sc8 * s[2 * 33], sc8 * s[3 * 33], w0, true);
            w1 = __builtin_amdgcn_cvt_pk_fp8_f32(sc8 * s[4 * 33], sc8 * s[5 * 33], w1, false); w1 = __builtin_amdgcn_cvt_pk_fp8_f32(sc8 * s[6 * 33], sc8 * s[7 * 33], w1, true);
            *(unsigned long long*)((unsigned char*)d.WT + (size_t)n * d.ldt + 8 * c) = (unsigned long long)w0 | ((unsigned long long)w1 << 32);
        } else {
            v4u o; o.x = pk2(s[0 * 33], s[1 * 33]); o.y = pk2(s[2 * 33], s[3 * 33]); o.z = pk2(s[4 * 33], s[5 * 33]); o.w = pk2(s[6 * 33], s[7 * 33]);
            *(v4u*)(d.WT + (size_t)n * d.ldt + 8 * c) = o; } }
    asm volatile("s_waitcnt lgkmcnt(0)" ::: "memory");
}
__device__ __forceinline__ TDesc tdesc(const float* W, int ldw, int nblk, bf16* WT, int ldt, int item) {
    const int kb = item / nblk, nb = item - kb * nblk, k0 = 64 * kb, n0 = 32 * nb;
    return TDesc{W + (size_t)k0 * ldw + n0, ldw, WT + (size_t)n0 * ldt + k0, ldt, 0};
}


namespace pg8 {
#define PG8_LAS __attribute__((address_space(3)))
typedef short bf16x8 __attribute__((ext_vector_type(8)));
typedef unsigned u32x4 __attribute__((ext_vector_type(4)));
typedef long l64x2 __attribute__((ext_vector_type(2)));
constexpr int BM = 256, BK = 64, HALF = 128, HTB = HALF * BK * 2, STAGE_BYTES = 8 * HTB, NXCD = 8, WGM = 8;
__device__ __forceinline__ int lds_byte(int r, int c) { const int st = (r >> 4) * 2 + (c >> 5), rr = r & 15, cc = c & 31, ob = rr * 64 + cc * 2; return st * 1024 + (ob ^ (((ob >> 9) & 1) << 5)); }
__device__ __forceinline__ void stage_rc(int b, int& R, int& C) { const int st = b / 1024, sb = b % 1024, swz = sb ^ (((sb >> 9) & 1) << 5); R = (st >> 1) * 16 + swz / 64; C = (st & 1) * 32 + (swz % 64) / 2; }
__device__ __forceinline__ int perm32(int rho) { const int n = rho >> 4, i = rho & 15; return 8 * (i >> 2) + 4 * n + (i & 3); }
__device__ __forceinline__ unsigned cvt_pk_bf16(float lo, float hi) { return pk2(lo, hi); }

struct Unit { int pm, pn, e, ti; };

struct SchedDense {
    int nM, nN, nwg, G, c, K; const bf16* Bt;
    __device__ __forceinline__ void init(int M, int N, int K_, const bf16* Bt_, int G_, int c_) { nM = M / BM; nN = N / BM; nwg = nM * nN; G = G_; c = c_; K = K_; Bt = Bt_; }
    __device__ __forceinline__ bool next(int i, Unit& u) const {
        const long L = (long)i * G + c; if (L >= nwg) return false;
        int wgid = (int)L; { const int q = nwg / NXCD, r = nwg % NXCD, xcd = wgid % NXCD, off = wgid / NXCD; wgid = (xcd < r ? xcd * (q + 1) : r * (q + 1) + (xcd - r) * q) + off; }
        const int nig = WGM * nN, gid = wgid / nig, fm = gid * WGM, gsz = (nM - fm) < WGM ? (nM - fm) : WGM;
        u.pm = fm + ((wgid % nig) % gsz); u.pn = (wgid % nig) / gsz; u.e = 0; u.ti = 0; return true;
    }
    __device__ __forceinline__ unsigned arow(const Unit& u, int r) const { return (unsigned)(u.pm * BM + r) * (unsigned)(K * 2); }
    __device__ __forceinline__ const char* bbase(const Unit& u) const { return (const char*)Bt + (size_t)u.pn * BM * K * 2; }
};

template <class Epi, class Sched, bool ALIGN_EPI, int EB = 2>
__device__ __forceinline__ void gemm_phase(PG8_LAS unsigned char* lds, const void* Aptr, const int K, const Sched& S, const Epi& E) {
    const int tid = ltid(), wid = __builtin_amdgcn_readfirstlane(tid >> 6), lane = tid & 63, wr = wid >> 2, wc = wid & 3, fr = lane & 15, fq = lane >> 4;
    const int KB = K * EB; int nt = KB / (BK * 2);
    asm volatile("" : "+s"(nt));
    const char* Abase = (const char*)Aptr;
    int sR[2]; unsigned sC[2]; unsigned voffB[2];
#pragma unroll
    for (int i = 0; i < 2; ++i) { int R, C; stage_rc(tid * 16 + i * 8192, R, C); const int Rb = Epi::PERM ? ((R & ~31) + perm32(R & 31)) : R;
        sR[i] = R; sC[i] = (unsigned)C * 2u; voffB[i] = (unsigned)(Rb * KB + C * 2); }
    const unsigned kstep = (unsigned)(BK * 2);
    const size_t hstep = (size_t)HALF * KB;
    const unsigned ldsw = (unsigned)wid * 1024u;
    const int aoff = lds_byte(wr * 64 + fr, fq * 8), boff = lds_byte(wc * 32 + fr, fq * 8);
#define PG8_SA(b, h) (((b) * 2 + (h)) * HTB)
#define PG8_SB(b, h) ((4 + (b) * 2 + (h)) * HTB)
#define PG8_STAGE(bufoff, gbase, voff) do { _Pragma("unroll") for (int _i = 0; _i < 2; ++_i) \
        __builtin_amdgcn_global_load_lds((const unsigned*)((const char*)(gbase) + (voff)[_i]), (PG8_LAS unsigned*)(lds + (bufoff) + ldsw + _i * 8192), 16, 0, 0); } while (0)
#define PG8_STAGE_A(bufoff, AO, h, kb) do { _Pragma("unroll") for (int _i = 0; _i < 2; ++_i) \
        __builtin_amdgcn_global_load_lds((const unsigned*)(Abase + (AO)[h][_i] + (kb)), (PG8_LAS unsigned*)(lds + (bufoff) + ldsw + _i * 8192), 16, 0, 0); } while (0)
#define PG8_LDA(dst, b, h) do { _Pragma("unroll") for (int m = 0; m < 4; ++m) _Pragma("unroll") for (int k = 0; k < 2; ++k) dst[m][k] = *(const PG8_LAS bf16x8*)(lds + PG8_SA(b, h) + aoff + m * 2048 + k * 1024); } while (0)
#define PG8_LDB(dst, b, h) do { _Pragma("unroll") for (int n = 0; n < 2; ++n) _Pragma("unroll") for (int k = 0; k < 2; ++k) dst[n][k] = *(const PG8_LAS bf16x8*)(lds + PG8_SB(b, h) + boff + n * 2048 + k * 1024); } while (0)
#define PG8_MMA(ai, bj, At, Bt) do { __builtin_amdgcn_s_setprio(1); _Pragma("unroll") for (int m = 0; m < 4; ++m) _Pragma("unroll") for (int n = 0; n < 2; ++n) _Pragma("unroll") for (int k = 0; k < 2; ++k) { \
        if constexpr (EB == 2) acc[ai][bj][m][n] = __builtin_amdgcn_mfma_f32_16x16x32_bf16(Bt[n][k], At[m][k], acc[ai][bj][m][n], 0, 0, 0); \
        else { const l64x2 _b = __builtin_bit_cast(l64x2, Bt[n][k]), _a = __builtin_bit_cast(l64x2, At[m][k]); \
            acc[ai][bj][m][n] = __builtin_amdgcn_mfma_f32_16x16x32_fp8_fp8(_b[0], _a[0], acc[ai][bj][m][n], 0, 0, 0); \
            acc[ai][bj][m][n] = __builtin_amdgcn_mfma_f32_16x16x32_fp8_fp8(_b[1], _a[1], acc[ai][bj][m][n], 0, 0, 0); } } \
        __builtin_amdgcn_s_setprio(0); } while (0)
#define PG8_WAIT_V(n) asm volatile("s_waitcnt vmcnt(" #n ")" ::: "memory")
#define PG8_WAIT_L(n) asm volatile("s_waitcnt lgkmcnt(" #n ")" ::: "memory")
#define PG8_BAR __builtin_amdgcn_s_barrier()
#define PG8_SCHED __builtin_amdgcn_sched_barrier(0)
#define PG8_AOFFS(dst, u) do { _Pragma("unroll") for (int _h = 0; _h < 2; ++_h) _Pragma("unroll") for (int _i = 0; _i < 2; ++_i) dst[_h][_i] = S.arow(u, _h * HALF + sR[_i]) + sC[_i]; } while (0)
    Unit cur, nxt; int ui = 0;
    if (!S.next(0, cur)) return;
    E.prefetch(cur, wr, fr);
    f32x4 acc[2][2][4][2];
#pragma unroll
    for (int a = 0; a < 2; ++a)
#pragma unroll
        for (int b = 0; b < 2; ++b)
#pragma unroll
            for (int m = 0; m < 4; ++m)
#pragma unroll
                for (int n = 0; n < 2; ++n) acc[a][b][m][n] = (f32x4){0.f, 0.f, 0.f, 0.f};
    bf16x8 At[4][2], B0[2][2], B1[2][2];
    unsigned cAo[2][2], nAo[2][2];
    PG8_AOFFS(cAo, cur);
    const char* cB = S.bbase(cur);
    PG8_STAGE(PG8_SB(0, 0), cB, voffB); PG8_STAGE(PG8_SB(0, 1), cB + hstep, voffB); PG8_STAGE_A(PG8_SA(0, 0), cAo, 0, 0u); PG8_STAGE_A(PG8_SA(0, 1), cAo, 1, 0u);
    if (wr == 1) PG8_BAR;
    PG8_WAIT_V(2); PG8_BAR;
    PG8_STAGE(PG8_SB(1, 0), cB + kstep, voffB); PG8_STAGE_A(PG8_SA(1, 0), cAo, 0, kstep); PG8_STAGE(PG8_SB(1, 1), cB + hstep + kstep, voffB);
    PG8_WAIT_V(6); PG8_BAR;
    for (;;) {
        const bool has_next = S.next(ui + 1, nxt);
        const char* nB = cB;
        if (has_next) { PG8_AOFFS(nAo, nxt); nB = S.bbase(nxt); }
        else {
#pragma unroll
            for (int _h = 0; _h < 2; ++_h)
#pragma unroll
                for (int _i = 0; _i < 2; ++_i) nAo[_h][_i] = cAo[_h][_i];
        }
#pragma unroll 1
        for (int t = 0; t < nt; t += 2) {
            const bool last = (t == nt - 2);
            const unsigned k1 = (unsigned)(t + 1) * kstep, k2 = last ? 0u : (unsigned)(t + 2) * kstep, k3 = k2 + kstep;
            unsigned xAo[2][2];
#pragma unroll
            for (int _h = 0; _h < 2; ++_h)
#pragma unroll
                for (int _i = 0; _i < 2; ++_i) xAo[_h][_i] = last ? nAo[_h][_i] : cAo[_h][_i];
            const char* b2 = last ? nB : cB + (size_t)(t + 2) * kstep; const char* b3 = b2 + kstep;
            PG8_LDB(B0, 0, 0); PG8_LDB(B1, 0, 1); PG8_SCHED; PG8_LDA(At, 0, 0); PG8_STAGE_A(PG8_SA(1, 1), cAo, 1, k1);
            PG8_WAIT_V(8); PG8_WAIT_L(0); PG8_BAR; PG8_MMA(0, 0, At, B0); PG8_MMA(0, 1, At, B1); PG8_BAR; PG8_SCHED;
            PG8_LDA(At, 0, 1); PG8_STAGE(PG8_SB(0, 0), b2, voffB); PG8_STAGE(PG8_SB(0, 1), b2 + hstep, voffB); PG8_STAGE_A(PG8_SA(0, 0), xAo, 0, k2);
            PG8_WAIT_V(8); PG8_WAIT_L(0); PG8_BAR; PG8_MMA(1, 0, At, B0); PG8_MMA(1, 1, At, B1); PG8_BAR; PG8_SCHED;
            PG8_LDB(B0, 1, 0); PG8_LDB(B1, 1, 1); PG8_SCHED; PG8_LDA(At, 1, 0); PG8_STAGE_A(PG8_SA(0, 1), xAo, 1, k2);
            PG8_WAIT_V(8); PG8_WAIT_L(0); PG8_BAR; PG8_MMA(0, 0, At, B0); PG8_MMA(0, 1, At, B1); PG8_BAR; PG8_SCHED;
            PG8_LDA(At, 1, 1); PG8_STAGE(PG8_SB(1, 0), b3, voffB); PG8_STAGE(PG8_SB(1, 1), b3 + hstep, voffB); PG8_STAGE_A(PG8_SA(1, 0), xAo, 0, k3);
            PG8_WAIT_V(8); PG8_WAIT_L(0); PG8_BAR; PG8_MMA(1, 0, At, B0); PG8_MMA(1, 1, At, B1); PG8_BAR; PG8_SCHED;
        }
        if constexpr (ALIGN_EPI) { if (wr == 0) PG8_BAR; }
        E(acc, cur, wr, wc, fr, fq);
        if (!has_next) break;
        E.prefetch(nxt, wr, fr);
#pragma unroll
        for (int a = 0; a < 2; ++a)
#pragma unroll
            for (int b = 0; b < 2; ++b)
#pragma unroll
                for (int m = 0; m < 4; ++m)
#pragma unroll
                    for (int n = 0; n < 2; ++n) acc[a][b][m][n] = (f32x4){0.f, 0.f, 0.f, 0.f};
        cur = nxt; cB = nB; ++ui;
#pragma unroll
        for (int _h = 0; _h < 2; ++_h)
#pragma unroll
            for (int _i = 0; _i < 2; ++_i) cAo[_h][_i] = nAo[_h][_i];
        if constexpr (ALIGN_EPI) { if (wr == 1) PG8_BAR; }
    }
    PG8_WAIT_V(0);
    if constexpr (!ALIGN_EPI) { if (wr == 0) PG8_BAR; }
    PG8_BAR;
#undef PG8_SA
#undef PG8_SB
#undef PG8_STAGE
#undef PG8_STAGE_A
#undef PG8_LDA
#undef PG8_LDB
#undef PG8_MMA
#undef PG8_WAIT_V
#undef PG8_WAIT_L
#undef PG8_BAR
#undef PG8_SCHED
#undef PG8_AOFFS
}

struct EpiProj {
    static constexpr bool PERM = true;
    __device__ __forceinline__ void prefetch(const Unit&, int, int) const {}
    __device__ __forceinline__ void rotate() const {}
    bf16* O; int ldc;
    __device__ __forceinline__ void operator()(const f32x4 (&acc)[2][2][4][2], const Unit& u, int wr, int wc, int fr, int fq) const {
        const int row0 = u.pm * BM + wr * 64 + fr, col0 = u.pn * BM + wc * 32 + 8 * fq;
#pragma unroll
        for (int ai = 0; ai < 2; ++ai)
#pragma unroll
            for (int m = 0; m < 4; ++m) { bf16* rowp = O + (size_t)(row0 + ai * HALF + m * 16) * ldc + col0;
#pragma unroll
                for (int bj = 0; bj < 2; ++bj) { const f32x4 v0 = acc[ai][bj][m][0], v1 = acc[ai][bj][m][1];
                    u32x4 w; w.x = cvt_pk_bf16(v0[0], v0[1]); w.y = cvt_pk_bf16(v0[2], v0[3]); w.z = cvt_pk_bf16(v1[0], v1[1]); w.w = cvt_pk_bf16(v1[2], v1[3]);
                    *(u32x4*)(rowp + bj * HALF) = w; } }
    }
};
struct EpiOut {
    static constexpr bool PERM = true;
    __device__ __forceinline__ void prefetch(const Unit&, int, int) const {}
    __device__ __forceinline__ void rotate() const {}
    bf16* xm; const float* MOD;
    __device__ __forceinline__ void operator()(const f32x4 (&acc)[2][2][4][2], const Unit& u, int wr, int wc, int fr, int fq) const {
        const int row0 = u.pm * BM + wr * 64 + fr, col0 = u.pn * BM + wc * 32 + 8 * fq;
        const float* gt = MOD + ((u.pm * BM) >> 13) * 6144 + 2048 + col0;
        f32x4 gv[2][2];
#pragma unroll
        for (int bj = 0; bj < 2; ++bj)
#pragma unroll
            for (int n = 0; n < 2; ++n) gv[bj][n] = *(const f32x4*)(gt + bj * HALF + n * 4);
#pragma unroll
        for (int ai = 0; ai < 2; ++ai)
#pragma unroll
            for (int m = 0; m < 4; ++m) { const size_t off = (size_t)(row0 + ai * HALF + m * 16) * 1024 + col0;
#pragma unroll
                for (int bj = 0; bj < 2; ++bj) {
                    const f32x4 v0 = gv[bj][0] * acc[ai][bj][m][0], v1 = gv[bj][1] * acc[ai][bj][m][1];
                    u32x4 w; w.x = cvt_pk_bf16(v0[0], v0[1]); w.y = cvt_pk_bf16(v0[2], v0[3]); w.z = cvt_pk_bf16(v1[0], v1[1]); w.w = cvt_pk_bf16(v1[2], v1[3]);
                    *(u32x4*)(xm + off + bj * HALF) = w; } }
    }
};

struct SchedMoE1 {
    const PG8_LAS int* tp; const PG8_LAS int* cnt; const int* LIST; const bf16* W; int G, c;
    __device__ __forceinline__ bool next(int i, Unit& u) const {
        const int NU = 2 * tp[32]; int L;
        if (G % 8 == 0) { const int per = (NU + 7) >> 3, x = c & 7; L = x * per + (c >> 3) + (G >> 3) * i; if (L >= min((x + 1) * per, NU)) return false; }
        else { L = i * G + c; if (L >= NU) return false; }
        const int rt = L >> 1; const int e = ((const PG8_LAS unsigned char*)(tp + 96))[rt];
        u.pm = rt; u.pn = L & 1; u.e = e; u.ti = rt - tp[e]; return true;
    }
    __device__ __forceinline__ unsigned arow(const Unit& u, int r) const { const int i = u.ti * 256 + r, ii = i < cnt[u.e] ? i : 0; return (unsigned)(LIST[2 * (u.e * T + ii)] >> 1) * 1024u; }
    __device__ __forceinline__ const char* bbase(const Unit& u) const { return (const char*)W + ((size_t)u.e * 512 + u.pn * 256) * 1024; }
};
struct EpiSwiglu {
    static constexpr bool PERM = true;
    __device__ __forceinline__ void prefetch(const Unit&, int, int) const {}
    __device__ __forceinline__ void rotate() const {}
    bf16* HID;
    __device__ __forceinline__ void operator()(const f32x4 (&acc)[2][2][4][2], const Unit& u, int wr, int wc, int fr, int fq) const {
#pragma unroll
        for (int ai = 0; ai < 2; ++ai)
#pragma unroll
            for (int m = 0; m < 4; ++m) {
                float h[8];
#pragma unroll
                for (int n = 0; n < 2; ++n)
#pragma unroll
                    for (int q = 0; q < 4; ++q) { const float a = acc[ai][0][m][n][q] * (1.f / 32.f), uu = acc[ai][1][m][n][q] * (1.f / 32.f); h[n * 4 + q] = a * frcp(1.f + __expf(-a)) * uu; }
                unsigned w0 = 0, w1 = 0;
                w0 = __builtin_amdgcn_cvt_pk_fp8_f32(4.f * h[0], 4.f * h[1], w0, false); w0 = __builtin_amdgcn_cvt_pk_fp8_f32(4.f * h[2], 4.f * h[3], w0, true);
                w1 = __builtin_amdgcn_cvt_pk_fp8_f32(4.f * h[4], 4.f * h[5], w1, false); w1 = __builtin_amdgcn_cvt_pk_fp8_f32(4.f * h[6], 4.f * h[7], w1, true);
                *(unsigned long long*)((unsigned char*)HID + (size_t)(u.pm * BM + ai * HALF + wr * 64 + m * 16 + fr) * 256 + u.pn * 128 + wc * 32 + 8 * fq) = (unsigned long long)w0 | ((unsigned long long)w1 << 32);
            }
    }
};
struct SchedMoE2 {
    const PG8_LAS int* tp; const bf16* W; int G, c;
    __device__ __forceinline__ bool next(int i, Unit& u) const {
        const int NU = 4 * tp[32]; int L;
        if (G % 8 == 0) { const int per = (NU + 7) >> 3, x = c & 7; L = x * per + (c >> 3) + (G >> 3) * i; if (L >= min((x + 1) * per, NU)) return false; }
        else { L = i * G + c; if (L >= NU) return false; }
        const int rt = L >> 2; const int e = ((const PG8_LAS unsigned char*)(tp + 96))[rt];
        u.pm = rt; u.pn = L & 3; u.e = e; u.ti = rt - tp[e]; return true;
    }
    __device__ __forceinline__ unsigned arow(const Unit& u, int r) const { return (unsigned)(u.pm * BM + r) * 256u; }
    __device__ __forceinline__ const char* bbase(const Unit& u) const { return (const char*)W + ((size_t)u.e * 1024 + u.pn * 256) * 256; }
};
struct EpiScatter {
    static constexpr bool PERM = true;
    bf16* Y; const PG8_LAS int* cnt; const int* LIST;
    typedef int i32x2 __attribute__((ext_vector_type(2)));
    mutable i32x2 cu[8];
    __device__ __forceinline__ void prefetch(const Unit& u, int wr, int fr) const {
        const int ce = cnt[u.e];
#pragma unroll
        for (int q = 0; q < 8; ++q) { const int i = u.ti * 256 + (q >> 2) * HALF + wr * 64 + (q & 3) * 16 + fr;
            cu[q] = *(const i32x2*)(LIST + 2 * (size_t)(u.e * T + (i < ce ? i : 0))); if (i >= ce) cu[q].x = -1; }
    }
    __device__ __forceinline__ void rotate() const {}
    __device__ __forceinline__ void operator()(const f32x4 (&acc)[2][2][4][2], const Unit& u, int wr, int wc, int fr, int fq) const {
#pragma unroll
        for (int ai = 0; ai < 2; ++ai)
#pragma unroll
            for (int m = 0; m < 4; ++m) {
                const int tok2 = cu[ai * 4 + m].x; const float r = __int_as_float(cu[ai * 4 + m].y) * (1.f / 64.f);
                if (tok2 >= 0) {
                    bf16* rowp = Y + (size_t)tok2 * 1024 + u.pn * BM + wc * 32 + 8 * fq;
#pragma unroll
                    for (int bj = 0; bj < 2; ++bj) { const f32x4 v0 = acc[ai][bj][m][0] * r, v1 = acc[ai][bj][m][1] * r;
                        u32x4 w; w.x = cvt_pk_bf16(v0[0], v0[1]); w.y = cvt_pk_bf16(v0[2], v0[3]); w.z = cvt_pk_bf16(v1[0], v1[1]); w.w = cvt_pk_bf16(v1[2], v1[3]);
                        *(u32x4*)(rowp + bj * HALF) = w; }
                }
            }
    }
};
}


namespace gla {
typedef short bf16x8 __attribute__((ext_vector_type(8)));
typedef float f32x16 __attribute__((ext_vector_type(16)));
typedef __attribute__((address_space(3))) unsigned char lds_t;
typedef __attribute__((address_space(3))) float lf;
typedef __attribute__((address_space(3))) unsigned short lus;
typedef __attribute__((address_space(3))) v4u lv4;
constexpr int LS = 144;
constexpr int O_VT = 0;
constexpr int O_QB = 18432;
constexpr int O_KB = 27648;
constexpr int O_KT = 36864;
constexpr int O_P = 46080;
constexpr int O_OUT = O_QB, OUT_LD = 132;
constexpr int O_ST = 55296;
constexpr int O_DEC = 73728;
constexpr int O_CS = 74240, O_CSB = 76288;
constexpr int O_ALS = 78336;
constexpr int O_RK = 86528, O_RQ = 95744;
constexpr int O_RV = 104960, RVS = 272;
static_assert(64 * OUT_LD * 4 <= 4 * 9216 && O_RV + 64 * RVS <= MISC_OFF, "gla LDS map");

__device__ __forceinline__ unsigned bfr(float f) { return f2bf(f); }

__device__ __forceinline__ f32x16 mm_tile(const lds_t* A, const lds_t* B, f32x16 acc, int lane) {
    const int off = (lane & 31) * LS + (lane >> 5) * 16;
#pragma unroll
    for (int s = 0; s < 4; ++s) {
        const bf16x8 a = *(const __attribute__((address_space(3))) bf16x8*)(A + off + s * 32);
        const bf16x8 b = *(const __attribute__((address_space(3))) bf16x8*)(B + off + s * 32);
        acc = __builtin_amdgcn_mfma_f32_32x32x16_bf16(a, b, acc, 0, 0, 0);
    }
    return acc;
}

struct Raw { v4u k, q, v0, v1; f32x4 al; };
template <bool NEEDQ, bool BOTH>
__device__ __forceinline__ void raw_load(Raw& R, const bf16* PROJ, const float* ALOW, int r0, int h, int dir, int tid) {
    const size_t row = (size_t)(r0 + (tid >> 3));
    R.k = *(const v4u*)(PROJ + row * NPROJ + PK + h * 64 + (tid & 7) * 8);
    if (NEEDQ) R.q = *(const v4u*)(PROJ + row * NPROJ + PQ + h * 64 + (tid & 7) * 8);
    R.v0 = *(const v4u*)(PROJ + row * NPROJ + PV + h * 128 + (tid & 7) * 16);
    R.v1 = *(const v4u*)(PROJ + row * NPROJ + PV + h * 128 + (tid & 7) * 16 + 8);
    if (BOTH) R.al = *(const f32x4*)(ALOW + row * 32 + (tid & 7) * 4);
    else if (tid < 256) R.al = *(const f32x4*)(ALOW + (size_t)(r0 + (tid >> 2)) * 32 + dir * 16 + (tid & 3) * 4);
}
template <bool NEEDQ, bool BOTH>
__device__ __forceinline__ void raw_stage(lds_t* L, const Raw& R, int tid) {
    const int j = tid >> 3, c = tid & 7;
    *(lv4*)(L + O_RK + j * LS + c * 16) = R.k;
    if (NEEDQ) *(lv4*)(L + O_RQ + j * LS + c * 16) = R.q;
    *(lv4*)(L + O_RV + j * RVS + c * 32) = R.v0;
    *(lv4*)(L + O_RV + j * RVS + c * 32 + 16) = R.v1;
    if (BOTH) *(__attribute__((address_space(3))) f32x4*)((lf*)(L + O_ALS) + j * 32 + c * 4) = R.al;
    else if (tid < 256) *(__attribute__((address_space(3))) f32x4*)((lf*)(L + O_ALS) + tid * 4) = R.al;
}
__device__ __forceinline__ void v_transpose(lds_t* L, int tid) {
    const int e = tid & 127, tg = tid >> 7;
    unsigned vr[16];
#pragma unroll
    for (int jj = 0; jj < 16; ++jj) vr[jj] = *(const lus*)(L + O_RV + (16 * tg + jj) * RVS + e * 2);
    v4u w0, w1;
    w0.x = vr[0] | (vr[1] << 16); w0.y = vr[2] | (vr[3] << 16); w0.z = vr[4] | (vr[5] << 16); w0.w = vr[6] | (vr[7] << 16);
    w1.x = vr[8] | (vr[9] << 16); w1.y = vr[10] | (vr[11] << 16); w1.z = vr[12] | (vr[13] << 16); w1.w = vr[14] | (vr[15] << 16);
    *(lv4*)(L + O_VT + e * LS + tg * 32) = w0;
    *(lv4*)(L + O_VT + e * LS + tg * 32 + 16) = w1;
}
template <int ALD>
__device__ __forceinline__ float la_cum(const lds_t* L, int to, int dir, int aoff, const float (&wd)[16], float bd, float (&bl)[8]) {
    const lf* ALS = (const lf*)(L + O_ALS);
    float cum = 0.f;
#pragma unroll
    for (int s2 = 0; s2 < 8; ++s2) {
        const int jj = dir ? 7 - s2 : s2, j = 8 * to + jj;
        float z = bd;
#pragma unroll
        for (int r4 = 0; r4 < 4; ++r4) { const f32x4 a = *(const __attribute__((address_space(3))) f32x4*)(ALS + j * ALD + aoff + r4 * 4);
            z += a.x * wd[r4 * 4] + a.y * wd[r4 * 4 + 1] + a.z * wd[r4 * 4 + 2] + a.w * wd[r4 * 4 + 3]; }
        const float la = (fminf(z, 0.f) - __logf(1.f + __expf(-fabsf(z)))) * (1.f / 16.f);
        cum += la; bl[jj] = cum;
    }
    return cum;
}
__device__ __forceinline__ void cs_combine(const lf* CS, int d, int to, int dir, float& offs, float& tot) {
    offs = 0.f; tot = 0.f;
#pragma unroll
    for (int o = 0; o < 8; ++o) { const float c = CS[o * 64 + d]; tot += c; if (dir ? (o > to) : (o < to)) offs += c; }
}

__device__ __forceinline__ void write_st(lds_t* L, const f32x16& S, int db, int eb, int lane) {
    const int e = 32 * eb + (lane & 31), hh = lane >> 5;
#pragma unroll
    for (int g = 0; g < 4; ++g) {
        const unsigned lo = pk2(S[4 * g], S[4 * g + 1]), hi = pk2(S[4 * g + 2], S[4 * g + 3]);
        *(__attribute__((address_space(3))) unsigned long long*)(L + O_ST + e * LS + (32 * db + 8 * g + 4 * hh) * 2) = (unsigned long long)lo | ((unsigned long long)hi << 32);
    }
}
__device__ __forceinline__ void scale_rows(lds_t* L, f32x16& S, int db, int lane) {
    const int hh = lane >> 5;
#pragma unroll
    for (int g = 0; g < 4; ++g) { const f32x4 dv = *(const __attribute__((address_space(3))) f32x4*)(L + O_DEC + (32 * db + 8 * g + 4 * hh) * 4);
        S[4 * g] *= dv.x; S[4 * g + 1] *= dv.y; S[4 * g + 2] *= dv.z; S[4 * g + 3] *= dv.w; }
}

__device__ __forceinline__ void state_unit(const Params& p, lds_t* L, int b, int si, int h) {
    const int tid = ltid(), lane = tid & 63, w = tid >> 6, hh = lane >> 5, d = lane, to = w;
    const bf16* PROJ = (const bf16*)(p.ws + WS_PROJ); const float* ALOW = (const float*)(p.ws + WS_ALOW);
    float* DST = (float*)(p.ws + WS_DST); float* DEC = (float*)(p.ws + WS_DEC);
    const float* w_dec = p.in[8]; const float* b_dec = p.in[9];
    const int db = w >> 2, eb = w & 3, base = si < 4 ? T + b * CTXL + 64 * si : b * SEQ + (si - 4) * 256, nch = si < 4 ? 1 : 4;
    float wf[16], wb[16];
#pragma unroll
    for (int r = 0; r < 16; ++r) { wf[r] = w_dec[r * 256 + h * 64 + d]; wb[r] = w_dec[4096 + r * 256 + h * 64 + d]; }
    const float bdf = b_dec[h * 64 + d], bdb = b_dec[256 + h * 64 + d];
    f32x16 Sf, Sb;
#pragma unroll
    for (int q = 0; q < 16; ++q) { Sf[q] = 0.f; Sb[q] = 0.f; }
    float pf = 1.f, pb = 1.f;
    Raw R;
    __syncthreads();
    raw_load<false, true>(R, PROJ, ALOW, base, h, 0, tid);
    raw_stage<false, true>(L, R, tid);
    __syncthreads();
#pragma unroll 1
    for (int c = 0; c < nch; ++c) {
        if (c + 1 < nch) raw_load<false, true>(R, PROJ, ALOW, base + 64 * (c + 1), h, 0, tid);
        float blf[8], blb[8];
        const float cf = la_cum<32>(L, to, 0, 0, wf, bdf, blf), cb = la_cum<32>(L, to, 1, 16, wb, bdb, blb);
        ((lf*)(L + O_CS))[to * 64 + d] = cf; ((lf*)(L + O_CSB))[to * 64 + d] = cb;
        __syncthreads();
        float of, tf, ob, tb;
        cs_combine((const lf*)(L + O_CS), d, to, 0, of, tf); cs_combine((const lf*)(L + O_CSB), d, to, 1, ob, tb);
        if (to == 0) ((lf*)(L + O_DEC))[d] = __expf(tf);
        float kf[8], kb[8];
#pragma unroll
        for (int jj = 0; jj < 8; ++jj) {
            const float k = bf2f(*(const lus*)(L + O_RK + (8 * to + jj) * LS + d * 2));
            kf[jj] = k * __expf(tf - (blf[jj] + of));
            kb[jj] = k * __expf(tb - (blb[jj] + ob)) * pb;
        }
        { v4u x; x.x = pk2(kf[0], kf[1]); x.y = pk2(kf[2], kf[3]); x.z = pk2(kf[4], kf[5]); x.w = pk2(kf[6], kf[7]); *(lv4*)(L + O_KT + d * LS + to * 16) = x; }
        { v4u x; x.x = pk2(kb[0], kb[1]); x.y = pk2(kb[2], kb[3]); x.z = pk2(kb[4], kb[5]); x.w = pk2(kb[6], kb[7]); *(lv4*)(L + O_KB + d * LS + to * 16) = x; }
        pf *= __expf(tf); pb *= __expf(tb);
        v_transpose(L, tid);
        __syncthreads();
        scale_rows(L, Sf, db, lane);
        Sf = mm_tile(L + O_KT + 32 * db * LS, L + O_VT + 32 * eb * LS, Sf, lane);
        Sb = mm_tile(L + O_KB + 32 * db * LS, L + O_VT + 32 * eb * LS, Sb, lane);
        if (c + 1 < nch) raw_stage<false, true>(L, R, tid);
        __syncthreads();
    }
    const int uf = ((0 * NB + b) * NSI + si) * 4 + h, ub = ((1 * NB + b) * NSI + si) * 4 + h;
#pragma unroll
    for (int q = 0; q < 16; ++q) { const int dl = (q & 3) + 8 * (q >> 2) + 4 * hh; const size_t o = (size_t)(32 * db + dl) * 128 + 32 * eb + (lane & 31);
        DST[(size_t)uf * 8192 + o] = Sf[q]; DST[(size_t)ub * 8192 + o] = Sb[q]; }
    if (to == 0) { DEC[uf * 64 + d] = pf; DEC[ub * 64 + d] = pb; }
}

template <int DIR>
__device__ __forceinline__ void out_pass(const Params& p, lds_t* L, int b, int sc, int h) {
    const int tid = ltid(), lane = tid & 63, w = tid >> 6, hh = lane >> 5, d = lane, to = w;
    const bf16* PROJ = (const bf16*)(p.ws + WS_PROJ); const float* ALOW = (const float*)(p.ws + WS_ALOW);
    const float* SPREV = (const float*)(p.ws + WS_SPREV); bf16* MIX = (bf16*)(p.ws + WS_MIX); float* OACC = (float*)(p.ws + WS_H);
    const float* w_dec = p.in[8]; const float* b_dec = p.in[9]; const float* gng = p.in[10];
    const int ib = w >> 2, eb = w & 3, base = b * SEQ + sc * 256;
    float wd[16];
#pragma unroll
    for (int r = 0; r < 16; ++r) wd[r] = w_dec[DIR * 4096 + r * 256 + h * 64 + d];
    const float bd = b_dec[DIR * 256 + h * 64 + d];
    const int u = ((DIR * NB + b) * 32 + sc) * 4 + h;
    f32x16 S;
#pragma unroll
    for (int q = 0; q < 16; ++q) { const int dl = (q & 3) + 8 * (q >> 2) + 4 * hh; S[q] = SPREV[(size_t)u * 8192 + (32 * ib + dl) * 128 + 32 * eb + (lane & 31)]; }
    float gnv[16];
    if (DIR == 0) {
#pragma unroll
        for (int q = 0; q < 16; ++q) gnv[q] = gng[(tid & 7) * 16 + q];
    }
    Raw R;
    __syncthreads();
    raw_load<true, false>(R, PROJ, ALOW, base + (DIR ? 192 : 0), h, DIR, tid);
    write_st(L, S, ib, eb, lane);
    raw_stage<true, false>(L, R, tid);
    __syncthreads();
#pragma unroll 1
    for (int cc = 0; cc < 4; ++cc) {
        const int c = DIR ? 3 - cc : cc, r0 = base + 64 * c;
        if (cc < 3) raw_load<true, false>(R, PROJ, ALOW, base + 64 * (DIR ? 2 - cc : cc + 1), h, DIR, tid);
        float* oa = OACC + (size_t)(r0 + 32 * ib + 4 * hh) * 512 + h * 128 + 32 * eb + (lane & 31);
        float ob[16]; v4u g0, g1;
        if (DIR == 0) {
#pragma unroll
            for (int q = 0; q < 16; ++q) ob[q] = oa[(size_t)((q & 3) + 8 * (q >> 2)) * 512];
            const size_t grow = (size_t)(r0 + (tid >> 3));
            g0 = *(const v4u*)(PROJ + grow * NPROJ + PG + h * 128 + (tid & 7) * 16); g1 = *(const v4u*)(PROJ + grow * NPROJ + PG + h * 128 + (tid & 7) * 16 + 8);
        }
        float bl[8];
        const float cum = la_cum<16>(L, to, DIR, 0, wd, bd, bl);
        ((lf*)(L + O_CS))[to * 64 + d] = cum;
        __syncthreads();
        float offs, tot; cs_combine((const lf*)(L + O_CS), d, to, DIR, offs, tot);
        const float dec = __expf(tot);
        if (to == 0) ((lf*)(L + O_DEC))[d] = dec;
        float kt[8];
#pragma unroll
        for (int jj = 0; jj < 8; ++jj) {
            const int j = 8 * to + jj;
            const float bq = bl[jj] + offs, E = __expf(bq), Einv = frcp(E);
            const float kf = bf2f(*(const lus*)(L + O_RK + j * LS + d * 2)) * Einv;
            const unsigned kq = pk2(kf, bf2f(*(const lus*)(L + O_RQ + j * LS + d * 2)) * 0.125f * E);
            *(lus*)(L + O_KB + j * LS + d * 2) = (unsigned short)kq;
            *(lus*)(L + O_QB + j * LS + d * 2) = (unsigned short)(kq >> 16);
            kt[jj] = kf * dec;
        }
        { v4u x; x.x = pk2(kt[0], kt[1]); x.y = pk2(kt[2], kt[3]); x.z = pk2(kt[4], kt[5]); x.w = pk2(kt[6], kt[7]); *(lv4*)(L + O_KT + d * LS + to * 16) = x; }
        v_transpose(L, tid);
        __syncthreads();
        if (w < 4) {
            const int pi = w >> 1, pj = w & 1;
            f32x16 pa;
#pragma unroll
            for (int q = 0; q < 16; ++q) pa[q] = 0.f;
            const bool dead = DIR ? (pj < pi) : (pj > pi);
            if (!dead) pa = mm_tile(L + O_QB + 32 * pi * LS, L + O_KB + 32 * pj * LS, pa, lane);
            const int jl = lane & 31;
#pragma unroll
            for (int q = 0; q < 16; q += 2) {
                const int il = (q & 3) + 8 * (q >> 2) + 4 * hh;
                float v0 = pa[q], v1 = pa[q + 1];
                if (pi == pj) { if (DIR ? (jl < il) : (jl > il)) v0 = 0.f; if (DIR ? (jl < il + 1) : (jl > il + 1)) v1 = 0.f; }
                const unsigned pw = pk2(v0, v1);
                *(lus*)(L + O_P + (32 * pi + il) * LS + (32 * pj + jl) * 2) = (unsigned short)pw;
                *(lus*)(L + O_P + (32 * pi + il + 1) * LS + (32 * pj + jl) * 2) = (unsigned short)(pw >> 16);
            }
        }
        __syncthreads();
        f32x16 o;
#pragma unroll
        for (int q = 0; q < 16; ++q) o[q] = 0.f;
        o = mm_tile(L + O_P + 32 * ib * LS, L + O_VT + 32 * eb * LS, o, lane);
        o = mm_tile(L + O_QB + 32 * ib * LS, L + O_ST + 32 * eb * LS, o, lane);
        scale_rows(L, S, ib, lane);
        S = mm_tile(L + O_KT + 32 * ib * LS, L + O_VT + 32 * eb * LS, S, lane);
        __syncthreads();
        write_st(L, S, ib, eb, lane);
        if (cc < 3) raw_stage<true, false>(L, R, tid);
        if (DIR == 1) {
#pragma unroll
            for (int q = 0; q < 16; ++q) oa[(size_t)((q & 3) + 8 * (q >> 2)) * 512] = o[q];
            __syncthreads();
        } else {
            lf* OUT = (lf*)(L + O_OUT);
#pragma unroll
            for (int q = 0; q < 16; ++q) { const int il = (q & 3) + 8 * (q >> 2) + 4 * hh; OUT[(32 * ib + il) * OUT_LD + 32 * eb + (lane & 31)] = o[q] + ob[q]; }
            __syncthreads();
            const int i = tid >> 3, e0 = (tid & 7) * 16;
            float v[16]; float ss = 0.f;
#pragma unroll
            for (int q4 = 0; q4 < 4; ++q4) { const f32x4 t = *(const __attribute__((address_space(3))) f32x4*)(OUT + i * OUT_LD + e0 + q4 * 4);
                v[q4 * 4] = t.x; v[q4 * 4 + 1] = t.y; v[q4 * 4 + 2] = t.z; v[q4 * 4 + 3] = t.w; ss += t.x * t.x + t.y * t.y + t.z * t.z + t.w * t.w; }
            ss += __shfl_xor(ss, 1); ss += __shfl_xor(ss, 2); ss += __shfl_xor(ss, 4);
            const float r = frsq(ss * (1.f / 128.f) + EPS);
            const size_t row = (size_t)(r0 + i);
            unsigned ow[8];
#pragma unroll
            for (int q = 0; q < 8; ++q) {
                const unsigned gw = q < 4 ? g0[q] : g1[q - 4];
                const float ga = __uint_as_float(gw << 16), gb = __uint_as_float(gw & 0xffff0000u);
                const float ya = v[2 * q] * r * gnv[2 * q] * (ga * frcp(1.f + __expf(-ga))), yb = v[2 * q + 1] * r * gnv[2 * q + 1] * (gb * frcp(1.f + __expf(-gb)));
                ow[q] = pk2(ya, yb);
            }
            v4u o0, o1; o0.x = ow[0]; o0.y = ow[1]; o0.z = ow[2]; o0.w = ow[3]; o1.x = ow[4]; o1.y = ow[5]; o1.z = ow[6]; o1.w = ow[7];
            *(v4u*)(MIX + row * 1024 + h * 128 + e0) = o0; *(v4u*)(MIX + row * 1024 + h * 128 + e0 + 8) = o1;
        }
    }
}
}

namespace pool {
typedef __attribute__((address_space(3))) unsigned char lds_t;
typedef __attribute__((address_space(3))) float lf;
constexpr int V_LD = 132, O_V0 = 0, O_V1 = 33792;
constexpr int PD_LS = 272;
constexpr int O_XG = 67584;
constexpr int O_PD = 102400;
static_assert(O_PD + 128 * PD_LS <= MISC_OFF, "pool LDS map");

template <int GI> struct PX { v4u x[2][(2 << GI) + 1]; };
template <int GI>
__device__ __forceinline__ void gload(PX<GI>& X, const Params& p, int b, int r0) {
    const int tid = ltid(), lane = tid & 63, wv = tid >> 6, co = lane & 15;
    const bf16* PROJ = (const bf16*)(p.ws + WS_PROJ);
    constexpr int w = 2 << GI, lo = w >> 1;
#pragma unroll
    for (int h2 = 0; h2 < 2; ++h2) {
        const int c = 8 * wv + 4 * h2 + (lane >> 4);
        const bf16* src = PROJ + (size_t)(b * SEQ + c) * NPROJ + PP + GI * 128 + 8 * co;
#pragma unroll
        for (int t = 0; t <= w; ++t) { const int r2 = min(max(r0 - lo + t, 0), 127); X.x[h2][t] = *(const v4u*)(src + (size_t)r2 * 64 * NPROJ); }
    }
}
template <int GI, class NX>
__device__ __forceinline__ void group(const Params& p, lds_t* L, int b, int r0, int tok0, PX<GI>& X, NX* nxt) {
    const int tid = ltid(), lane = tid & 63, wv = tid >> 6, hh = lane >> 5;
    const bf16* PROJ = (const bf16*)(p.ws + WS_PROJ); bf16* MIX = (bf16*)(p.ws + WS_MIX); const bf16* WPT = (const bf16*)(p.ws + WS_WPOOL);
    const float* pscale = p.in[12];
    constexpr int gi = GI, w = 2 << GI, lo = w >> 1, hi = w - 1 - lo;
    const float ps = pscale[gi * 128 + (tid & 127)];
    {
        const int co = lane & 15;
        v4u (&x)[2][w + 1] = X.x;
#pragma unroll
        for (int h2 = 0; h2 < 2; ++h2) {
            const int c = 8 * wv + 4 * h2 + (lane >> 4);
            float a0[8], a1[8];
#pragma unroll
            for (int q = 0; q < 8; ++q) { a0[q] = 0.f; a1[q] = 0.f; }
#pragma unroll
            for (int t = 0; t <= w; ++t) { const int r2 = r0 - lo + t; const float m = (r2 >= 0 && r2 < 128) ? 1.f : 0.f;
#pragma unroll
                for (int q = 0; q < 4; ++q) { const float xl = m * __uint_as_float(x[h2][t][q] << 16), xh = m * __uint_as_float(x[h2][t][q] & 0xffff0000u);
                    if (t < w) { a0[2 * q] += xl; a0[2 * q + 1] += xh; }
                    if (t > 0) { a1[2 * q] += xl; a1[2 * q + 1] += xh; } } }
            lf* v0 = (lf*)(L + O_V0) + c * V_LD + 8 * co; lf* v1 = (lf*)(L + O_V1) + c * V_LD + 8 * co;
            *(__attribute__((address_space(3))) f32x4*)v0 = (f32x4){a0[0], a0[1], a0[2], a0[3]}; *(__attribute__((address_space(3))) f32x4*)(v0 + 4) = (f32x4){a0[4], a0[5], a0[6], a0[7]};
            *(__attribute__((address_space(3))) f32x4*)v1 = (f32x4){a1[0], a1[1], a1[2], a1[3]}; *(__attribute__((address_space(3))) f32x4*)(v1 + 4) = (f32x4){a1[4], a1[5], a1[6], a1[7]};
            *(__attribute__((address_space(3))) v4u*)(L + O_XG + c * PD_LS + co * 16) = x[h2][lo];
            *(__attribute__((address_space(3))) v4u*)(L + O_XG + (64 + c) * PD_LS + co * 16) = x[h2][lo + 1];
        }
    }
    __syncthreads();
    if constexpr (GI < 3) gload<GI + 1>(*nxt, p, b, r0);
#pragma unroll
    for (int rr = 0; rr < 2; ++rr) {
        const int r = r0 + rr, rs = max(r - lo, 0), re = min(r + hi + 1, 128);
        const int ch = tid & 127, c0 = 16 * (tid >> 7);
        const lf* V = (const lf*)(L + (rr ? O_V1 : O_V0)) + ch;
        const float invr = 1.f / (float)(re - rs);
        float sacc = 0.f;
        for (int c2 = max(c0 - lo, 0); c2 <= min(c0 + hi, 63); ++c2) sacc += V[c2 * V_LD];
#pragma unroll 4
        for (int ci = 0; ci < 16; ++ci) {
            const int c = c0 + ci;
            if (ci > 0) { const int ad = c + hi, rm = c - lo - 1; if (ad < 64) sacc += V[ad * V_LD]; if (rm >= 0) sacc -= V[rm * V_LD]; }
            const int cs = max(c - lo, 0), ce = min(c + hi + 1, 64);
            const float m = sacc * invr / (float)(ce - cs);
            const float x = bf2f(*(const __attribute__((address_space(3))) unsigned short*)(L + O_XG + (64 * rr + c) * PD_LS + ch * 2));
            MIX[(size_t)(tok0 + 64 * rr + c) * 1024 + 512 + gi * 128 + ch] = (bf16)f2bf((m - x) * ps);
        }
    }
    __syncthreads();
}
__device__ __forceinline__ void unit(const Params& p, lds_t* L, int b, int rp) {
    const int r0 = 2 * rp, tok0 = b * SEQ + r0 * 64;
    PX<0> x0; gload<0>(x0, p, b, r0);
    __syncthreads();
    PX<1> x1; group<0>(p, L, b, r0, tok0, x0, &x1);
    PX<2> x2; group<1>(p, L, b, r0, tok0, x1, &x2);
    PX<3> x3; group<2>(p, L, b, r0, tok0, x2, &x3);
    group<3>(p, L, b, r0, tok0, x3, (PX<3>*)nullptr);
}
}

__device__ __forceinline__ void phase0(const Params& p, unsigned char* lds) {
    const int tid = ltid(), lane = tid & 63, wave = tid >> 6, G = gridDim.x;
    const int gtid = blockIdx.x * 512 + tid, gthreads = G * 512;
    float* MOD = (float*)(p.ws + WS_MOD);
    const float* c = p.in[1]; const float* cctx = p.in[3]; const float* w_ada = p.in[4]; const float* b_ada = p.in[5];
    {
        float* SIL = (float*)lds;
        float* RED = (float*)(lds + 20480);
        for (int i = tid; i < 5 * 1024; i += 512) { const float v = i < 4096 ? c[i] : cctx[i - 4096]; SIL[i] = silu(v); }
        __syncthreads();
        for (int task = blockIdx.x; task < 192; task += G) {
            const int kg = tid >> 5, col = tid & 31;
            float wv[64];
#pragma unroll
            for (int k = 0; k < 64; ++k) wv[k] = w_ada[(size_t)(64 * kg + k) * 6144 + 32 * task + col];
            float a[5] = {0.f, 0.f, 0.f, 0.f, 0.f};
#pragma unroll
            for (int k = 0; k < 64; ++k)
#pragma unroll
                for (int v = 0; v < 5; ++v) a[v] += SIL[v * 1024 + 64 * kg + k] * wv[k];
#pragma unroll
            for (int v = 0; v < 5; ++v) RED[(kg * 5 + v) * 32 + col] = a[v];
            __syncthreads();
            if (tid < 160) { const int v = tid >> 5; float sacc = b_ada[32 * task + col];
#pragma unroll
                for (int g = 0; g < 16; ++g) sacc += RED[(g * 5 + v) * 32 + col];
                MOD[v * 6144 + 32 * task + col] = sacc; }
            __syncthreads();
        }
    }
    const float* w_in = p.in[7];
    bf16* WA = (bf16*)(p.ws + WS_WA);
    for (int idx = gtid; idx < 32 * 1024; idx += gthreads) { const int jj = idx >> 10, k = idx & 1023; WA[idx] = (bf16)f2bf(w_in[(size_t)k * IN_COLS + OFF_A + jj]); }
    const float* w_rg = p.in[15]; const float* w_re = p.in[16];
    bf16* WRH = (bf16*)(p.ws + WS_WR); bf16* WRL = WRH + 48 * 1024;
    for (int idx = gtid; idx < 48 * 1024; idx += gthreads) { const int r = idx >> 10, k = idx & 1023;
        const float v = r < 32 ? w_re[k * 32 + r] : (r < 36 ? w_rg[k * 4 + (r - 32)] : 0.f);
        const unsigned hi = f2bf(v); WRH[idx] = (bf16)hi; WRL[idx] = (bf16)f2bf(v - bf2f(hi)); }
    {
        float* TA = (float*)lds;
        float* TB = (float*)(lds + 32768);
        bf16* WINp = (bf16*)(p.ws + WS_WIN);
        const int nfold = 64, fb = (G == 256) ? (int)blockIdx.x - 192 : (int)blockIdx.x, fs = (G == 256) ? 64 : G;
        for (int task = fb; task >= 0 && task < nfold; task += fs) {
            const int g = task >> 4, k0 = (task & 15) * 64;
            __syncthreads();
            for (int i = tid; i < 64 * 32; i += 512) { const int k = i >> 5, c4 = i & 31; *(f32x4*)(TA + k * 128 + 4 * c4) = *(const f32x4*)(p.in[7] + (size_t)(k0 + k) * IN_COLS + OFF_P + g * 128 + 4 * c4); }
            for (int i = tid; i < 128 * 32; i += 512) *(f32x4*)(TB + 4 * i) = *(const f32x4*)(p.in[11] + (size_t)g * 16384 + 4 * i);
            __syncthreads();
            const int d = tid & 127, kq = tid >> 7;
            float acc[16];
#pragma unroll
            for (int i = 0; i < 16; ++i) acc[i] = 0.f;
            for (int c = 0; c < 128; c += 4) {
                const float w0 = TB[c * 128 + d], w1 = TB[(c + 1) * 128 + d], w2 = TB[(c + 2) * 128 + d], w3 = TB[(c + 3) * 128 + d];
#pragma unroll
                for (int i = 0; i < 16; ++i) { const f32x4 a = *(const f32x4*)(TA + (kq * 16 + i) * 128 + c); acc[i] += a.x * w0 + a.y * w1 + a.z * w2 + a.w * w3; }
            }
            v4u o0, o1;
            o0.x = pk2(acc[0], acc[1]); o0.y = pk2(acc[2], acc[3]); o0.z = pk2(acc[4], acc[5]); o0.w = pk2(acc[6], acc[7]);
            o1.x = pk2(acc[8], acc[9]); o1.y = pk2(acc[10], acc[11]); o1.z = pk2(acc[12], acc[13]); o1.w = pk2(acc[14], acc[15]);
            bf16* dst = WINp + (size_t)(1536 + g * 128 + d) * 1024 + k0 + kq * 16;
            *(v4u*)dst = o0; *(v4u*)(dst + 8) = o1;
        }
        __syncthreads();
    }
    float* scr = (float*)(lds + wave * 8448);
    const int gw = blockIdx.x * 8 + wave, NGW = G * 8;
    bf16* WIN = (bf16*)(p.ws + WS_WIN); bf16* WOUT = (bf16*)(p.ws + WS_WOUT); bf16* WE1 = (bf16*)(p.ws + WS_WE1); bf16* WE2 = (bf16*)(p.ws + WS_WE2);
    const float* w_out = p.in[13]; const float* w_e_in = p.in[17]; const float* w_e_out = p.in[18];
    constexpr int I_A = 16 * 48, I_O = 16 * 32, I_E1 = 32 * 256, I_E2 = 32 * 128;
    auto desc_of = [&](int it) -> TDesc {
        int r = it;
        if (r < I_A) return tdesc(w_in, IN_COLS, 48, WIN, 1024, r); r -= I_A;
        if (r < I_O) return tdesc(w_out, 1024, 32, WOUT, 1024, r); r -= I_O;
        if (r < I_E1) { const int e = r >> 8, sub = (r >> 6) & 3, item = r & 63, pn = sub >> 1, half = sub & 1;
            const int kb = item >> 2, nb = item & 3, k0 = 64 * kb, n0 = 32 * nb;
            return TDesc{w_e_in + (size_t)e * 1024 * 512 + half * 256 + 128 * pn + (size_t)k0 * 512 + n0, 512,
                         (bf16*)((unsigned char*)WE1 + ((size_t)e * 512 + 256 * pn + 128 * half + n0) * 1024 + k0), 1024, 32}; } r -= I_E1;
        { const int e = r >> 7, item = r & 127, kb = item >> 5, nb = item & 31, k0 = 64 * kb, n0 = 32 * nb;
          return TDesc{w_e_out + (size_t)e * 256 * 1024 + (size_t)k0 * 1024 + n0, 1024, (bf16*)((unsigned char*)WE2 + ((size_t)e * 1024 + n0) * 256 + k0), 256, 16}; }
    };
    constexpr int NIT = I_A + I_O + I_E1 + I_E2;
    if (gw < NIT) {
        TDesc d = desc_of(gw); float tv[32]; titem_load(d, tv, lane);
        for (int it = gw; it < NIT; it += NGW) {
            const bool has = it + NGW < NIT;
            TDesc dn = d; float tn[32];
            if (has) { dn = desc_of(it + NGW); titem_load(dn, tn, lane); }
            titem_store(d, tv, scr, lane);
            if (has) { d = dn;
#pragma unroll
                for (int i = 0; i < 32; ++i) tv[i] = tn[i]; }
        }
    }
}

namespace skinny {
typedef __attribute__((address_space(3))) unsigned char lds_t;
typedef short bf16x8 __attribute__((ext_vector_type(8)));
constexpr int TLS = 2064;
constexpr int O_THI = 0, O_TLO = 16 * TLS, O_PART = 2 * 16 * TLS, O_LOG = O_PART + 8 * 16 * 48 * 4, O_RT = O_LOG + 16 * 48 * 4;
template <int NT, bool SPLIT>
__device__ __forceinline__ void mma_part(lds_t* L, const bf16* WH, const bf16* WL, int wv, int lane) {
    const int fr = lane & 15, fq = lane >> 4;
    f32x4 acc[NT];
#pragma unroll
    for (int t = 0; t < NT; ++t) acc[t] = (f32x4){0.f, 0.f, 0.f, 0.f};
#pragma unroll
    for (int s2 = 0; s2 < 4; ++s2) {
        const int k = 128 * wv + 32 * s2 + 8 * fq;
        const bf16x8 ah = *(const __attribute__((address_space(3))) bf16x8*)(L + O_THI + fr * TLS + k * 2);
        bf16x8 al; if (SPLIT) al = *(const __attribute__((address_space(3))) bf16x8*)(L + O_TLO + fr * TLS + k * 2);
#pragma unroll
        for (int t = 0; t < NT; ++t) {
            const bf16x8 bh = *(const bf16x8*)(WH + (size_t)(16 * t + fr) * 1024 + k);
            acc[t] = __builtin_amdgcn_mfma_f32_16x16x32_bf16(ah, bh, acc[t], 0, 0, 0);
            if (SPLIT) { const bf16x8 bl = *(const bf16x8*)(WL + (size_t)(16 * t + fr) * 1024 + k);
                acc[t] = __builtin_amdgcn_mfma_f32_16x16x32_bf16(al, bh, acc[t], 0, 0, 0);
                acc[t] = __builtin_amdgcn_mfma_f32_16x16x32_bf16(ah, bl, acc[t], 0, 0, 0); }
        }
    }
    __attribute__((address_space(3))) float* P = (__attribute__((address_space(3))) float*)(L + O_PART) + wv * 16 * 16 * NT;
#pragma unroll
    for (int t = 0; t < NT; ++t)
#pragma unroll
        for (int q = 0; q < 4; ++q) P[(4 * fq + q) * 16 * NT + 16 * t + fr] = acc[t][q];
}
template <int NT>
__device__ __forceinline__ void load_bfrags(bf16x8 (&bh)[NT][4], const bf16* W, int wv, int lane) {
    const int fr = lane & 15, fq = lane >> 4;
#pragma unroll
    for (int t = 0; t < NT; ++t)
#pragma unroll
        for (int s2 = 0; s2 < 4; ++s2) bh[t][s2] = *(const bf16x8*)(W + (size_t)(16 * t + fr) * 1024 + 128 * wv + 32 * s2 + 8 * fq);
}
template <int NT, bool SPLIT>
__device__ __forceinline__ void mma_part_reg(lds_t* L, const bf16x8 (&bh)[NT][4], int wv, int lane) {
    const int fr = lane & 15, fq = lane >> 4;
    f32x4 acc[NT];
#pragma unroll
    for (int t = 0; t < NT; ++t) acc[t] = (f32x4){0.f, 0.f, 0.f, 0.f};
#pragma unroll
    for (int s2 = 0; s2 < 4; ++s2) {
        const int k = 128 * wv + 32 * s2 + 8 * fq;
        const bf16x8 ah = *(const __attribute__((address_space(3))) bf16x8*)(L + O_THI + fr * TLS + k * 2);
        bf16x8 al; if (SPLIT) al = *(const __attribute__((address_space(3))) bf16x8*)(L + O_TLO + fr * TLS + k * 2);
#pragma unroll
        for (int t = 0; t < NT; ++t) {
            acc[t] = __builtin_amdgcn_mfma_f32_16x16x32_bf16(ah, bh[t][s2], acc[t], 0, 0, 0);
            if (SPLIT) acc[t] = __builtin_amdgcn_mfma_f32_16x16x32_bf16(al, bh[t][s2], acc[t], 0, 0, 0);
        }
    }
    __attribute__((address_space(3))) float* P = (__attribute__((address_space(3))) float*)(L + O_PART) + wv * 16 * 16 * NT;
#pragma unroll
    for (int t = 0; t < NT; ++t)
#pragma unroll
        for (int q = 0; q < 4; ++q) P[(4 * fq + q) * 16 * NT + 16 * t + fr] = acc[t][q];
}
template <int NT>
__device__ __forceinline__ float part_sum(const lds_t* L, int idx) {
    const __attribute__((address_space(3))) float* P = (const __attribute__((address_space(3))) float*)(L + O_PART);
    float s = 0.f;
#pragma unroll
    for (int w = 0; w < 8; ++w) s += P[w * 16 * 16 * NT + idx];
    return s;
}
}

struct P1Iters {
    int G, b;
    __device__ __forceinline__ int count() const { if (G != 256) return (TT / 16 - b + G - 1) / G; return 9; }
    __device__ __forceinline__ int at(int li) const {
        if (G != 256) return b + li * G;
        return li == 0 ? T / 16 + (b >> 2) : b * 8 + (li - 1);
    }
    __device__ __forceinline__ int quarter() const { return G != 256 ? -1 : (b & 3); }
};
__device__ __forceinline__ void phase1(const Params& p, unsigned char* lds) {
    using namespace skinny;
    lds_t* L = (lds_t*)lds;
    const int tid = ltid(), lane = tid & 63, wave = tid >> 6, G = gridDim.x;
    const float* MOD = (const float*)(p.ws + WS_MOD); const bf16* WA = (const bf16*)(p.ws + WS_WA); const bf16* WIN = (const bf16*)(p.ws + WS_WIN);
    bf16* H = (bf16*)(p.ws + WS_H); float* ALOW = (float*)(p.ws + WS_ALOW); bf16* PROJ = (bf16*)(p.ws + WS_PROJ);
    const float* g1 = p.in[6];
    const P1Iters I{G, (int)blockIdx.x};
    const int nit = I.count();
    bf16x8 bw[2][4]; load_bfrags<2>(bw, WA, wave, lane);
    f32x4 nx[2][4], nx2[2][4];
#pragma unroll
    for (int rr = 0; rr < 2; ++rr)
#pragma unroll
        for (int j = 0; j < 4; ++j) { nx[rr][j] = (f32x4){0.f, 0.f, 0.f, 0.f}; nx2[rr][j] = (f32x4){0.f, 0.f, 0.f, 0.f}; }
    auto xrow = [&](int it, int rr) -> const float* { const int row = it * 16 + wave * 2 + rr; return row < T ? p.in[0] + (size_t)row * D : p.in[2] + (size_t)(row - T) * D; };
    if (nit > 0) {
#pragma unroll
        for (int rr = 0; rr < 2; ++rr)
#pragma unroll
            for (int j = 0; j < 4; ++j) nx[rr][j] = ((const f32x4*)xrow(I.at(0), rr))[lane + 64 * j]; }
    if (nit > 1) {
#pragma unroll
        for (int rr = 0; rr < 2; ++rr)
#pragma unroll
            for (int j = 0; j < 4; ++j) nx2[rr][j] = ((const f32x4*)xrow(I.at(1), rr))[lane + 64 * j]; }
#pragma unroll 1
    for (int li = 0; li < nit; ++li) {
        const int it = I.at(li);
        f32x4 v[2][4];
#pragma unroll
        for (int rr = 0; rr < 2; ++rr)
#pragma unroll
            for (int j = 0; j < 4; ++j) { v[rr][j] = nx[rr][j]; nx[rr][j] = nx2[rr][j]; }
        if (li + 2 < nit) {
#pragma unroll
            for (int rr = 0; rr < 2; ++rr)
#pragma unroll
                for (int j = 0; j < 4; ++j) nx2[rr][j] = ((const f32x4*)xrow(I.at(li + 2), rr))[lane + 64 * j]; }
        f32x4 gm1[4], sh1[4];
        { const float* md = MOD + (it * 16 < T ? ((it * 16) >> 13) : 4) * 6144;
#pragma unroll
          for (int j = 0; j < 4; ++j) { gm1[j] = ((const f32x4*)g1)[lane + 64 * j] * (((const f32x4*)(md + 1024))[lane + 64 * j] + 1.f); sh1[j] = ((const f32x4*)md)[lane + 64 * j]; } }
        __syncthreads();
#pragma unroll
        for (int rr = 0; rr < 2; ++rr) {
            const int lr = wave * 2 + rr, row = it * 16 + lr;
            float ss = 0.f;
#pragma unroll
            for (int j = 0; j < 4; ++j) ss += v[rr][j].x * v[rr][j].x + v[rr][j].y * v[rr][j].y + v[rr][j].z * v[rr][j].z + v[rr][j].w * v[rr][j].w;
            const float r = frsq(wave_sum(ss) * (1.f / D) + EPS);
#pragma unroll
            for (int j = 0; j < 4; ++j) {
                const f32x4 hv = v[rr][j] * r * gm1[j] + sh1[j];
                const unsigned long long o = (unsigned long long)pk2(hv.x, hv.y) | ((unsigned long long)pk2(hv.z, hv.w) << 32);
                if (row < T) ((unsigned long long*)(H + (size_t)row * D))[lane + 64 * j] = o;
                *(__attribute__((address_space(3))) unsigned long long*)(L + O_THI + lr * TLS + (lane + 64 * j) * 8) = o;
            }
        }
        __syncthreads();
        mma_part_reg<2, false>(L, bw, wave, lane);
        if (it >= T / 16) {
            const int fr = lane & 15, fq = lane >> 4, q0 = I.quarter() < 0 ? 0 : I.quarter(), q1 = I.quarter() < 0 ? 4 : I.quarter() + 1;
            for (int qt = q0; qt < q1; ++qt) {
                f32x4 acc[3];
#pragma unroll
                for (int t = 0; t < 3; ++t) acc[t] = (f32x4){0.f, 0.f, 0.f, 0.f};
                const int c0 = PK + 192 * qt + 48 * (wave & 3), kh = wave >> 2;
                const bf16* wb = WIN + (size_t)(c0 + fr) * 1024 + 512 * kh + 8 * fq;
#pragma unroll 1
                for (int sb = 0; sb < 4; ++sb) {
                    bf16x8 bq[4][3];
#pragma unroll
                    for (int s2 = 0; s2 < 4; ++s2)
#pragma unroll
                        for (int t = 0; t < 3; ++t) bq[s2][t] = *(const bf16x8*)(wb + (size_t)t * 16 * 1024 + 32 * (4 * sb + s2));
#pragma unroll
                    for (int s2 = 0; s2 < 4; ++s2) {
                        const bf16x8 a = *(const __attribute__((address_space(3))) bf16x8*)(L + O_THI + fr * TLS + (512 * kh + 32 * (4 * sb + s2) + 8 * fq) * 2);
#pragma unroll
                        for (int t = 0; t < 3; ++t) acc[t] = __builtin_amdgcn_mfma_f32_16x16x32_bf16(a, bq[s2][t], acc[t], 0, 0, 0);
                    }
                }
                __attribute__((address_space(3))) float* CP = (__attribute__((address_space(3))) float*)(L + O_LOG);
#pragma unroll
                for (int t = 0; t < 3; ++t)
#pragma unroll
                    for (int q = 0; q < 4; ++q) CP[(kh * 16 + 4 * fq + q) * 192 + 48 * (wave & 3) + 16 * t + fr] = acc[t][q];
                __syncthreads();
                for (int idx = tid; idx < 16 * 96; idx += 512) { const int r = idx / 96, c2 = (idx - r * 96) * 2;
                    const float v0 = CP[r * 192 + c2] + CP[(16 + r) * 192 + c2], v1 = CP[r * 192 + c2 + 1] + CP[(16 + r) * 192 + c2 + 1];
                    *(unsigned*)(PROJ + (size_t)(it * 16 + r) * NPROJ + PK + 192 * qt + c2) = pk2(v0, v1); }
                __syncthreads();
            }
        }
        __syncthreads();
        ALOW[(size_t)it * 16 * 32 + tid] = part_sum<2>(L, tid);
    }
}

__device__ __forceinline__ void phase2(const Params& p, unsigned char* lds) {
    const bf16* H = (const bf16*)(p.ws + WS_H); const bf16* WIN = (const bf16*)(p.ws + WS_WIN); bf16* PROJ = (bf16*)(p.ws + WS_PROJ);
    pg8::SchedDense S; S.init(T, NPROJ, D, WIN, (int)gridDim.x, (int)blockIdx.x);
    pg8::EpiProj E{PROJ, NPROJ};
    pg8::gemm_phase<pg8::EpiProj, pg8::SchedDense, true>((PG8_LAS unsigned char*)lds, H, D, S, E);
}

__device__ __forceinline__ void phase4(const Params& p, unsigned char* lds) {
    for (int u = blockIdx.x; u < NB * 32 * 4 + NB * 4 * 4; u += gridDim.x) {
        if (u < NB * 32 * 4) gla::state_unit(p, (gla::lds_t*)lds, u >> 7, 4 + ((u >> 2) & 31), u & 3);
        else { const int v = u - NB * 32 * 4; gla::state_unit(p, (gla::lds_t*)lds, v >> 4, (v >> 2) & 3, v & 3); }
    }
    __syncthreads();
}

__device__ __forceinline__ void phase5(const Params& p) {
    const int gtid = blockIdx.x * 512 + threadIdx.x, gthreads = gridDim.x * 512;
    const float* DST = (const float*)(p.ws + WS_DST); const float* DEC = (const float*)(p.ws + WS_DEC); float* SPREV = (float*)(p.ws + WS_SPREV);
    typedef float f32x2 __attribute__((ext_vector_type(2)));
    for (int idx = gtid; idx < 2 * NB * 4 * 4096; idx += gthreads) {
        const int de = (idx & 4095) * 2, h = (idx >> 12) & 3, b = (idx >> 14) & 3, dir = idx >> 16, d = de >> 7;
        const int ub = ((dir * NB + b) * NSI) * 4 + h, us = ((dir * NB + b) * 32) * 4 + h;
        f32x2 ds[NSI]; float dc[NSI];
#pragma unroll
        for (int si = 0; si < NSI; ++si) { ds[si] = *(const f32x2*)(DST + (size_t)(ub + 4 * si) * 8192 + de); dc[si] = DEC[(ub + 4 * si) * 64 + d]; }
        if (dir == 0) {
            f32x2 S = ds[0];
#pragma unroll
            for (int si = 1; si < 4; ++si) S = S * dc[si] + ds[si];
#pragma unroll
            for (int si = 4; si < NSI; ++si) { *(f32x2*)(SPREV + (size_t)(us + 4 * (si - 4)) * 8192 + de) = S; S = S * dc[si] + ds[si]; }
        } else {
            f32x2 S = ds[3];
#pragma unroll
            for (int si = 2; si >= 0; --si) S = S * dc[si] + ds[si];
#pragma unroll
            for (int si = NSI - 1; si >= 4; --si) { *(f32x2*)(SPREV + (size_t)(us + 4 * (si - 4)) * 8192 + de) = S; S = S * dc[si] + ds[si]; }
        }
    }
}

__device__ __forceinline__ void phase6(const Params& p, unsigned char* lds) {
    gla::lds_t* L = (gla::lds_t*)lds;
    for (int unit = blockIdx.x; unit < NB * 32 * 4; unit += gridDim.x) {
        const int h = unit & 3, sc = (unit >> 2) & 31, b = unit >> 7;
        gla::out_pass<1>(p, L, b, sc, h);
        gla::out_pass<0>(p, L, b, sc, h);
    }
    __syncthreads();
}

__device__ __forceinline__ void phase7(const Params& p, unsigned char* lds) {
    const int G = gridDim.x, vcu = (G % 8 == 0) ? (int)(blockIdx.x % 8) * (G / 8) + (int)(blockIdx.x / 8) : (int)blockIdx.x;
    for (int u = vcu; u < NB * 64; u += G) pool::unit(p, (pool::lds_t*)lds, u >> 6, u & 63);
    __syncthreads();
}

__device__ __forceinline__ void phase8(const Params& p, unsigned char* lds) {
    const bf16* MIX = (const bf16*)(p.ws + WS_MIX); const bf16* WOUT = (const bf16*)(p.ws + WS_WOUT); const float* MOD = (const float*)(p.ws + WS_MOD);
    pg8::SchedDense S; S.init(T, D, D, WOUT, (int)gridDim.x, (int)blockIdx.x);
    pg8::EpiOut E{(bf16*)(p.ws + WS_OUTP), MOD};
    pg8::gemm_phase<pg8::EpiOut, pg8::SchedDense, true>((PG8_LAS unsigned char*)lds, MIX, D, S, E);
}

__device__ __forceinline__ void phase9(const Params& p, unsigned char* lds) {
    using namespace skinny;
    lds_t* L = (lds_t*)lds;
    typedef __attribute__((address_space(3))) float lf; typedef __attribute__((address_space(3))) int li;
    const int tid = ltid(), lane = tid & 63, wave = tid >> 6, G = gridDim.x;
    const float* MOD = (const float*)(p.ws + WS_MOD); const bf16* WRH = (const bf16*)(p.ws + WS_WR); const bf16* WRL = WRH + 48 * 1024;
    bf16* H2 = (bf16*)(p.ws + WS_H); int* LIST = (int*)(p.ws + WS_LIST);
    unsigned* CNT = (unsigned*)(p.ws + WS_CTL) + CW_CNT;
    const float* g2 = p.in[14];
    lf* LOG = (lf*)(L + O_LOG);
    li* EID = (li*)(L + O_RT);
    lf* EWT = (lf*)(L + O_RT + 1024);
    li* RNK = (li*)(L + O_RT + 2048);
    li* LCN = (li*)(L + O_RT + 3072);
    bf16x8 bwh[3][4]; load_bfrags<3>(bwh, WRH, wave, lane);
    for (int blk = blockIdx.x; blk < T / 128; blk += G) {
        __syncthreads();
        if (tid < 32) LCN[tid] = 0;
        f32x4 gm9[4], sh9[4];
        { const float* md = MOD + ((blk * 128) >> 13) * 6144;
#pragma unroll
          for (int j = 0; j < 4; ++j) { gm9[j] = ((const f32x4*)g2)[lane + 64 * j] * (((const f32x4*)(md + 4096))[lane + 64 * j] + 1.f); sh9[j] = ((const f32x4*)(md + 3072))[lane + 64 * j]; } }
        unsigned long long nx[2][4]; f32x4 nf[2][4];
#pragma unroll
        for (int rr = 0; rr < 2; ++rr)
#pragma unroll
            for (int j = 0; j < 4; ++j) { const size_t ro = (size_t)(blk * 128 + wave * 2 + rr) * D;
                nx[rr][j] = ((const unsigned long long*)((const bf16*)(p.ws + WS_OUTP) + ro))[lane + 64 * j]; nf[rr][j] = ((const f32x4*)(p.in[0] + ro))[lane + 64 * j]; }
#pragma unroll 1
        for (int it8 = 0; it8 < 8; ++it8) {
            const int row0 = blk * 128 + it8 * 16;
            unsigned long long cx[2][4]; f32x4 cf[2][4];
#pragma unroll
            for (int rr = 0; rr < 2; ++rr)
#pragma unroll
                for (int j = 0; j < 4; ++j) { cx[rr][j] = nx[rr][j]; cf[rr][j] = nf[rr][j]; }
            if (it8 < 7) {
#pragma unroll
                for (int rr = 0; rr < 2; ++rr)
#pragma unroll
                    for (int j = 0; j < 4; ++j) { const size_t ro = (size_t)(row0 + 16 + wave * 2 + rr) * D;
                        nx[rr][j] = ((const unsigned long long*)((const bf16*)(p.ws + WS_OUTP) + ro))[lane + 64 * j]; nf[rr][j] = ((const f32x4*)(p.in[0] + ro))[lane + 64 * j]; }
            }
            __syncthreads();
#pragma unroll
            for (int rr = 0; rr < 2; ++rr) {
                const int lr = wave * 2 + rr, row = row0 + lr;
                const float* md = MOD + (row >> 13) * 6144;
                f32x4 v[4]; float ss = 0.f;
#pragma unroll
                for (int j = 0; j < 4; ++j) { const unsigned long long xw = cx[rr][j];
                    v[j].x = cf[rr][j].x + bf2f((unsigned)(xw & 0xffff)); v[j].y = cf[rr][j].y + bf2f((unsigned)((xw >> 16) & 0xffff)); v[j].z = cf[rr][j].z + bf2f((unsigned)((xw >> 32) & 0xffff)); v[j].w = cf[rr][j].w + bf2f((unsigned)(xw >> 48));
                    ((unsigned long long*)((bf16*)(p.ws + WS_XMID) + (size_t)row * D))[lane + 64 * j] = (unsigned long long)pk2(v[j].x, v[j].y) | ((unsigned long long)pk2(v[j].z, v[j].w) << 32);
                    ss += v[j].x * v[j].x + v[j].y * v[j].y + v[j].z * v[j].z + v[j].w * v[j].w; }
                const float r = frsq(wave_sum(ss) * (1.f / D) + EPS);
#pragma unroll
                for (int j = 0; j < 4; ++j) {
                    v[j] = v[j] * r * gm9[j] + sh9[j];
                    const unsigned h0 = f2bf(v[j].x), h1 = f2bf(v[j].y), h2 = f2bf(v[j].z), h3 = f2bf(v[j].w);
                    const unsigned long long o = (unsigned long long)(h0 | (h1 << 16)) | ((unsigned long long)(h2 | (h3 << 16)) << 32);
                    const unsigned long long ol = (unsigned long long)pk2(v[j].x - bf2f(h0), v[j].y - bf2f(h1)) | ((unsigned long long)pk2(v[j].z - bf2f(h2), v[j].w - bf2f(h3)) << 32);
                    { unsigned q8 = 0; q8 = __builtin_amdgcn_cvt_pk_fp8_f32(v[j].x, v[j].y, q8, false); q8 = __builtin_amdgcn_cvt_pk_fp8_f32(v[j].z, v[j].w, q8, true);
                      ((unsigned*)((unsigned char*)H2 + (size_t)row * D))[lane + 64 * j] = q8; }
                    *(__attribute__((address_space(3))) unsigned long long*)(L + O_THI + lr * TLS + (lane + 64 * j) * 8) = o;
                    *(__attribute__((address_space(3))) unsigned long long*)(L + O_TLO + lr * TLS + (lane + 64 * j) * 8) = ol;
                }
            }
            __syncthreads();
            mma_part_reg<3, true>(L, bwh, wave, lane);
            __syncthreads();
            LOG[tid] = part_sum<3>(L, tid);
            if (tid < 256) LOG[512 + tid] = part_sum<3>(L, 512 + tid);
            __syncthreads();
            if (tid < 16) {
                const lf* lg = LOG + tid * 48;
                int gi = 0; float gm = lg[32];
#pragma unroll
                for (int q = 1; q < 4; ++q) if (lg[32 + q] > gm) { gm = lg[32 + q]; gi = q; }
                float gs = 0.f;
#pragma unroll
                for (int q = 0; q < 4; ++q) gs += __expf(lg[32 + q] - gm);
                const float gp = 1.f / gs;
                float le[8];
#pragma unroll
                for (int q = 0; q < 8; ++q) le[q] = lg[gi * 8 + q];
                int i0 = 0; float m0 = le[0];
#pragma unroll
                for (int q = 1; q < 8; ++q) if (le[q] > m0) { m0 = le[q]; i0 = q; }
                int i1 = -1; float m1 = -3.0e38f;
#pragma unroll
                for (int q = 0; q < 8; ++q) if (q != i0 && le[q] > m1) { m1 = le[q]; i1 = q; }
                const float e1 = __expf(m1 - m0), w0 = gp / (1.f + e1), w1 = gp * e1 / (1.f + e1);
                const int pr = (it8 * 16 + tid) * 2;
                EID[pr] = gi * 8 + i0; EWT[pr] = w0; EID[pr + 1] = gi * 8 + i1; EWT[pr + 1] = w1;
            }
        }
        __syncthreads();
        if (tid < 256) RNK[tid] = __hip_atomic_fetch_add((int*)(LCN + EID[tid]), 1, __ATOMIC_RELAXED, __HIP_MEMORY_SCOPE_WORKGROUP);
        __syncthreads();
        if (tid < 32) { const int c = LCN[tid]; LCN[tid] = c ? (int)atomicAdd(CNT + tid, (unsigned)c) : 0; }
        __syncthreads();
        if (tid < 256) { const int e = EID[tid], tok2 = blk * 256 + tid; const size_t sl = (size_t)(e * T + LCN[e] + RNK[tid]); LIST[2 * sl] = tok2; LIST[2 * sl + 1] = __float_as_int(EWT[tid]); }
    }
}

__device__ __forceinline__ void moe_tables(const Params& p, unsigned char* lds) {
    PG8_LAS int* tp = (PG8_LAS int*)((PG8_LAS unsigned char*)lds + MISC_OFF) + 32; PG8_LAS int* cn = tp + 64;
    const unsigned* CNT = (const unsigned*)(p.ws + WS_CTL) + CW_CNT;
    __syncthreads();
    if (threadIdx.x < 32) cn[threadIdx.x] = (int)CNT[threadIdx.x];
    __syncthreads();
    if (threadIdx.x == 0) { int a = 0; for (int e = 0; e < 32; ++e) { tp[e] = a; a += (cn[e] + 255) >> 8; } tp[32] = a; }
    __syncthreads();
    {
        PG8_LAS unsigned char* r2e = (PG8_LAS unsigned char*)(tp + 96);
        for (int rt = threadIdx.x; rt < 288; rt += 512) { int e = 0; while (e < 31 && tp[e + 1] <= rt) ++e; r2e[rt] = (unsigned char)e; }
    }
    __syncthreads();
}
__device__ __forceinline__ void phase10(const Params& p, unsigned char* lds) {
    moe_tables(p, lds);
    const PG8_LAS int* tp = (const PG8_LAS int*)((PG8_LAS unsigned char*)lds + MISC_OFF) + 32; const PG8_LAS int* cn = tp + 64;
    pg8::SchedMoE1 S{tp, cn, (const int*)(p.ws + WS_LIST), (const bf16*)(p.ws + WS_WE1), (int)gridDim.x, (int)blockIdx.x};
    pg8::EpiSwiglu E{(bf16*)(p.ws + WS_HID)};
    pg8::gemm_phase<pg8::EpiSwiglu, pg8::SchedMoE1, true, 1>((PG8_LAS unsigned char*)lds, (const void*)(p.ws + WS_H), D, S, E);
}
__device__ __forceinline__ void phase11(const Params& p, unsigned char* lds) {
    const PG8_LAS int* tp = (const PG8_LAS int*)((PG8_LAS unsigned char*)lds + MISC_OFF) + 32; const PG8_LAS int* cn = tp + 64;
    pg8::SchedMoE2 S{tp, (const bf16*)(p.ws + WS_WE2), (int)gridDim.x, (int)blockIdx.x};
    pg8::EpiScatter E{(bf16*)(p.ws + WS_PROJ), cn, (const int*)(p.ws + WS_LIST)};
    pg8::gemm_phase<pg8::EpiScatter, pg8::SchedMoE2, true, 1>((PG8_LAS unsigned char*)lds, (const void*)(p.ws + WS_HID), DE, S, E);
}

__device__ __forceinline__ void phase12(const Params& p) {
    const int tid = ltid(), lane = tid & 63, wave = tid >> 6, G = gridDim.x;
    const int gw = blockIdx.x * 8 + wave, NGW = G * 8;
    const float* MOD = (const float*)(p.ws + WS_MOD); const bf16* Y = (const bf16*)(p.ws + WS_PROJ); const bf16* XM = (const bf16*)(p.ws + WS_XMID);
    f32x4 gfin[4];
#pragma unroll
    for (int j = 0; j < 4; ++j) gfin[j] = ((const f32x4*)p.in[19])[lane + 64 * j];
    for (int row = gw; row < T; row += 2 * NGW) {
        unsigned long long xw[2][4], y0[2][4], y1[2][4]; f32x4 gt[2][4];
#pragma unroll
        for (int rr = 0; rr < 2; ++rr) {
            const int r = min(row + rr * NGW, T - 1);
#pragma unroll
            for (int j = 0; j < 4; ++j) {
                xw[rr][j] = ((const unsigned long long*)(XM + (size_t)r * D))[lane + 64 * j];
                y0[rr][j] = ((const unsigned long long*)(Y + (size_t)(2 * r) * 1024))[lane + 64 * j];
                y1[rr][j] = ((const unsigned long long*)(Y + (size_t)(2 * r + 1) * 1024))[lane + 64 * j];
                gt[rr][j] = ((const f32x4*)(MOD + (r >> 13) * 6144 + 5120))[lane + 64 * j];
            }
        }
#pragma unroll
        for (int rr = 0; rr < 2; ++rr) {
            const int r = row + rr * NGW;
            f32x4 v[4]; float ss = 0.f;
#pragma unroll
            for (int j = 0; j < 4; ++j) {
                const unsigned long long a = xw[rr][j], b0 = y0[rr][j], b1 = y1[rr][j];
                f32x4 xv, ys;
                xv.x = bf2f((unsigned)(a & 0xffff)); xv.y = bf2f((unsigned)((a >> 16) & 0xffff)); xv.z = bf2f((unsigned)((a >> 32) & 0xffff)); xv.w = bf2f((unsigned)(a >> 48));
                ys.x = bf2f((unsigned)(b0 & 0xffff)) + bf2f((unsigned)(b1 & 0xffff));
                ys.y = bf2f((unsigned)((b0 >> 16) & 0xffff)) + bf2f((unsigned)((b1 >> 16) & 0xffff));
                ys.z = bf2f((unsigned)((b0 >> 32) & 0xffff)) + bf2f((unsigned)((b1 >> 32) & 0xffff));
                ys.w = bf2f((unsigned)(b0 >> 48)) + bf2f((unsigned)(b1 >> 48));
                v[j] = xv + gt[rr][j] * ys;
                ss += v[j].x * v[j].x + v[j].y * v[j].y + v[j].z * v[j].z + v[j].w * v[j].w;
            }
            const float rn = frsq(wave_sum(ss) * (1.f / D) + EPS);
            if (r < T) {
#pragma unroll
                for (int j = 0; j < 4; ++j) ((f32x4*)(p.out + (size_t)r * D))[lane + 64 * j] = v[j] * rn * gfin[j];
            }
        }
    }
}

#define LAS __attribute__((address_space(3)))
#define XB_TMO      128
#define XB_XCNT(j)  (256  + 64 * (j))
#define XB_XSUB(j)  (1280 + 64 * (j))
#define XB_XGEN(j)  (2304 + 64 * (j))
#define XB_TOP      3328
#define XB_TOPGEN   3392
#define XCD_BAR_WORDS 3456
#define XB_SPIN_CAP (1u << 18)
__device__ __forceinline__ unsigned xb_ld(unsigned* p)              { return __hip_atomic_load(p, __ATOMIC_RELAXED, __HIP_MEMORY_SCOPE_AGENT); }
__device__ __forceinline__ unsigned xb_add(unsigned* p, unsigned v) { return __hip_atomic_fetch_add(p, v, __ATOMIC_RELAXED, __HIP_MEMORY_SCOPE_AGENT); }
__device__ __forceinline__ unsigned xb_xcc_id() { return (unsigned)__builtin_amdgcn_s_getreg((3 << 11) | 20) & 0xFu; }
#define XB_SPIN(cond, bar) do { unsigned _sp = 0; while (cond) { __builtin_amdgcn_s_sleep(1); \
    if ((++_sp & 255u) == 0u) { if (xb_ld(&(bar)[XB_TMO])) break; if (_sp > XB_SPIN_CAP) { atomicAdd(&(bar)[XB_TMO], 1u); break; } } } } while (0)
struct XcdBarrier { unsigned* bar; unsigned x; volatile LAS unsigned* st; };
__device__ __forceinline__ XcdBarrier xcd_barrier_post(unsigned* bar, volatile LAS unsigned* st) {
    XcdBarrier b; b.bar = bar; b.x = xb_xcc_id(); b.st = st;
    if (threadIdx.x == 0) (void)xb_add(&bar[XB_XCNT(b.x)], 1u);
    return b;
}
__device__ __forceinline__ void xcd_barrier_complete(unsigned* bar, unsigned x, unsigned& nloc, unsigned& nx) {
    const unsigned G = gridDim.x * gridDim.y * gridDim.z;
    unsigned sum, cnt, mine, sp = 0u;
    for (;;) {
        sum = 0u; cnt = 0u; mine = 0u;
#pragma unroll
        for (unsigned j = 0; j < 16; ++j) { const unsigned c = xb_ld(&bar[XB_XCNT(j)]); sum += c; cnt += (c > 0u) ? 1u : 0u; mine = (j == x) ? c : mine; }
        if (sum == G) break;
        __builtin_amdgcn_s_sleep(1);
        if ((++sp & 255u) == 0u) { if (xb_ld(&bar[XB_TMO])) break; if (sp > XB_SPIN_CAP) { atomicAdd(&bar[XB_TMO], 1u); break; } }
    }
    nloc = mine > 0u ? mine : 1u; nx = cnt > 0u ? cnt : 1u;
}
__device__ __forceinline__ void xcd_barrier(const XcdBarrier& b) {
    asm volatile("s_waitcnt vmcnt(0)" ::: "memory");
    __syncthreads();
    if (threadIdx.x == 0) {
        unsigned* bar = b.bar;
        __builtin_amdgcn_s_waitcnt(0);
        unsigned nloc = b.st[0], nx = b.st[1];
        if (nloc == 0u) { xcd_barrier_complete(bar, b.x, nloc, nx); b.st[0] = nloc; b.st[1] = nx; }
        const unsigned old = xb_add(&bar[XB_XSUB(b.x)], 1u);
        const unsigned gen = old / nloc;
        if (old + 1u == (gen + 1u) * nloc) {
            __builtin_amdgcn_fence(__ATOMIC_RELEASE, "agent");
            asm volatile("s_waitcnt vmcnt(0)" ::: "memory");
            const unsigned og = xb_add(&bar[XB_TOP], 1u);
            const unsigned tg = og / nx;
            if (og + 1u == (tg + 1u) * nx) xb_add(&bar[XB_TOPGEN], 1u);
            else XB_SPIN(xb_ld(&bar[XB_TOPGEN]) == tg, bar);
            __builtin_amdgcn_fence(__ATOMIC_ACQUIRE, "agent");
            xb_add(&bar[XB_XGEN(b.x)], 1u);
            asm volatile("s_waitcnt vmcnt(0)" ::: "memory");
        } else {
            XB_SPIN(xb_ld(&bar[XB_XGEN(b.x)]) == gen, bar);
            __builtin_amdgcn_fence(__ATOMIC_ACQUIRE, "agent");
            asm volatile("s_waitcnt vmcnt(0)" ::: "memory");
        }
    }
    __syncthreads();
}

constexpr int MISC_OFF_UNUSED = 0;
__global__ void __launch_bounds__(512, 2) mk_fwd(Params p) {
    extern __shared__ __attribute__((aligned(16))) unsigned char lds[];
    volatile LAS unsigned* MISC = (volatile LAS unsigned*)((LAS unsigned char*)lds + MISC_OFF);
    if (threadIdx.x < 256) MISC[threadIdx.x] = 0u;
    __syncthreads();
    XcdBarrier bar = xcd_barrier_post((unsigned*)(p.ws + WS_CTL) + CW_BAR, MISC + 8);
#ifndef REPEAT_PHASE
#define REPEAT_PHASE -1
#endif
#define PHASE(k, call) { call; xcd_barrier(bar); if ((k) == REPEAT_PHASE) { call; xcd_barrier(bar); call; xcd_barrier(bar); } }
    PHASE(0, phase0(p, lds))
    PHASE(1, phase1(p, lds))
    PHASE(2, phase2(p, lds))
    PHASE(4, phase4(p, lds))
    PHASE(5, phase5(p))
    PHASE(6, phase6(p, lds); phase7(p, lds))
    PHASE(8, phase8(p, lds))
    PHASE(9, phase9(p, lds))
    PHASE(10, phase10(p, lds))
    PHASE(11, phase11(p, lds))
    phase12(p);
}

extern "C" void kernel_launch(void* const* d_in, const int* in_sizes, int n_in, void* d_out, int out_size, void* d_ws, size_t ws_size, hipStream_t stream) {
    static int grid = 0;
    if (grid == 0) {
        if (n_in != 20 || in_sizes[0] != T * D || in_sizes[7] != D * IN_COLS || out_size != T * D || ws_size < WS_END) {
            fprintf(stderr, "kernel_launch: unexpected shapes (n_in %d in0 %d in7 %d out %d ws %zu)\n", n_in, n_in > 0 ? in_sizes[0] : -1, n_in > 7 ? in_sizes[7] : -1, out_size, ws_size); grid = -1; return; }
        int dev = 0, cus = 0;
        if (hipGetDevice(&dev) != hipSuccess || hipDeviceGetAttribute(&cus, hipDeviceAttributeMultiprocessorCount, dev) != hipSuccess) { grid = -1; return; }
        if (hipFuncSetAttribute((const void*)mk_fwd, hipFuncAttributeMaxDynamicSharedMemorySize, LDS_BYTES) != hipSuccess) { grid = -1; return; }
        grid = cus;
    }
    if (grid < 0) return;
    (void)hipMemsetAsync((char*)d_ws + WS_CTL, 0, CTL_BYTES, stream);
    Params a{};
    for (int i = 0; i < 20; ++i) a.in[i] = (const float*)d_in[i];
    a.out = (float*)d_out; a.ws = (unsigned char*)d_ws;
    hipLaunchKernelGGL(mk_fwd, dim3(grid), dim3(512), LDS_BYTES, stream, a);
}
```

```cpp
#include <hip/hip_runtime.h>
#include <cstdint>
#include <cstdio>

typedef unsigned short bf16;
typedef unsigned v4u __attribute__((ext_vector_type(4)));
typedef float f32x4 __attribute__((ext_vector_type(4)));

constexpr int D = 1024, NB = 4, SEQ = 8192, T = NB * SEQ, CTXL = 256, TC = NB * CTXL, TT = T + TC;
constexpr int IN_COLS = 2080, OFF_A = 1536, OFF_P = 1568;
constexpr int NPROJ = 2048;
constexpr int PQ = 0, PK = 256, PV = 512, PG = 1024, PP = 1536;
constexpr int NSI = 36;
constexpr int NE = 32, DE = 256;
constexpr float EPS = 1e-6f;

constexpr size_t MiB = 1u << 20;
constexpr size_t WS_CTL = 0, CTL_BYTES = 65536;
constexpr size_t WS_MOD = 1 * MiB;
constexpr size_t WS_WIN = 2 * MiB;
constexpr size_t WS_WA = 6 * MiB;
constexpr size_t WS_WOUT = 7 * MiB;
constexpr size_t WS_WPOOL = 9 * MiB;
constexpr size_t WS_WR = 10 * MiB;
constexpr size_t WS_DEC = 11 * MiB;
constexpr size_t WS_LIST = 502 * MiB;
constexpr size_t WS_WE1 = 18 * MiB;
constexpr size_t WS_WE2 = 50 * MiB;
constexpr size_t WS_H = 66 * MiB;
constexpr size_t WS_ALOW = 132 * MiB;
constexpr size_t WS_PROJ = 138 * MiB;
constexpr size_t WS_DST = 270 * MiB;
constexpr size_t WS_XMID = 270 * MiB;
constexpr size_t WS_OUTP = 438 * MiB;
constexpr size_t WS_SPREV = 306 * MiB;
constexpr size_t WS_MIX = 338 * MiB;
constexpr size_t WS_HID = 402 * MiB;
constexpr size_t WS_END = 510 * MiB;
constexpr int CW_CNT = 1024;
constexpr int CW_BAR = 4096;

constexpr int LDS_BYTES = 147456;
constexpr int MISC_OFF = LDS_BYTES - 1024;
constexpr int NPHASE = 12;

struct Params { const float* in[20]; float* out; unsigned char* ws; int ph_lo, ph_hi; };

__device__ __forceinline__ float bf2f(unsigned b) { return __uint_as_float(b << 16); }
typedef float f32x2_t __attribute__((ext_vector_type(2)));
typedef __bf16 bf16x2_t __attribute__((ext_vector_type(2)));
__device__ __forceinline__ unsigned pk2(float lo, float hi) { const f32x2_t v = {lo, hi}; return __builtin_bit_cast(unsigned, __builtin_convertvector(v, bf16x2_t)); }
__device__ __forceinline__ unsigned f2bf(float f) { return pk2(f, 0.f) & 0xffffu; }
__device__ __forceinline__ float frcp(float x) { return __builtin_amdgcn_rcpf(x); }
__device__ __forceinline__ float frsq(float x) { return __builtin_amdgcn_rsqf(x); }
template <int CTRL> __device__ __forceinline__ float dppf(float v) { return __int_as_float(__builtin_amdgcn_update_dpp(0, __float_as_int(v), CTRL, 0xf, 0xf, false)); }
__device__ __forceinline__ float wave_sum(float v) {
    v += dppf<0xB1>(v);
    v += dppf<0x4E>(v);
    v += dppf<0x141>(v);
    v += dppf<0x140>(v);
    const int iv = __float_as_int(v);
    return (__int_as_float(__builtin_amdgcn_readlane(iv, 0)) + __int_as_float(__builtin_amdgcn_readlane(iv, 16))) + (__int_as_float(__builtin_amdgcn_readlane(iv, 32)) + __int_as_float(__builtin_amdgcn_readlane(iv, 48)));
}
__device__ __forceinline__ int ltid() { int t = threadIdx.x; asm volatile("" : "+v"(t)); return t; }
__device__ __forceinline__ float silu(float s) { return s * frcp(1.f + __expf(-s)); }
struct TDesc { const float* W; int ldw; bf16* WT; int ldt; int f8; };
__device__ __forceinline__ void titem_load(const TDesc& d, float (&tv)[32], int lane) {
#pragma unroll
    for (int i = 0; i < 32; ++i) tv[i] = d.W[(size_t)(2 * i + (lane >> 5)) * d.ldw + (lane & 31)];
}
__device__ __forceinline__ void titem_store(const TDesc& d, const float (&tv)[32], float* scr, int lane) {
#pragma unroll
    for (int i = 0; i < 32; ++i) scr[(2 * i + (lane >> 5)) * 33 + (lane & 31)] = tv[i];
    asm volatile("s_waitcnt lgkmcnt(0)" ::: "memory");
    const int c = lane & 7;
#pragma unroll
    for (int j = 0; j < 4; ++j) { const int n = (lane >> 3) + 8 * j; const float* s = scr + (8 * c) * 33 + n;
        if (d.f8) {
            unsigned w0 = 0, w1 = 0; const float sc8 = (float)d.f8;
            w0 = __builtin_amdgcn_cvt_pk_fp8_f32(sc8 * s[0 * 33], sc8 * s[1 * 33], w0, false); w0 = __builtin_amdgcn_cvt_pk_fp8_f32(sc8 * s[2 * 33], sc8 * s[3 * 33], w0, true);
            w1 = __builtin_amdgcn_cvt_pk_fp8_f32(sc8 * s[4 * 33], sc8 * s[5 * 33], w1, false); w1 = __builtin_amdgcn_cvt_pk_fp8_f32(sc8 * s[6 * 33], sc8 * s[7 * 33], w1, true);
            *(unsigned long long*)((unsigned char*)d.WT + (size_t)n * d.ldt + 8 * c) = (unsigned long long)w0 | ((unsigned long long)w1 << 32);
        } else {
            v4u o; o.x = pk2(s[0 * 33], s[1 * 33]); o.y = pk2(s[2 * 33], s[3 * 33]); o.z = pk2(s[4 * 33], s[5 * 33]); o.w = pk2(s[6 * 33], s[7 * 33]);
            *(v4u*)(d.WT + (size_t)n * d.ldt + 8 * c) = o; } }
    asm volatile("s_waitcnt lgkmcnt(0)" ::: "memory");
}
__device__ __forceinline__ TDesc tdesc(const float* W, int ldw, int nblk, bf16* WT, int ldt, int item) {
    const int kb = item / nblk, nb = item - kb * nblk, k0 = 64 * kb, n0 = 32 * nb;
    return TDesc{W + (size_t)k0 * ldw + n0, ldw, WT + (size_t)n0 * ldt + k0, ldt, 0};
}


namespace pg8 {
#define PG8_LAS __attribute__((address_space(3)))
typedef short bf16x8 __attribute__((ext_vector_type(8)));
typedef unsigned u32x4 __attribute__((ext_vector_type(4)));
typedef long l64x2 __attribute__((ext_vector_type(2)));
constexpr int BM = 256, BK = 64, HALF = 128, HTB = HALF * BK * 2, STAGE_BYTES = 8 * HTB, NXCD = 8, WGM = 8;
__device__ __forceinline__ int lds_byte(int r, int c) { const int st = (r >> 4) * 2 + (c >> 5), rr = r & 15, cc = c & 31, ob = rr * 64 + cc * 2; return st * 1024 + (ob ^ (((ob >> 9) & 1) << 5)); }
__device__ __forceinline__ void stage_rc(int b, int& R, int& C) { const int st = b / 1024, sb = b % 1024, swz = sb ^ (((sb >> 9) & 1) << 5); R = (st >> 1) * 16 + swz / 64; C = (st & 1) * 32 + (swz % 64) / 2; }
__device__ __forceinline__ int perm32(int rho) { const int n = rho >> 4, i = rho & 15; return 8 * (i >> 2) + 4 * n + (i & 3); }
__device__ __forceinline__ unsigned cvt_pk_bf16(float lo, float hi) { return pk2(lo, hi); }

struct Unit { int pm, pn, e, ti; };

struct SchedDense {
    int nM, nN, nwg, G, c, K; const bf16* Bt;
    __device__ __forceinline__ void init(int M, int N, int K_, const bf16* Bt_, int G_, int c_) { nM = M / BM; nN = N / BM; nwg = nM * nN; G = G_; c = c_; K = K_; Bt = Bt_; }
    __device__ __forceinline__ bool next(int i, Unit& u) const {
        const long L = (long)i * G + c; if (L >= nwg) return false;
        int wgid = (int)L; { const int q = nwg / NXCD, r = nwg % NXCD, xcd = wgid % NXCD, off = wgid / NXCD; wgid = (xcd < r ? xcd * (q + 1) : r * (q + 1) + (xcd - r) * q) + off; }
        const int nig = WGM * nN, gid = wgid / nig, fm = gid * WGM, gsz = (nM - fm) < WGM ? (nM - fm) : WGM;
        u.pm = fm + ((wgid % nig) % gsz); u.pn = (wgid % nig) / gsz; u.e = 0; u.ti = 0; return true;
    }
    __device__ __forceinline__ unsigned arow(const Unit& u, int r) const { return (unsigned)(u.pm * BM + r) * (unsigned)(K * 2); }
    __device__ __forceinline__ const char* bbase(const Unit& u) const { return (const char*)Bt + (size_t)u.pn * BM * K * 2; }
};

template <class Epi, class Sched, bool ALIGN_EPI, int EB = 2>
__device__ __forceinline__ void gemm_phase(PG8_LAS unsigned char* lds, const void* Aptr, const int K, const Sched& S, const Epi& E) {
    const int tid = ltid(), wid = __builtin_amdgcn_readfirstlane(tid >> 6), lane = tid & 63, wr = wid >> 2, wc = wid & 3, fr = lane & 15, fq = lane >> 4;
    const int KB = K * EB; int nt = KB / (BK * 2);
    asm volatile("" : "+s"(nt));
    const char* Abase = (const char*)Aptr;
    int sR[2]; unsigned sC[2]; unsigned voffB[2];
#pragma unroll
    for (int i = 0; i < 2; ++i) { int R, C; stage_rc(tid * 16 + i * 8192, R, C); const int Rb = Epi::PERM ? ((R & ~31) + perm32(R & 31)) : R;
        sR[i] = R; sC[i] = (unsigned)C * 2u; voffB[i] = (unsigned)(Rb * KB + C * 2); }
    const unsigned kstep = (unsigned)(BK * 2);
    const size_t hstep = (size_t)HALF * KB;
    const unsigned ldsw = (unsigned)wid * 1024u;
    const int aoff = lds_byte(wr * 64 + fr, fq * 8), boff = lds_byte(wc * 32 + fr, fq * 8);
#define PG8_SA(b, h) (((b) * 2 + (h)) * HTB)
#define PG8_SB(b, h) ((4 + (b) * 2 + (h)) * HTB)
#define PG8_STAGE(bufoff, gbase, voff) do { _Pragma("unroll") for (int _i = 0; _i < 2; ++_i) \
        __builtin_amdgcn_global_load_lds((const unsigned*)((const char*)(gbase) + (voff)[_i]), (PG8_LAS unsigned*)(lds + (bufoff) + ldsw + _i * 8192), 16, 0, 0); } while (0)
#define PG8_STAGE_A(bufoff, AO, h, kb) do { _Pragma("unroll") for (int _i = 0; _i < 2; ++_i) \
        __builtin_amdgcn_global_load_lds((const unsigned*)(Abase + (AO)[h][_i] + (kb)), (PG8_LAS unsigned*)(lds + (bufoff) + ldsw + _i * 8192), 16, 0, 0); } while (0)
#define PG8_LDA(dst, b, h) do { _Pragma("unroll") for (int m = 0; m < 4; ++m) _Pragma("unroll") for (int k = 0; k < 2; ++k) dst[m][k] = *(const PG8_LAS bf16x8*)(lds + PG8_SA(b, h) + aoff + m * 2048 + k * 1024); } while (0)
#define PG8_LDB(dst, b, h) do { _Pragma("unroll") for (int n = 0; n < 2; ++n) _Pragma("unroll") for (int k = 0; k < 2; ++k) dst[n][k] = *(const PG8_LAS bf16x8*)(lds + PG8_SB(b, h) + boff + n * 2048 + k * 1024); } while (0)
#define PG8_MMA(ai, bj, At, Bt) do { __builtin_amdgcn_s_setprio(1); _Pragma("unroll") for (int m = 0; m < 4; ++m) _Pragma("unroll") for (int n = 0; n < 2; ++n) _Pragma("unroll") for (int k = 0; k < 2; ++k) { \
        if constexpr (EB == 2) acc[ai][bj][m][n] = __builtin_amdgcn_mfma_f32_16x16x32_bf16(Bt[n][k], At[m][k], acc[ai][bj][m][n], 0, 0, 0); \
        else { const l64x2 _b = __builtin_bit_cast(l64x2, Bt[n][k]), _a = __builtin_bit_cast(l64x2, At[m][k]); \
            acc[ai][bj][m][n] = __builtin_amdgcn_mfma_f32_16x16x32_fp8_fp8(_b[0], _a[0], acc[ai][bj][m][n], 0, 0, 0); \
            acc[ai][bj][m][n] = __builtin_amdgcn_mfma_f32_16x16x32_fp8_fp8(_b[1], _a[1], acc[ai][bj][m][n], 0, 0, 0); } } \
        __builtin_amdgcn_s_setprio(0); } while (0)
#define PG8_WAIT_V(n) asm volatile("s_waitcnt vmcnt(" #n ")" ::: "memory")
#define PG8_WAIT_L(n) asm volatile("s_waitcnt lgkmcnt(" #n ")" ::: "memory")
#define PG8_BAR __builtin_amdgcn_s_barrier()
#define PG8_SCHED __builtin_amdgcn_sched_barrier(0)
#define PG8_AOFFS(dst, u) do { _Pragma("unroll") for (int _h = 0; _h < 2; ++_h) _Pragma("unroll") for (int _i = 0; _i < 2; ++_i) dst[_h][_i] = S.arow(u, _h * HALF + sR[_i]) + sC[_i]; } while (0)
    Unit cur, nxt; int ui = 0;
    if (!S.next(0, cur)) return;
    E.prefetch(cur, wr, fr);
    f32x4 acc[2][2][4][2];
#pragma unroll
    for (int a = 0; a < 2; ++a)
#pragma unroll
        for (int b = 0; b < 2; ++b)
#pragma unroll
            for (int m = 0; m < 4; ++m)
#pragma unroll
                for (int n = 0; n < 2; ++n) acc[a][b][m][n] = (f32x4){0.f, 0.f, 0.f, 0.f};
    bf16x8 At[4][2], B0[2][2], B1[2][2];
    unsigned cAo[2][2], nAo[2][2];
    PG8_AOFFS(cAo, cur);
    const char* cB = S.bbase(cur);
    PG8_STAGE(PG8_SB(0, 0), cB, voffB); PG8_STAGE(PG8_SB(0, 1), cB + hstep, voffB); PG8_STAGE_A(PG8_SA(0, 0), cAo, 0, 0u); PG8_STAGE_A(PG8_SA(0, 1), cAo, 1, 0u);
    if (wr == 1) PG8_BAR;
    PG8_WAIT_V(2); PG8_BAR;
    PG8_STAGE(PG8_SB(1, 0), cB + kstep, voffB); PG8_STAGE_A(PG8_SA(1, 0), cAo, 0, kstep); PG8_STAGE(PG8_SB(1, 1), cB + hstep + kstep, voffB);
    PG8_WAIT_V(6); PG8_BAR;
    for (;;) {
        const bool has_next = S.next(ui + 1, nxt);
        const char* nB = cB;
        if (has_next) { PG8_AOFFS(nAo, nxt); nB = S.bbase(nxt); }
        else {
#pragma unroll
            for (int _h = 0; _h < 2; ++_h)
#pragma unroll
                for (int _i = 0; _i < 2; ++_i) nAo[_h][_i] = cAo[_h][_i];
        }
#pragma unroll 1
        for (int t = 0; t < nt; t += 2) {
            const bool last = (t == nt - 2);
            const unsigned k1 = (unsigned)(t + 1) * kstep, k2 = last ? 0u : (unsigned)(t + 2) * kstep, k3 = k2 + kstep;
            unsigned xAo[2][2];
#pragma unroll
            for (int _h = 0; _h < 2; ++_h)
#pragma unroll
                for (int _i = 0; _i < 2; ++_i) xAo[_h][_i] = last ? nAo[_h][_i] : cAo[_h][_i];
            const char* b2 = last ? nB : cB + (size_t)(t + 2) * kstep; const char* b3 = b2 + kstep;
            PG8_LDB(B0, 0, 0); PG8_LDB(B1, 0, 1); PG8_SCHED; PG8_LDA(At, 0, 0); PG8_STAGE_A(PG8_SA(1, 1), cAo, 1, k1);
            PG8_WAIT_V(8); PG8_WAIT_L(0); PG8_BAR; PG8_MMA(0, 0, At, B0); PG8_MMA(0, 1, At, B1); PG8_BAR; PG8_SCHED;
            PG8_LDA(At, 0, 1); PG8_STAGE(PG8_SB(0, 0), b2, voffB); PG8_STAGE(PG8_SB(0, 1), b2 + hstep, voffB); PG8_STAGE_A(PG8_SA(0, 0), xAo, 0, k2);
            PG8_WAIT_V(8); PG8_WAIT_L(0); PG8_BAR; PG8_MMA(1, 0, At, B0); PG8_MMA(1, 1, At, B1); PG8_BAR; PG8_SCHED;
            PG8_LDB(B0, 1, 0); PG8_LDB(B1, 1, 1); PG8_SCHED; PG8_LDA(At, 1, 0); PG8_STAGE_A(PG8_SA(0, 1), xAo, 1, k2);
            PG8_WAIT_V(8); PG8_WAIT_L(0); PG8_BAR; PG8_MMA(0, 0, At, B0); PG8_MMA(0, 1, At, B1); PG8_BAR; PG8_SCHED;
            PG8_LDA(At, 1, 1); PG8_STAGE(PG8_SB(1, 0), b3, voffB); PG8_STAGE(PG8_SB(1, 1), b3 + hstep, voffB); PG8_STAGE_A(PG8_SA(1, 0), xAo, 0, k3);
            PG8_WAIT_V(8); PG8_WAIT_L(0); PG8_BAR; PG8_MMA(1, 0, At, B0); PG8_MMA(1, 1, At, B1); PG8_BAR; PG8_SCHED;
        }
        if constexpr (ALIGN_EPI) { if (wr == 0) PG8_BAR; }
        E(acc, cur, wr, wc, fr, fq);
        if (!has_next) break;
        E.prefetch(nxt, wr, fr);
#pragma unroll
        for (int a = 0; a < 2; ++a)
#pragma unroll
            for (int b = 0; b < 2; ++b)
#pragma unroll
                for (int m = 0; m < 4; ++m)
#pragma unroll
                    for (int n = 0; n < 2; ++n) acc[a][b][m][n] = (f32x4){0.f, 0.f, 0.f, 0.f};
        cur = nxt; cB = nB; ++ui;
#pragma unroll
        for (int _h = 0; _h < 2; ++_h)
#pragma unroll
            for (int _i = 0; _i < 2; ++_i) cAo[_h][_i] = nAo[_h][_i];
        if constexpr (ALIGN_EPI) { if (wr == 1) PG8_BAR; }
    }
    PG8_WAIT_V(0);
    if constexpr (!ALIGN_EPI) { if (wr == 0) PG8_BAR; }
    PG8_BAR;
#undef PG8_SA
#undef PG8_SB
#undef PG8_STAGE
#undef PG8_STAGE_A
#undef PG8_LDA
#undef PG8_LDB
#undef PG8_MMA
#undef PG8_WAIT_V
#undef PG8_WAIT_L
#undef PG8_BAR
#undef PG8_SCHED
#undef PG8_AOFFS
}

struct EpiProj {
    static constexpr bool PERM = true;
    __device__ __forceinline__ void prefetch(const Unit&, int, int) const {}
    __device__ __forceinline__ void rotate() const {}
    bf16* O; int ldc;
    __device__ __forceinline__ void operator()(const f32x4 (&acc)[2][2][4][2], const Unit& u, int wr, int wc, int fr, int fq) const {
        const int row0 = u.pm * BM + wr * 64 + fr, col0 = u.pn * BM + wc * 32 + 8 * fq;
#pragma unroll
        for (int ai = 0; ai < 2; ++ai)
#pragma unroll
            for (int m = 0; m < 4; ++m) { bf16* rowp = O + (size_t)(row0 + ai * HALF + m * 16) * ldc + col0;
#pragma unroll
                for (int bj = 0; bj < 2; ++bj) { const f32x4 v0 = acc[ai][bj][m][0], v1 = acc[ai][bj][m][1];
                    u32x4 w; w.x = cvt_pk_bf16(v0[0], v0[1]); w.y = cvt_pk_bf16(v0[2], v0[3]); w.z = cvt_pk_bf16(v1[0], v1[1]); w.w = cvt_pk_bf16(v1[2], v1[3]);
                    *(u32x4*)(rowp + bj * HALF) = w; } }
    }
};
struct EpiOut {
    static constexpr bool PERM = true;
    __device__ __forceinline__ void prefetch(const Unit&, int, int) const {}
    __device__ __forceinline__ void rotate() const {}
    bf16* xm; const float* MOD;
    __device__ __forceinline__ void operator()(const f32x4 (&acc)[2][2][4][2], const Unit& u, int wr, int wc, int fr, int fq) const {
        const int row0 = u.pm * BM + wr * 64 + fr, col0 = u.pn * BM + wc * 32 + 8 * fq;
        const float* gt = MOD + ((u.pm * BM) >> 13) * 6144 + 2048 + col0;
        f32x4 gv[2][2];
#pragma unroll
        for (int bj = 0; bj < 2; ++bj)
#pragma unroll
            for (int n = 0; n < 2; ++n) gv[bj][n] = *(const f32x4*)(gt + bj * HALF + n * 4);
#pragma unroll
        for (int ai = 0; ai < 2; ++ai)
#pragma unroll
            for (int m = 0; m < 4; ++m) { const size_t off = (size_t)(row0 + ai * HALF + m * 16) * 1024 + col0;
#pragma unroll
                for (int bj = 0; bj < 2; ++bj) {
                    const f32x4 v0 = gv[bj][0] * acc[ai][bj][m][0], v1 = gv[bj][1] * acc[ai][bj][m][1];
                    u32x4 w; w.x = cvt_pk_bf16(v0[0], v0[1]); w.y = cvt_pk_bf16(v0[2], v0[3]); w.z = cvt_pk_bf16(v1[0], v1[1]); w.w = cvt_pk_bf16(v1[2], v1[3]);
                    *(u32x4*)(xm + off + bj * HALF) = w; } }
    }
};

struct SchedMoE1 {
    const PG8_LAS int* tp; const PG8_LAS int* cnt; const int* LIST; const bf16* W; int G, c;
    __device__ __forceinline__ bool next(int i, Unit& u) const {
        const int NU = 2 * tp[32]; int L;
        if (G % 8 == 0) { const int per = (NU + 7) >> 3, x = c & 7; L = x * per + (c >> 3) + (G >> 3) * i; if (L >= min((x + 1) * per, NU)) return false; }
        else { L = i * G + c; if (L >= NU) return false; }
        const int rt = L >> 1; const int e = ((const PG8_LAS unsigned char*)(tp + 96))[rt];
        u.pm = rt; u.pn = L & 1; u.e = e; u.ti = rt - tp[e]; return true;
    }
    __device__ __forceinline__ unsigned arow(const Unit& u, int r) const { const int i = u.ti * 256 + r, ii = i < cnt[u.e] ? i : 0; return (unsigned)(LIST[2 * (u.e * T + ii)] >> 1) * 1024u; }
    __device__ __forceinline__ const char* bbase(const Unit& u) const { return (const char*)W + ((size_t)u.e * 512 + u.pn * 256) * 1024; }
};
struct EpiSwiglu {
    static constexpr bool PERM = true;
    __device__ __forceinline__ void prefetch(const Unit&, int, int) const {}
    __device__ __forceinline__ void rotate() const {}
    bf16* HID;
    __device__ __forceinline__ void operator()(const f32x4 (&acc)[2][2][4][2], const Unit& u, int wr, int wc, int fr, int fq) const {
#pragma unroll
        for (int ai = 0; ai < 2; ++ai)
#pragma unroll
            for (int m = 0; m < 4; ++m) {
                float h[8];
#pragma unroll
                for (int n = 0; n < 2; ++n)
#pragma unroll
                    for (int q = 0; q < 4; ++q) { const float a = acc[ai][0][m][n][q] * (1.f / 32.f), uu = acc[ai][1][m][n][q] * (1.f / 32.f); h[n * 4 + q] = a * frcp(1.f + __expf(-a)) * uu; }
                unsigned w0 = 0, w1 = 0;
                w0 = __builtin_amdgcn_cvt_pk_fp8_f32(4.f * h[0], 4.f * h[1], w0, false); w0 = __builtin_amdgcn_cvt_pk_fp8_f32(4.f * h[2], 4.f * h[3], w0, true);
                w1 = __builtin_amdgcn_cvt_pk_fp8_f32(4.f * h[4], 4.f * h[5], w1, false); w1 = __builtin_amdgcn_cvt_pk_fp8_f32(4.f * h[6], 4.f * h[7], w1, true);
                *(unsigned long long*)((unsigned char*)HID + (size_t)(u.pm * BM + ai * HALF + wr * 64 + m * 16 + fr) * 256 + u.pn * 128 + wc * 32 + 8 * fq) = (unsigned long long)w0 | ((unsigned long long)w1 << 32);
            }
    }
};
struct SchedMoE2 {
    const PG8_LAS int* tp; const bf16* W; int G, c;
    __device__ __forceinline__ bool next(int i, Unit& u) const {
        const int NU = 4 * tp[32]; int L;
        if (G % 8 == 0) { const int per = (NU + 7) >> 3, x = c & 7; L = x * per + (c >> 3) + (G >> 3) * i; if (L >= min((x + 1) * per, NU)) return false; }
        else { L = i * G + c; if (L >= NU) return false; }
        const int rt = L >> 2; const int e = ((const PG8_LAS unsigned char*)(tp + 96))[rt];
        u.pm = rt; u.pn = L & 3; u.e = e; u.ti = rt - tp[e]; return true;
    }
    __device__ __forceinline__ unsigned arow(const Unit& u, int r) const { return (unsigned)(u.pm * BM + r) * 256u; }
    __device__ __forceinline__ const char* bbase(const Unit& u) const { return (const char*)W + ((size_t)u.e * 1024 + u.pn * 256) * 256; }
};
struct EpiScatter {
    static constexpr bool PERM = true;
    bf16* Y; const PG8_LAS int* cnt; const int* LIST;
    typedef int i32x2 __attribute__((ext_vector_type(2)));
    mutable i32x2 cu[8];
    __device__ __forceinline__ void prefetch(const Unit& u, int wr, int fr) const {
        const int ce = cnt[u.e];
#pragma unroll
        for (int q = 0; q < 8; ++q) { const int i = u.ti * 256 + (q >> 2) * HALF + wr * 64 + (q & 3) * 16 + fr;
            cu[q] = *(const i32x2*)(LIST + 2 * (size_t)(u.e * T + (i < ce ? i : 0))); if (i >= ce) cu[q].x = -1; }
    }
    __device__ __forceinline__ void rotate() const {}
    __device__ __forceinline__ void operator()(const f32x4 (&acc)[2][2][4][2], const Unit& u, int wr, int wc, int fr, int fq) const {
#pragma unroll
        for (int ai = 0; ai < 2; ++ai)
#pragma unroll
            for (int m = 0; m < 4; ++m) {
                const int tok2 = cu[ai * 4 + m].x; const float r = __int_as_float(cu[ai * 4 + m].y) * (1.f / 64.f);
                if (tok2 >= 0) {
                    bf16* rowp = Y + (size_t)tok2 * 1024 + u.pn * BM + wc * 32 + 8 * fq;
#pragma unroll
                    for (int bj = 0; bj < 2; ++bj) { const f32x4 v0 = acc[ai][bj][m][0] * r, v1 = acc[ai][bj][m][1] * r;
                        u32x4 w; w.x = cvt_pk_bf16(v0[0], v0[1]); w.y = cvt_pk_bf16(v0[2], v0[3]); w.z = cvt_pk_bf16(v1[0], v1[1]); w.w = cvt_pk_bf16(v1[2], v1[3]);
                        *(u32x4*)(rowp + bj * HALF) = w; }
                }
            }
    }
};
}


namespace gla {
typedef short bf16x8 __attribute__((ext_vector_type(8)));
typedef float f32x16 __attribute__((ext_vector_type(16)));
typedef __attribute__((address_space(3))) unsigned char lds_t;
typedef __attribute__((address_space(3))) float lf;
typedef __attribute__((address_space(3))) unsigned short lus;
typedef __attribute__((address_space(3))) v4u lv4;
constexpr int LS = 144;
constexpr int O_QB = 0;
constexpr int O_KB = 9216;
constexpr int O_P = 18432;
constexpr int O_OUT = O_QB, OUT_LD = 132;
constexpr int O_ST = 33792;
constexpr int O_DEC = 52224;
constexpr int O_CS = 52480, O_CSB = 54528;
constexpr int O_ALS = 56576;
constexpr int O_RK = 64768, O_RQ = 73984;
constexpr int O_RV = 83200, RVS = 320, O_RV2 = O_RV + 64 * RVS;
static_assert(64 * OUT_LD * 4 <= O_ST && O_P + 9216 <= O_ST && O_RV2 + 64 * RVS <= MISC_OFF, "gla LDS map");

__device__ __forceinline__ unsigned bfr(float f) { return f2bf(f); }

typedef short s16x4 __attribute__((ext_vector_type(4)));
#define GLA_MFMA(a, b, c) __builtin_amdgcn_mfma_f32_32x32x16_bf16(a, b, c, 0, 0, 0)
__device__ __forceinline__ bf16x8 fr_row(const lds_t* X, int stride, int lane, int s) { return *(const __attribute__((address_space(3))) bf16x8*)(X + (lane & 31) * stride + (lane >> 5) * 16 + s * 32); }
__device__ __forceinline__ s16x4 trd(const lds_t* q) { return __builtin_amdgcn_ds_read_tr16_b64_v4i16((__attribute__((address_space(3))) s16x4*)q); }
__device__ __forceinline__ int tr_off(int lane, int stride) { return (8 * (lane >> 5) + ((lane & 15) >> 2)) * stride + (16 * ((lane >> 4) & 1) + 4 * (lane & 3)) * 2; }
__device__ __forceinline__ bf16x8 fr_tr(const lds_t* X, int stride, int s) { const s16x4 a = trd(X + 16 * s * stride), b = trd(X + (16 * s + 4) * stride); return __builtin_shufflevector(a, b, 0, 1, 2, 3, 4, 5, 6, 7); }

struct Raw { v4u k, q, v0, v1; f32x4 al; };
template <bool NEEDQ, bool BOTH>
__device__ __forceinline__ void raw_load(Raw& R, const bf16* PROJ, const float* ALOW, int r0, int h, int dir, int tid) {
    const size_t row = (size_t)(r0 + (tid >> 3));
    R.k = *(const v4u*)(PROJ + row * NPROJ + PK + h * 64 + (tid & 7) * 8);
    if (NEEDQ) R.q = *(const v4u*)(PROJ + row * NPROJ + PQ + h * 64 + (tid & 7) * 8);
    R.v0 = *(const v4u*)(PROJ + row * NPROJ + PV + h * 128 + (tid & 7) * 16);
    R.v1 = *(const v4u*)(PROJ + row * NPROJ + PV + h * 128 + (tid & 7) * 16 + 8);
    if (BOTH) R.al = *(const f32x4*)(ALOW + row * 32 + (tid & 7) * 4);
    else if (tid < 256) R.al = *(const f32x4*)(ALOW + (size_t)(r0 + (tid >> 2)) * 32 + dir * 16 + (tid & 3) * 4);
}
template <bool NEEDQ, bool BOTH>
__device__ __forceinline__ void raw_stage(lds_t* L, const Raw& R, int tid, int ov = O_RV) {
    const int j = tid >> 3, c = tid & 7;
    *(lv4*)(L + O_RK + j * LS + c * 16) = R.k;
    if (NEEDQ) *(lv4*)(L + O_RQ + j * LS + c * 16) = R.q;
    *(lv4*)(L + ov + j * RVS + c * 32) = R.v0;
    *(lv4*)(L + ov + j * RVS + c * 32 + 16) = R.v1;
    if (BOTH) *(__attribute__((address_space(3))) f32x4*)((lf*)(L + O_ALS) + j * 32 + c * 4) = R.al;
    else if (tid < 256) *(__attribute__((address_space(3))) f32x4*)((lf*)(L + O_ALS) + tid * 4) = R.al;
}
template <int ALD>
__device__ __forceinline__ float la_cum(const lds_t* L, int to, int dir, int aoff, const float (&wd)[16], float bd, float (&bl)[8]) {
    const lf* ALS = (const lf*)(L + O_ALS);
    float cum = 0.f;
#pragma unroll
    for (int s2 = 0; s2 < 8; ++s2) {
        const int jj = dir ? 7 - s2 : s2, j = 8 * to + jj;
        float z = bd;
#pragma unroll
        for (int r4 = 0; r4 < 4; ++r4) { const f32x4 a = *(const __attribute__((address_space(3))) f32x4*)(ALS + j * ALD + aoff + r4 * 4);
            z += a.x * wd[r4 * 4] + a.y * wd[r4 * 4 + 1] + a.z * wd[r4 * 4 + 2] + a.w * wd[r4 * 4 + 3]; }
        const float la = (fminf(z, 0.f) - __logf(1.f + __expf(-fabsf(z)))) * (1.f / 16.f);
        cum += la; bl[jj] = cum;
    }
    return cum;
}
__device__ __forceinline__ void cs_combine(const lf* CS, int d, int to, int dir, float& offs, float& tot) {
    offs = 0.f; tot = 0.f;
#pragma unroll
    for (int o = 0; o < 8; ++o) { const float c = CS[o * 64 + d]; tot += c; if (dir ? (o > to) : (o < to)) offs += c; }
}

__device__ __forceinline__ void write_st(lds_t* L, const f32x16& S, int db, int eb, int lane) {
    const int e = 32 * eb + (lane & 31), hh = lane >> 5;
#pragma unroll
    for (int g = 0; g < 4; ++g) {
        const unsigned lo = pk2(S[4 * g], S[4 * g + 1]), hi = pk2(S[4 * g + 2], S[4 * g + 3]);
        *(__attribute__((address_space(3))) unsigned long long*)(L + O_ST + e * LS + (32 * db + 8 * g + 4 * hh) * 2) = (unsigned long long)lo | ((unsigned long long)hi << 32);
    }
}
__device__ __forceinline__ void scale_rows(lds_t* L, f32x16& S, int db, int lane) {
    const int hh = lane >> 5;
#pragma unroll
    for (int g = 0; g < 4; ++g) { const f32x4 dv = *(const __attribute__((address_space(3))) f32x4*)(L + O_DEC + (32 * db + 8 * g + 4 * hh) * 4);
        S[4 * g] *= dv.x; S[4 * g + 1] *= dv.y; S[4 * g + 2] *= dv.z; S[4 * g + 3] *= dv.w; }
}

__device__ __forceinline__ void state_unit(const Params& p, lds_t* L, int b, int si, int h) {
    const int tid = ltid(), lane = tid & 63, w = tid >> 6, hh = lane >> 5, d = lane, to = w;
    const bf16* PROJ = (const bf16*)(p.ws + WS_PROJ); const float* ALOW = (const float*)(p.ws + WS_ALOW);
    float* DST = (float*)(p.ws + WS_DST); float* DEC = (float*)(p.ws + WS_DEC);
    const float* w_dec = p.in[8]; const float* b_dec = p.in[9];
    const int db = w >> 2, eb = w & 3, base = si < 4 ? T + b * CTXL + 64 * si : b * SEQ + (si - 4) * 256, nch = si < 4 ? 1 : 4;
    float wf[16], wb[16];
#pragma unroll
    for (int r = 0; r < 16; ++r) { wf[r] = w_dec[r * 256 + h * 64 + d]; wb[r] = w_dec[4096 + r * 256 + h * 64 + d]; }
    const float bdf = b_dec[h * 64 + d], bdb = b_dec[256 + h * 64 + d];
    f32x16 Sf, Sb;
#pragma unroll
    for (int q = 0; q < 16; ++q) { Sf[q] = 0.f; Sb[q] = 0.f; }
    float pf = 1.f, pb = 1.f;
    const int trk = (8 * to + ((lane & 15) >> 2)) * LS + (16 * (lane >> 4) + 4 * (lane & 3)) * 2, trv = tr_off(lane, RVS);
    Raw R;
    __syncthreads();
    raw_load<false, true>(R, PROJ, ALOW, base, h, 0, tid);
    raw_stage<false, true>(L, R, tid);
    __syncthreads();
#pragma unroll 1
    for (int c = 0; c < nch; ++c) {
        if (c + 1 < nch) raw_load<false, true>(R, PROJ, ALOW, base + 64 * (c + 1), h, 0, tid);
        float blf[8], blb[8];
        const float cf = la_cum<32>(L, to, 0, 0, wf, bdf, blf), cb = la_cum<32>(L, to, 1, 16, wb, bdb, blb);
        ((lf*)(L + O_CS))[to * 64 + d] = cf; ((lf*)(L + O_CSB))[to * 64 + d] = cb;
        __syncthreads();
        float of, tf, ob, tb;
        cs_combine((const lf*)(L + O_CS), d, to, 0, of, tf); cs_combine((const lf*)(L + O_CSB), d, to, 1, ob, tb);
        if (to == 0) ((lf*)(L + O_DEC))[d] = __expf(tf);
        float kf[8], kb[8];
        { const s16x4 k0 = trd(L + O_RK + trk), k1 = trd(L + O_RK + trk + 4 * LS);
#pragma unroll
          for (int jj = 0; jj < 8; ++jj) {
            const float k = bf2f((unsigned)(unsigned short)(jj < 4 ? k0[jj & 3] : k1[jj & 3]));
            kf[jj] = k * __expf(tf - (blf[jj] + of));
            kb[jj] = k * __expf(tb - (blb[jj] + ob)) * pb;
          } }
        { v4u x; x.x = pk2(kf[0], kf[1]); x.y = pk2(kf[2], kf[3]); x.z = pk2(kf[4], kf[5]); x.w = pk2(kf[6], kf[7]); *(lv4*)(L + O_QB + d * LS + to * 16) = x; }
        { v4u x; x.x = pk2(kb[0], kb[1]); x.y = pk2(kb[2], kb[3]); x.z = pk2(kb[4], kb[5]); x.w = pk2(kb[6], kb[7]); *(lv4*)(L + O_KB + d * LS + to * 16) = x; }
        pf *= __expf(tf); pb *= __expf(tb);
        __syncthreads();
        scale_rows(L, Sf, db, lane);
#pragma unroll
        for (int s = 0; s < 4; ++s) { const bf16x8 vf = fr_tr(L + ((c & 1) ? O_RV2 : O_RV) + 64 * eb + trv, RVS, s);
            Sf = GLA_MFMA(fr_row(L + O_QB + 32 * db * LS, LS, lane, s), vf, Sf);
            Sb = GLA_MFMA(fr_row(L + O_KB + 32 * db * LS, LS, lane, s), vf, Sb); }
        if (c + 1 < nch) raw_stage<false, true>(L, R, tid, (c & 1) ? O_RV : O_RV2);
        __syncthreads();
    }
    const int uf = ((0 * NB + b) * NSI + si) * 4 + h, ub = ((1 * NB + b) * NSI + si) * 4 + h;
#pragma unroll
    for (int q = 0; q < 16; ++q) { const int dl = (q & 3) + 8 * (q >> 2) + 4 * hh; const size_t o = (size_t)(32 * db + dl) * 128 + 32 * eb + (lane & 31);
        DST[(size_t)uf * 8192 + o] = Sf[q]; DST[(size_t)ub * 8192 + o] = Sb[q]; }
    if (to == 0) { DEC[uf * 64 + d] = pf; DEC[ub * 64 + d] = pb; }
}

template <int DIR>
__device__ __forceinline__ void out_pass(const Params& p, lds_t* L, int b, int sc, int h) {
    const int tid = ltid(), lane = tid & 63, w = tid >> 6, hh = lane >> 5, d = lane, to = w;
    const bf16* PROJ = (const bf16*)(p.ws + WS_PROJ); const float* ALOW = (const float*)(p.ws + WS_ALOW);
    const float* SPREV = (const float*)(p.ws + WS_SPREV); bf16* MIX = (bf16*)(p.ws + WS_MIX); float* OACC = (float*)(p.ws + WS_H);
    const float* w_dec = p.in[8]; const float* b_dec = p.in[9]; const float* gng = p.in[10];
    const int ib = w >> 2, eb = w & 3, base = b * SEQ + sc * 256;
    float wd[16];
#pragma unroll
    for (int r = 0; r < 16; ++r) wd[r] = w_dec[DIR * 4096 + r * 256 + h * 64 + d];
    const float bd = b_dec[DIR * 256 + h * 64 + d];
    const int u = ((DIR * NB + b) * 32 + sc) * 4 + h;
    f32x16 S;
#pragma unroll
    for (int q = 0; q < 16; ++q) { const int dl = (q & 3) + 8 * (q >> 2) + 4 * hh; S[q] = SPREV[(size_t)u * 8192 + (32 * ib + dl) * 128 + 32 * eb + (lane & 31)]; }
    float gnv[16];
    if (DIR == 0) {
#pragma unroll
        for (int q = 0; q < 16; ++q) gnv[q] = gng[(tid & 7) * 16 + q];
    }
    const int trk = (8 * to + ((lane & 15) >> 2)) * LS + (16 * (lane >> 4) + 4 * (lane & 3)) * 2, trq = tr_off(lane, LS), trv = tr_off(lane, RVS);
    Raw R;
    __syncthreads();
    raw_load<true, false>(R, PROJ, ALOW, base + (DIR ? 192 : 0), h, DIR, tid);
    write_st(L, S, ib, eb, lane);
    raw_stage<true, false>(L, R, tid);
    __syncthreads();
#pragma unroll 1
    for (int cc = 0; cc < 4; ++cc) {
        const int c = DIR ? 3 - cc : cc, r0 = base + 64 * c;
        if (cc < 3) raw_load<true, false>(R, PROJ, ALOW, base + 64 * (DIR ? 2 - cc : cc + 1), h, DIR, tid);
        float* oa = OACC + (size_t)(r0 + 32 * ib + 4 * hh) * 512 + h * 128 + 32 * eb + (lane & 31);
        float ob[16]; v4u g0, g1;
        if (DIR == 0) {
#pragma unroll
            for (int q = 0; q < 16; ++q) ob[q] = oa[(size_t)((q & 3) + 8 * (q >> 2)) * 512];
            const size_t grow = (size_t)(r0 + (tid >> 3));
            g0 = *(const v4u*)(PROJ + grow * NPROJ + PG + h * 128 + (tid & 7) * 16); g1 = *(const v4u*)(PROJ + grow * NPROJ + PG + h * 128 + (tid & 7) * 16 + 8);
        }
        float bl[8];
        const float cum = la_cum<16>(L, to, DIR, 0, wd, bd, bl);
        ((lf*)(L + O_CS))[to * 64 + d] = cum;
        __syncthreads();
        float offs, tot; cs_combine((const lf*)(L + O_CS), d, to, DIR, offs, tot);
        const float dec = __expf(tot);
        if (to == 0) ((lf*)(L + O_DEC))[d] = dec;
        {
            const s16x4 k0 = trd(L + O_RK + trk), k1 = trd(L + O_RK + trk + 4 * LS), q0 = trd(L + O_RQ + trk), q1 = trd(L + O_RQ + trk + 4 * LS);
            float kf[8], qf[8];
#pragma unroll
            for (int jj = 0; jj < 8; ++jj) {
                const float bq = bl[jj] + offs, E = __expf(bq), Einv = frcp(E);
                kf[jj] = bf2f((unsigned)(unsigned short)(jj < 4 ? k0[jj & 3] : k1[jj & 3])) * Einv;
                qf[jj] = bf2f((unsigned)(unsigned short)(jj < 4 ? q0[jj & 3] : q1[jj & 3])) * 0.125f * E;
            }
            { v4u x; x.x = pk2(kf[0], kf[1]); x.y = pk2(kf[2], kf[3]); x.z = pk2(kf[4], kf[5]); x.w = pk2(kf[6], kf[7]); *(lv4*)(L + O_KB + d * LS + to * 16) = x; }
            { v4u x; x.x = pk2(qf[0], qf[1]); x.y = pk2(qf[2], qf[3]); x.z = pk2(qf[4], qf[5]); x.w = pk2(qf[6], qf[7]); *(lv4*)(L + O_QB + d * LS + to * 16) = x; }
        }
        __syncthreads();
        if (w < 4) {
            const int pi = w >> 1, pj = w & 1;
            f32x16 pa;
#pragma unroll
            for (int q = 0; q < 16; ++q) pa[q] = 0.f;
            const bool dead = DIR ? (pj < pi) : (pj > pi);
            if (!dead) {
#pragma unroll
                for (int s = 0; s < 4; ++s) pa = GLA_MFMA(fr_tr(L + O_QB + 64 * pi + trq, LS, s), fr_tr(L + O_KB + 64 * pj + trq, LS, s), pa);
            }
            const int jl = lane & 31;
#pragma unroll
            for (int q = 0; q < 16; q += 2) {
                const int il = (q & 3) + 8 * (q >> 2) + 4 * hh;
                float v0 = pa[q], v1 = pa[q + 1];
                if (pi == pj) { if (DIR ? (jl < il) : (jl > il)) v0 = 0.f; if (DIR ? (jl < il + 1) : (jl > il + 1)) v1 = 0.f; }
                const unsigned pw = pk2(v0, v1);
                *(lus*)(L + O_P + (32 * pi + il) * LS + (32 * pj + jl) * 2) = (unsigned short)pw;
                *(lus*)(L + O_P + (32 * pi + il + 1) * LS + (32 * pj + jl) * 2) = (unsigned short)(pw >> 16);
            }
        }
        __syncthreads();
        f32x16 o;
#pragma unroll
        for (int q = 0; q < 16; ++q) o[q] = 0.f;
        {
            bf16x8 vf[4];
#pragma unroll
            for (int s = 0; s < 4; ++s) vf[s] = fr_tr(L + O_RV + 64 * eb + trv, RVS, s);
#pragma unroll
            for (int s = 0; s < 4; ++s) o = GLA_MFMA(fr_row(L + O_P + 32 * ib * LS, LS, lane, s), vf[s], o);
#pragma unroll
            for (int s = 0; s < 4; ++s) o = GLA_MFMA(fr_tr(L + O_QB + 64 * ib + trq, LS, s), fr_row(L + O_ST + 32 * eb * LS, LS, lane, s), o);
#pragma unroll
            for (int s = 0; s < 4; ++s) S = GLA_MFMA(fr_row(L + O_KB + 32 * ib * LS, LS, lane, s), vf[s], S);
            scale_rows(L, S, ib, lane);
        }
        __syncthreads();
        write_st(L, S, ib, eb, lane);
        if (cc < 3) raw_stage<true, false>(L, R, tid);
        if (DIR == 1) {
#pragma unroll
            for (int q = 0; q < 16; ++q) oa[(size_t)((q & 3) + 8 * (q >> 2)) * 512] = o[q];
            __syncthreads();
        } else {
            lf* OUT = (lf*)(L + O_OUT);
#pragma unroll
            for (int q = 0; q < 16; ++q) { const int il = (q & 3) + 8 * (q >> 2) + 4 * hh; OUT[(32 * ib + il) * OUT_LD + 32 * eb + (lane & 31)] = o[q] + ob[q]; }
            __syncthreads();
            const int i = tid >> 3, e0 = (tid & 7) * 16;
            float v[16]; float ss = 0.f;
#pragma unroll
            for (int q4 = 0; q4 < 4; ++q4) { const f32x4 t = *(const __attribute__((address_space(3))) f32x4*)(OUT + i * OUT_LD + e0 + q4 * 4);
                v[q4 * 4] = t.x; v[q4 * 4 + 1] = t.y; v[q4 * 4 + 2] = t.z; v[q4 * 4 + 3] = t.w; ss += t.x * t.x + t.y * t.y + t.z * t.z + t.w * t.w; }
            ss += __shfl_xor(ss, 1); ss += __shfl_xor(ss, 2); ss += __shfl_xor(ss, 4);
            const float r = frsq(ss * (1.f / 128.f) + EPS);
            const size_t row = (size_t)(r0 + i);
            unsigned ow[8];
#pragma unroll
            for (int q = 0; q < 8; ++q) {
                const unsigned gw = q < 4 ? g0[q] : g1[q - 4];
                const float ga = __uint_as_float(gw << 16), gb = __uint_as_float(gw & 0xffff0000u);
                const float ya = v[2 * q] * r * gnv[2 * q] * (ga * frcp(1.f + __expf(-ga))), yb = v[2 * q + 1] * r * gnv[2 * q + 1] * (gb * frcp(1.f + __expf(-gb)));
                ow[q] = pk2(ya, yb);
            }
            v4u o0, o1; o0.x = ow[0]; o0.y = ow[1]; o0.z = ow[2]; o0.w = ow[3]; o1.x = ow[4]; o1.y = ow[5]; o1.z = ow[6]; o1.w = ow[7];
            *(v4u*)(MIX + row * 1024 + h * 128 + e0) = o0; *(v4u*)(MIX + row * 1024 + h * 128 + e0 + 8) = o1;
        }
    }
}
}

namespace pool {
typedef __attribute__((address_space(3))) unsigned char lds_t;
typedef __attribute__((address_space(3))) float lf;
constexpr int V_LD = 132, O_V0 = 0, O_V1 = 33792;
constexpr int PD_LS = 272;
constexpr int O_XG = 67584;
constexpr int O_PD = 102400;
static_assert(O_PD + 128 * PD_LS <= MISC_OFF, "pool LDS map");

template <int GI> struct PX { v4u x[2][(2 << GI) + 1]; };
template <int GI>
__device__ __forceinline__ void gload(PX<GI>& X, const Params& p, int b, int r0) {
    const int tid = ltid(), lane = tid & 63, wv = tid >> 6, co = lane & 15;
    const bf16* PROJ = (const bf16*)(p.ws + WS_PROJ);
    constexpr int w = 2 << GI, lo = w >> 1;
#pragma unroll
    for (int h2 = 0; h2 < 2; ++h2) {
        const int c = 8 * wv + 4 * h2 + (lane >> 4);
        const bf16* src = PROJ + (size_t)(b * SEQ + c) * NPROJ + PP + GI * 128 + 8 * co;
#pragma unroll
        for (int t = 0; t <= w; ++t) { const int r2 = min(max(r0 - lo + t, 0), 127); X.x[h2][t] = *(const v4u*)(src + (size_t)r2 * 64 * NPROJ); }
    }
}
template <int GI, class NX>
__device__ __forceinline__ void group(const Params& p, lds_t* L, int b, int r0, int tok0, PX<GI>& X, NX* nxt) {
    const int tid = ltid(), lane = tid & 63, wv = tid >> 6, hh = lane >> 5;
    const bf16* PROJ = (const bf16*)(p.ws + WS_PROJ); bf16* MIX = (bf16*)(p.ws + WS_MIX); const bf16* WPT = (const bf16*)(p.ws + WS_WPOOL);
    const float* pscale = p.in[12];
    constexpr int gi = GI, w = 2 << GI, lo = w >> 1, hi = w - 1 - lo;
    const float ps = pscale[gi * 128 + (tid & 127)];
    {
        const int co = lane & 15;
        v4u (&x)[2][w + 1] = X.x;
#pragma unroll
        for (int h2 = 0; h2 < 2; ++h2) {
            const int c = 8 * wv + 4 * h2 + (lane >> 4);
            float a0[8], a1[8];
#pragma unroll
            for (int q = 0; q < 8; ++q) { a0[q] = 0.f; a1[q] = 0.f; }
#pragma unroll
            for (int t = 0; t <= w; ++t) { const int r2 = r0 - lo + t; const float m = (r2 >= 0 && r2 < 128) ? 1.f : 0.f;
#pragma unroll
                for (int q = 0; q < 4; ++q) { const float xl = m * __uint_as_float(x[h2][t][q] << 16), xh = m * __uint_as_float(x[h2][t][q] & 0xffff0000u);
                    if (t < w) { a0[2 * q] += xl; a0[2 * q + 1] += xh; }
                    if (t > 0) { a1[2 * q] += xl; a1[2 * q + 1] += xh; } } }
            lf* v0 = (lf*)(L + O_V0) + c * V_LD + 8 * co; lf* v1 = (lf*)(L + O_V1) + c * V_LD + 8 * co;
            *(__attribute__((address_space(3))) f32x4*)v0 = (f32x4){a0[0], a0[1], a0[2], a0[3]}; *(__attribute__((address_space(3))) f32x4*)(v0 + 4) = (f32x4){a0[4], a0[5], a0[6], a0[7]};
            *(__attribute__((address_space(3))) f32x4*)v1 = (f32x4){a1[0], a1[1], a1[2], a1[3]}; *(__attribute__((address_space(3))) f32x4*)(v1 + 4) = (f32x4){a1[4], a1[5], a1[6], a1[7]};
            *(__attribute__((address_space(3))) v4u*)(L + O_XG + c * PD_LS + co * 16) = x[h2][lo];
            *(__attribute__((address_space(3))) v4u*)(L + O_XG + (64 + c) * PD_LS + co * 16) = x[h2][lo + 1];
        }
    }
    __syncthreads();
    if constexpr (GI < 3) gload<GI + 1>(*nxt, p, b, r0);
#pragma unroll
    for (int rr = 0; rr < 2; ++rr) {
        const int r = r0 + rr, rs = max(r - lo, 0), re = min(r + hi + 1, 128);
        const int ch = tid & 127, c0 = 16 * (tid >> 7);
        const lf* V = (const lf*)(L + (rr ? O_V1 : O_V0)) + ch;
        const float invr = 1.f / (float)(re - rs);
        float sacc = 0.f;
        for (int c2 = max(c0 - lo, 0); c2 <= min(c0 + hi, 63); ++c2) sacc += V[c2 * V_LD];
#pragma unroll 4
        for (int ci = 0; ci < 16; ++ci) {
            const int c = c0 + ci;
            if (ci > 0) { const int ad = c + hi, rm = c - lo - 1; if (ad < 64) sacc += V[ad * V_LD]; if (rm >= 0) sacc -= V[rm * V_LD]; }
            const int cs = max(c - lo, 0), ce = min(c + hi + 1, 64);
            const float m = sacc * invr / (float)(ce - cs);
            const float x = bf2f(*(const __attribute__((address_space(3))) unsigned short*)(L + O_XG + (64 * rr + c) * PD_LS + ch * 2));
            MIX[(size_t)(tok0 + 64 * rr + c) * 1024 + 512 + gi * 128 + ch] = (bf16)f2bf((m - x) * ps);
        }
    }
    __syncthreads();
}
__device__ __forceinline__ void unit(const Params& p, lds_t* L, int b, int rp) {
    const int r0 = 2 * rp, tok0 = b * SEQ + r0 * 64;
    PX<0> x0; gload<0>(x0, p, b, r0);
    __syncthreads();
    PX<1> x1; group<0>(p, L, b, r0, tok0, x0, &x1);
    PX<2> x2; group<1>(p, L, b, r0, tok0, x1, &x2);
    PX<3> x3; group<2>(p, L, b, r0, tok0, x2, &x3);
    group<3>(p, L, b, r0, tok0, x3, (PX<3>*)nullptr);
}
}

__device__ __forceinline__ void phase0(const Params& p, unsigned char* lds) {
    const int tid = ltid(), lane = tid & 63, wave = tid >> 6, G = gridDim.x;
    const int gtid = blockIdx.x * 512 + tid, gthreads = G * 512;
    float* MOD = (float*)(p.ws + WS_MOD);
    const float* c = p.in[1]; const float* cctx = p.in[3]; const float* w_ada = p.in[4]; const float* b_ada = p.in[5];
    {
        float* SIL = (float*)lds;
        float* RED = (float*)(lds + 20480);
        for (int i = tid; i < 5 * 1024; i += 512) { const float v = i < 4096 ? c[i] : cctx[i - 4096]; SIL[i] = silu(v); }
        __syncthreads();
        for (int task = blockIdx.x; task < 192; task += G) {
            const int kg = tid >> 5, col = tid & 31;
            float wv[64];
#pragma unroll
            for (int k = 0; k < 64; ++k) wv[k] = w_ada[(size_t)(64 * kg + k) * 6144 + 32 * task + col];
            float a[5] = {0.f, 0.f, 0.f, 0.f, 0.f};
#pragma unroll
            for (int k = 0; k < 64; ++k)
#pragma unroll
                for (int v = 0; v < 5; ++v) a[v] += SIL[v * 1024 + 64 * kg + k] * wv[k];
#pragma unroll
            for (int v = 0; v < 5; ++v) RED[(kg * 5 + v) * 32 + col] = a[v];
            __syncthreads();
            if (tid < 160) { const int v = tid >> 5; float sacc = b_ada[32 * task + col];
#pragma unroll
                for (int g = 0; g < 16; ++g) sacc += RED[(g * 5 + v) * 32 + col];
                MOD[v * 6144 + 32 * task + col] = sacc; }
            __syncthreads();
        }
    }
    const float* w_in = p.in[7];
    bf16* WA = (bf16*)(p.ws + WS_WA);
    for (int idx = gtid; idx < 32 * 1024; idx += gthreads) { const int jj = idx >> 10, k = idx & 1023; WA[idx] = (bf16)f2bf(w_in[(size_t)k * IN_COLS + OFF_A + jj]); }
    const float* w_rg = p.in[15]; const float* w_re = p.in[16];
    bf16* WRH = (bf16*)(p.ws + WS_WR); bf16* WRL = WRH + 48 * 1024;
    for (int idx = gtid; idx < 48 * 1024; idx += gthreads) { const int r = idx >> 10, k = idx & 1023;
        const float v = r < 32 ? w_re[k * 32 + r] : (r < 36 ? w_rg[k * 4 + (r - 32)] : 0.f);
        const unsigned hi = f2bf(v); WRH[idx] = (bf16)hi; WRL[idx] = (bf16)f2bf(v - bf2f(hi)); }
    {
        float* TA = (float*)lds;
        float* TB = (float*)(lds + 32768);
        bf16* WINp = (bf16*)(p.ws + WS_WIN);
        const int nfold = 64, fb = (G == 256) ? (int)blockIdx.x - 192 : (int)blockIdx.x, fs = (G == 256) ? 64 : G;
        for (int task = fb; task >= 0 && task < nfold; task += fs) {
            const int g = task >> 4, k0 = (task & 15) * 64;
            __syncthreads();
            for (int i = tid; i < 64 * 32; i += 512) { const int k = i >> 5, c4 = i & 31; *(f32x4*)(TA + k * 128 + 4 * c4) = *(const f32x4*)(p.in[7] + (size_t)(k0 + k) * IN_COLS + OFF_P + g * 128 + 4 * c4); }
            for (int i = tid; i < 128 * 32; i += 512) *(f32x4*)(TB + 4 * i) = *(const f32x4*)(p.in[11] + (size_t)g * 16384 + 4 * i);
            __syncthreads();
            const int d = tid & 127, kq = tid >> 7;
            float acc[16];
#pragma unroll
            for (int i = 0; i < 16; ++i) acc[i] = 0.f;
            for (int c = 0; c < 128; c += 4) {
                const float w0 = TB[c * 128 + d], w1 = TB[(c + 1) * 128 + d], w2 = TB[(c + 2) * 128 + d], w3 = TB[(c + 3) * 128 + d];
#pragma unroll
                for (int i = 0; i < 16; ++i) { const f32x4 a = *(const f32x4*)(TA + (kq * 16 + i) * 128 + c); acc[i] += a.x * w0 + a.y * w1 + a.z * w2 + a.w * w3; }
            }
            v4u o0, o1;
            o0.x = pk2(acc[0], acc[1]); o0.y = pk2(acc[2], acc[3]); o0.z = pk2(acc[4], acc[5]); o0.w = pk2(acc[6], acc[7]);
            o1.x = pk2(acc[8], acc[9]); o1.y = pk2(acc[10], acc[11]); o1.z = pk2(acc[12], acc[13]); o1.w = pk2(acc[14], acc[15]);
            bf16* dst = WINp + (size_t)(1536 + g * 128 + d) * 1024 + k0 + kq * 16;
            *(v4u*)dst = o0; *(v4u*)(dst + 8) = o1;
        }
        __syncthreads();
    }
    float* scr = (float*)(lds + wave * 8448);
    const int gw = blockIdx.x * 8 + wave, NGW = G * 8;
    bf16* WIN = (bf16*)(p.ws + WS_WIN); bf16* WOUT = (bf16*)(p.ws + WS_WOUT); bf16* WE1 = (bf16*)(p.ws + WS_WE1); bf16* WE2 = (bf16*)(p.ws + WS_WE2);
    const float* w_out = p.in[13]; const float* w_e_in = p.in[17]; const float* w_e_out = p.in[18];
    constexpr int I_A = 16 * 48, I_O = 16 * 32, I_E1 = 32 * 256, I_E2 = 32 * 128;
    auto desc_of = [&](int it) -> TDesc {
        int r = it;
        if (r < I_A) return tdesc(w_in, IN_COLS, 48, WIN, 1024, r); r -= I_A;
        if (r < I_O) return tdesc(w_out, 1024, 32, WOUT, 1024, r); r -= I_O;
        if (r < I_E1) { const int e = r >> 8, sub = (r >> 6) & 3, item = r & 63, pn = sub >> 1, half = sub & 1;
            const int kb = item >> 2, nb = item & 3, k0 = 64 * kb, n0 = 32 * nb;
            return TDesc{w_e_in + (size_t)e * 1024 * 512 + half * 256 + 128 * pn + (size_t)k0 * 512 + n0, 512,
                         (bf16*)((unsigned char*)WE1 + ((size_t)e * 512 + 256 * pn + 128 * half + n0) * 1024 + k0), 1024, 32}; } r -= I_E1;
        { const int e = r >> 7, item = r & 127, kb = item >> 5, nb = item & 31, k0 = 64 * kb, n0 = 32 * nb;
          return TDesc{w_e_out + (size_t)e * 256 * 1024 + (size_t)k0 * 1024 + n0, 1024, (bf16*)((unsigned char*)WE2 + ((size_t)e * 1024 + n0) * 256 + k0), 256, 16}; }
    };
    constexpr int NIT = I_A + I_O + I_E1 + I_E2;
    if (gw < NIT) {
        TDesc d = desc_of(gw); float tv[32]; titem_load(d, tv, lane);
        for (int it = gw; it < NIT; it += NGW) {
            const bool has = it + NGW < NIT;
            TDesc dn = d; float tn[32];
            if (has) { dn = desc_of(it + NGW); titem_load(dn, tn, lane); }
            titem_store(d, tv, scr, lane);
            if (has) { d = dn;
#pragma unroll
                for (int i = 0; i < 32; ++i) tv[i] = tn[i]; }
        }
    }
}

namespace skinny {
typedef __attribute__((address_space(3))) unsigned char lds_t;
typedef short bf16x8 __attribute__((ext_vector_type(8)));
constexpr int TLS = 2064;
constexpr int O_THI = 0, O_TLO = 16 * TLS, O_PART = 2 * 16 * TLS, O_LOG = O_PART + 8 * 16 * 48 * 4, O_RT = O_LOG + 16 * 48 * 4;
template <int NT, bool SPLIT>
__device__ __forceinline__ void mma_part(lds_t* L, const bf16* WH, const bf16* WL, int wv, int lane) {
    const int fr = lane & 15, fq = lane >> 4;
    f32x4 acc[NT];
#pragma unroll
    for (int t = 0; t < NT; ++t) acc[t] = (f32x4){0.f, 0.f, 0.f, 0.f};
#pragma unroll
    for (int s2 = 0; s2 < 4; ++s2) {
        const int k = 128 * wv + 32 * s2 + 8 * fq;
        const bf16x8 ah = *(const __attribute__((address_space(3))) bf16x8*)(L + O_THI + fr * TLS + k * 2);
        bf16x8 al; if (SPLIT) al = *(const __attribute__((address_space(3))) bf16x8*)(L + O_TLO + fr * TLS + k * 2);
#pragma unroll
        for (int t = 0; t < NT; ++t) {
            const bf16x8 bh = *(const bf16x8*)(WH + (size_t)(16 * t + fr) * 1024 + k);
            acc[t] = __builtin_amdgcn_mfma_f32_16x16x32_bf16(ah, bh, acc[t], 0, 0, 0);
            if (SPLIT) { const bf16x8 bl = *(const bf16x8*)(WL + (size_t)(16 * t + fr) * 1024 + k);
                acc[t] = __builtin_amdgcn_mfma_f32_16x16x32_bf16(al, bh, acc[t], 0, 0, 0);
                acc[t] = __builtin_amdgcn_mfma_f32_16x16x32_bf16(ah, bl, acc[t], 0, 0, 0); }
        }
    }
    __attribute__((address_space(3))) float* P = (__attribute__((address_space(3))) float*)(L + O_PART) + wv * 16 * 16 * NT;
#pragma unroll
    for (int t = 0; t < NT; ++t)
#pragma unroll
        for (int q = 0; q < 4; ++q) P[(4 * fq + q) * 16 * NT + 16 * t + fr] = acc[t][q];
}
template <int NT>
__device__ __forceinline__ void load_bfrags(bf16x8 (&bh)[NT][4], const bf16* W, int wv, int lane) {
    const int fr = lane & 15, fq = lane >> 4;
#pragma unroll
    for (int t = 0; t < NT; ++t)
#pragma unroll
        for (int s2 = 0; s2 < 4; ++s2) bh[t][s2] = *(const bf16x8*)(W + (size_t)(16 * t + fr) * 1024 + 128 * wv + 32 * s2 + 8 * fq);
}
template <int NT, bool SPLIT>
__device__ __forceinline__ void mma_part_reg(lds_t* L, const bf16x8 (&bh)[NT][4], int wv, int lane) {
    const int fr = lane & 15, fq = lane >> 4;
    f32x4 acc[NT];
#pragma unroll
    for (int t = 0; t < NT; ++t) acc[t] = (f32x4){0.f, 0.f, 0.f, 0.f};
#pragma unroll
    for (int s2 = 0; s2 < 4; ++s2) {
        const int k = 128 * wv + 32 * s2 + 8 * fq;
        const bf16x8 ah = *(const __attribute__((address_space(3))) bf16x8*)(L + O_THI + fr * TLS + k * 2);
        bf16x8 al; if (SPLIT) al = *(const __attribute__((address_space(3))) bf16x8*)(L + O_TLO + fr * TLS + k * 2);
#pragma unroll
        for (int t = 0; t < NT; ++t) {
            acc[t] = __builtin_amdgcn_mfma_f32_16x16x32_bf16(ah, bh[t][s2], acc[t], 0, 0, 0);
            if (SPLIT) acc[t] = __builtin_amdgcn_mfma_f32_16x16x32_bf16(al, bh[t][s2], acc[t], 0, 0, 0);
        }
    }
    __attribute__((address_space(3))) float* P = (__attribute__((address_space(3))) float*)(L + O_PART) + wv * 16 * 16 * NT;
#pragma unroll
    for (int t = 0; t < NT; ++t)
#pragma unroll
        for (int q = 0; q < 4; ++q) P[(4 * fq + q) * 16 * NT + 16 * t + fr] = acc[t][q];
}
template <int NT>
__device__ __forceinline__ float part_sum(const lds_t* L, int idx) {
    const __attribute__((address_space(3))) float* P = (const __attribute__((address_space(3))) float*)(L + O_PART);
    float s = 0.f;
#pragma unroll
    for (int w = 0; w < 8; ++w) s += P[w * 16 * 16 * NT + idx];
    return s;
}
}

struct P1Iters {
    int G, b;
    __device__ __forceinline__ int count() const { if (G != 256) return (TT / 16 - b + G - 1) / G; return 9; }
    __device__ __forceinline__ int at(int li) const {
        if (G != 256) return b + li * G;
        return li == 0 ? T / 16 + (b >> 2) : b * 8 + (li - 1);
    }
    __device__ __forceinline__ int quarter() const { return G != 256 ? -1 : (b & 3); }
};
__device__ __forceinline__ void phase1(const Params& p, unsigned char* lds) {
    using namespace skinny;
    lds_t* L = (lds_t*)lds;
    const int tid = ltid(), lane = tid & 63, wave = tid >> 6, G = gridDim.x;
    const float* MOD = (const float*)(p.ws + WS_MOD); const bf16* WA = (const bf16*)(p.ws + WS_WA); const bf16* WIN = (const bf16*)(p.ws + WS_WIN);
    bf16* H = (bf16*)(p.ws + WS_H); float* ALOW = (float*)(p.ws + WS_ALOW); bf16* PROJ = (bf16*)(p.ws + WS_PROJ);
    const float* g1 = p.in[6];
    const P1Iters I{G, (int)blockIdx.x};
    const int nit = I.count();
    bf16x8 bw[2][4]; load_bfrags<2>(bw, WA, wave, lane);
    f32x4 nx[2][4], nx2[2][4];
#pragma unroll
    for (int rr = 0; rr < 2; ++rr)
#pragma unroll
        for (int j = 0; j < 4; ++j) { nx[rr][j] = (f32x4){0.f, 0.f, 0.f, 0.f}; nx2[rr][j] = (f32x4){0.f, 0.f, 0.f, 0.f}; }
    auto xrow = [&](int it, int rr) -> const float* { const int row = it * 16 + wave * 2 + rr; return row < T ? p.in[0] + (size_t)row * D : p.in[2] + (size_t)(row - T) * D; };
    if (nit > 0) {
#pragma unroll
        for (int rr = 0; rr < 2; ++rr)
#pragma unroll
            for (int j = 0; j < 4; ++j) nx[rr][j] = ((const f32x4*)xrow(I.at(0), rr))[lane + 64 * j]; }
    if (nit > 1) {
#pragma unroll
        for (int rr = 0; rr < 2; ++rr)
#pragma unroll
            for (int j = 0; j < 4; ++j) nx2[rr][j] = ((const f32x4*)xrow(I.at(1), rr))[lane + 64 * j]; }
#pragma unroll 1
    for (int li = 0; li < nit; ++li) {
        const int it = I.at(li);
        f32x4 v[2][4];
#pragma unroll
        for (int rr = 0; rr < 2; ++rr)
#pragma unroll
            for (int j = 0; j < 4; ++j) { v[rr][j] = nx[rr][j]; nx[rr][j] = nx2[rr][j]; }
        if (li + 2 < nit) {
#pragma unroll
            for (int rr = 0; rr < 2; ++rr)
#pragma unroll
                for (int j = 0; j < 4; ++j) nx2[rr][j] = ((const f32x4*)xrow(I.at(li + 2), rr))[lane + 64 * j]; }
        f32x4 gm1[4], sh1[4];
        { const float* md = MOD + (it * 16 < T ? ((it * 16) >> 13) : 4) * 6144;
#pragma unroll
          for (int j = 0; j < 4; ++j) { gm1[j] = ((const f32x4*)g1)[lane + 64 * j] * (((const f32x4*)(md + 1024))[lane + 64 * j] + 1.f); sh1[j] = ((const f32x4*)md)[lane + 64 * j]; } }
        __syncthreads();
#pragma unroll
        for (int rr = 0; rr < 2; ++rr) {
            const int lr = wave * 2 + rr, row = it * 16 + lr;
            float ss = 0.f;
#pragma unroll
            for (int j = 0; j < 4; ++j) ss += v[rr][j].x * v[rr][j].x + v[rr][j].y * v[rr][j].y + v[rr][j].z * v[rr][j].z + v[rr][j].w * v[rr][j].w;
            const float r = frsq(wave_sum(ss) * (1.f / D) + EPS);
#pragma unroll
            for (int j = 0; j < 4; ++j) {
                const f32x4 hv = v[rr][j] * r * gm1[j] + sh1[j];
                const unsigned long long o = (unsigned long long)pk2(hv.x, hv.y) | ((unsigned long long)pk2(hv.z, hv.w) << 32);
                if (row < T) ((unsigned long long*)(H + (size_t)row * D))[lane + 64 * j] = o;
                *(__attribute__((address_space(3))) unsigned long long*)(L + O_THI + lr * TLS + (lane + 64 * j) * 8) = o;
            }
        }
        __syncthreads();
        mma_part_reg<2, false>(L, bw, wave, lane);
        if (it >= T / 16) {
            const int fr = lane & 15, fq = lane >> 4, q0 = I.quarter() < 0 ? 0 : I.quarter(), q1 = I.quarter() < 0 ? 4 : I.quarter() + 1;
            for (int qt = q0; qt < q1; ++qt) {
                f32x4 acc[3];
#pragma unroll
                for (int t = 0; t < 3; ++t) acc[t] = (f32x4){0.f, 0.f, 0.f, 0.f};
                const int c0 = PK + 192 * qt + 48 * (wave & 3), kh = wave >> 2;
                const bf16* wb = WIN + (size_t)(c0 + fr) * 1024 + 512 * kh + 8 * fq;
#pragma unroll 1
                for (int sb = 0; sb < 4; ++sb) {
                    bf16x8 bq[4][3];
#pragma unroll
                    for (int s2 = 0; s2 < 4; ++s2)
#pragma unroll
                        for (int t = 0; t < 3; ++t) bq[s2][t] = *(const bf16x8*)(wb + (size_t)t * 16 * 1024 + 32 * (4 * sb + s2));
#pragma unroll
                    for (int s2 = 0; s2 < 4; ++s2) {
                        const bf16x8 a = *(const __attribute__((address_space(3))) bf16x8*)(L + O_THI + fr * TLS + (512 * kh + 32 * (4 * sb + s2) + 8 * fq) * 2);
#pragma unroll
                        for (int t = 0; t < 3; ++t) acc[t] = __builtin_amdgcn_mfma_f32_16x16x32_bf16(a, bq[s2][t], acc[t], 0, 0, 0);
                    }
                }
                __attribute__((address_space(3))) float* CP = (__attribute__((address_space(3))) float*)(L + O_LOG);
#pragma unroll
                for (int t = 0; t < 3; ++t)
#pragma unroll
                    for (int q = 0; q < 4; ++q) CP[(kh * 16 + 4 * fq + q) * 192 + 48 * (wave & 3) + 16 * t + fr] = acc[t][q];
                __syncthreads();
                for (int idx = tid; idx < 16 * 96; idx += 512) { const int r = idx / 96, c2 = (idx - r * 96) * 2;
                    const float v0 = CP[r * 192 + c2] + CP[(16 + r) * 192 + c2], v1 = CP[r * 192 + c2 + 1] + CP[(16 + r) * 192 + c2 + 1];
                    *(unsigned*)(PROJ + (size_t)(it * 16 + r) * NPROJ + PK + 192 * qt + c2) = pk2(v0, v1); }
                __syncthreads();
            }
        }
        __syncthreads();
        ALOW[(size_t)it * 16 * 32 + tid] = part_sum<2>(L, tid);
    }
}

__device__ __forceinline__ void phase2(const Params& p, unsigned char* lds) {
    const bf16* H = (const bf16*)(p.ws + WS_H); const bf16* WIN = (const bf16*)(p.ws + WS_WIN); bf16* PROJ = (bf16*)(p.ws + WS_PROJ);
    pg8::SchedDense S; S.init(T, NPROJ, D, WIN, (int)gridDim.x, (int)blockIdx.x);
    pg8::EpiProj E{PROJ, NPROJ};
    pg8::gemm_phase<pg8::EpiProj, pg8::SchedDense, true>((PG8_LAS unsigned char*)lds, H, D, S, E);
}

__device__ __forceinline__ void phase4(const Params& p, unsigned char* lds) {
    for (int u = blockIdx.x; u < NB * 32 * 4 + NB * 4 * 4; u += gridDim.x) {
        if (u < NB * 32 * 4) gla::state_unit(p, (gla::lds_t*)lds, u >> 7, 4 + ((u >> 2) & 31), u & 3);
        else { const int v = u - NB * 32 * 4; gla::state_unit(p, (gla::lds_t*)lds, v >> 4, (v >> 2) & 3, v & 3); }
    }
    __syncthreads();
}

__device__ __forceinline__ void phase5(const Params& p) {
    const int gtid = blockIdx.x * 512 + threadIdx.x, gthreads = gridDim.x * 512;
    const float* DST = (const float*)(p.ws + WS_DST); const float* DEC = (const float*)(p.ws + WS_DEC); float* SPREV = (float*)(p.ws + WS_SPREV);
    typedef float f32x2 __attribute__((ext_vector_type(2)));
    for (int idx = gtid; idx < 2 * NB * 4 * 4096; idx += gthreads) {
        const int de = (idx & 4095) * 2, h = (idx >> 12) & 3, b = (idx >> 14) & 3, dir = idx >> 16, d = de >> 7;
        const int ub = ((dir * NB + b) * NSI) * 4 + h, us = ((dir * NB + b) * 32) * 4 + h;
        f32x2 ds[NSI]; float dc[NSI];
#pragma unroll
        for (int si = 0; si < NSI; ++si) { ds[si] = *(const f32x2*)(DST + (size_t)(ub + 4 * si) * 8192 + de); dc[si] = DEC[(ub + 4 * si) * 64 + d]; }
        if (dir == 0) {
            f32x2 S = ds[0];
#pragma unroll
            for (int si = 1; si < 4; ++si) S = S * dc[si] + ds[si];
#pragma unroll
            for (int si = 4; si < NSI; ++si) { *(f32x2*)(SPREV + (size_t)(us + 4 * (si - 4)) * 8192 + de) = S; S = S * dc[si] + ds[si]; }
        } else {
            f32x2 S = ds[3];
#pragma unroll
            for (int si = 2; si >= 0; --si) S = S * dc[si] + ds[si];
#pragma unroll
            for (int si = NSI - 1; si >= 4; --si) { *(f32x2*)(SPREV + (size_t)(us + 4 * (si - 4)) * 8192 + de) = S; S = S * dc[si] + ds[si]; }
        }
    }
}

__device__ __forceinline__ void phase6(const Params& p, unsigned char* lds) {
    gla::lds_t* L = (gla::lds_t*)lds;
    for (int unit = blockIdx.x; unit < NB * 32 * 4; unit += gridDim.x) {
        const int h = unit & 3, sc = (unit >> 2) & 31, b = unit >> 7;
        gla::out_pass<1>(p, L, b, sc, h);
        gla::out_pass<0>(p, L, b, sc, h);
    }
    __syncthreads();
}

__device__ __forceinline__ void phase7(const Params& p, unsigned char* lds) {
    const int G = gridDim.x, vcu = (G % 8 == 0) ? (int)(blockIdx.x % 8) * (G / 8) + (int)(blockIdx.x / 8) : (int)blockIdx.x;
    for (int u = vcu; u < NB * 64; u += G) pool::unit(p, (pool::lds_t*)lds, u >> 6, u & 63);
    __syncthreads();
}

__device__ __forceinline__ void phase8(const Params& p, unsigned char* lds) {
    const bf16* MIX = (const bf16*)(p.ws + WS_MIX); const bf16* WOUT = (const bf16*)(p.ws + WS_WOUT); const float* MOD = (const float*)(p.ws + WS_MOD);
    pg8::SchedDense S; S.init(T, D, D, WOUT, (int)gridDim.x, (int)blockIdx.x);
    pg8::EpiOut E{(bf16*)(p.ws + WS_OUTP), MOD};
    pg8::gemm_phase<pg8::EpiOut, pg8::SchedDense, true>((PG8_LAS unsigned char*)lds, MIX, D, S, E);
}

__device__ __forceinline__ void phase9(const Params& p, unsigned char* lds) {
    using namespace skinny;
    lds_t* L = (lds_t*)lds;
    typedef __attribute__((address_space(3))) float lf; typedef __attribute__((address_space(3))) int li;
    const int tid = ltid(), lane = tid & 63, wave = tid >> 6, G = gridDim.x;
    const float* MOD = (const float*)(p.ws + WS_MOD); const bf16* WRH = (const bf16*)(p.ws + WS_WR); const bf16* WRL = WRH + 48 * 1024;
    bf16* H2 = (bf16*)(p.ws + WS_H); int* LIST = (int*)(p.ws + WS_LIST);
    unsigned* CNT = (unsigned*)(p.ws + WS_CTL) + CW_CNT;
    const float* g2 = p.in[14];
    lf* LOG = (lf*)(L + O_LOG);
    li* EID = (li*)(L + O_RT);
    lf* EWT = (lf*)(L + O_RT + 1024);
    li* RNK = (li*)(L + O_RT + 2048);
    li* LCN = (li*)(L + O_RT + 3072);
    bf16x8 bwh[3][4]; load_bfrags<3>(bwh, WRH, wave, lane);
    for (int blk = blockIdx.x; blk < T / 128; blk += G) {
        __syncthreads();
        if (tid < 32) LCN[tid] = 0;
        f32x4 gm9[4], sh9[4];
        { const float* md = MOD + ((blk * 128) >> 13) * 6144;
#pragma unroll
          for (int j = 0; j < 4; ++j) { gm9[j] = ((const f32x4*)g2)[lane + 64 * j] * (((const f32x4*)(md + 4096))[lane + 64 * j] + 1.f); sh9[j] = ((const f32x4*)(md + 3072))[lane + 64 * j]; } }
        unsigned long long nx[2][4]; f32x4 nf[2][4];
#pragma unroll
        for (int rr = 0; rr < 2; ++rr)
#pragma unroll
            for (int j = 0; j < 4; ++j) { const size_t ro = (size_t)(blk * 128 + wave * 2 + rr) * D;
                nx[rr][j] = ((const unsigned long long*)((const bf16*)(p.ws + WS_OUTP) + ro))[lane + 64 * j]; nf[rr][j] = ((const f32x4*)(p.in[0] + ro))[lane + 64 * j]; }
#pragma unroll 1
        for (int it8 = 0; it8 < 8; ++it8) {
            const int row0 = blk * 128 + it8 * 16;
            unsigned long long cx[2][4]; f32x4 cf[2][4];
#pragma unroll
            for (int rr = 0; rr < 2; ++rr)
#pragma unroll
                for (int j = 0; j < 4; ++j) { cx[rr][j] = nx[rr][j]; cf[rr][j] = nf[rr][j]; }
            if (it8 < 7) {
#pragma unroll
                for (int rr = 0; rr < 2; ++rr)
#pragma unroll
                    for (int j = 0; j < 4; ++j) { const size_t ro = (size_t)(row0 + 16 + wave * 2 + rr) * D;
                        nx[rr][j] = ((const unsigned long long*)((const bf16*)(p.ws + WS_OUTP) + ro))[lane + 64 * j]; nf[rr][j] = ((const f32x4*)(p.in[0] + ro))[lane + 64 * j]; }
            }
            __syncthreads();
#pragma unroll
            for (int rr = 0; rr < 2; ++rr) {
                const int lr = wave * 2 + rr, row = row0 + lr;
                const float* md = MOD + (row >> 13) * 6144;
                f32x4 v[4]; float ss = 0.f;
#pragma unroll
                for (int j = 0; j < 4; ++j) { const unsigned long long xw = cx[rr][j];
                    v[j].x = cf[rr][j].x + bf2f((unsigned)(xw & 0xffff)); v[j].y = cf[rr][j].y + bf2f((unsigned)((xw >> 16) & 0xffff)); v[j].z = cf[rr][j].z + bf2f((unsigned)((xw >> 32) & 0xffff)); v[j].w = cf[rr][j].w + bf2f((unsigned)(xw >> 48));
                    ((unsigned long long*)((bf16*)(p.ws + WS_XMID) + (size_t)row * D))[lane + 64 * j] = (unsigned long long)pk2(v[j].x, v[j].y) | ((unsigned long long)pk2(v[j].z, v[j].w) << 32);
                    ss += v[j].x * v[j].x + v[j].y * v[j].y + v[j].z * v[j].z + v[j].w * v[j].w; }
                const float r = frsq(wave_sum(ss) * (1.f / D) + EPS);
#pragma unroll
                for (int j = 0; j < 4; ++j) {
                    v[j] = v[j] * r * gm9[j] + sh9[j];
                    const unsigned h0 = f2bf(v[j].x), h1 = f2bf(v[j].y), h2 = f2bf(v[j].z), h3 = f2bf(v[j].w);
                    const unsigned long long o = (unsigned long long)(h0 | (h1 << 16)) | ((unsigned long long)(h2 | (h3 << 16)) << 32);
                    const unsigned long long ol = (unsigned long long)pk2(v[j].x - bf2f(h0), v[j].y - bf2f(h1)) | ((unsigned long long)pk2(v[j].z - bf2f(h2), v[j].w - bf2f(h3)) << 32);
                    { unsigned q8 = 0; q8 = __builtin_amdgcn_cvt_pk_fp8_f32(v[j].x, v[j].y, q8, false); q8 = __builtin_amdgcn_cvt_pk_fp8_f32(v[j].z, v[j].w, q8, true);
                      ((unsigned*)((unsigned char*)H2 + (size_t)row * D))[lane + 64 * j] = q8; }
                    *(__attribute__((address_space(3))) unsigned long long*)(L + O_THI + lr * TLS + (lane + 64 * j) * 8) = o;
                    *(__attribute__((address_space(3))) unsigned long long*)(L + O_TLO + lr * TLS + (lane + 64 * j) * 8) = ol;
                }
            }
            __syncthreads();
            mma_part_reg<3, true>(L, bwh, wave, lane);
            __syncthreads();
            LOG[tid] = part_sum<3>(L, tid);
            if (tid < 256) LOG[512 + tid] = part_sum<3>(L, 512 + tid);
            __syncthreads();
            if (tid < 16) {
                const lf* lg = LOG + tid * 48;
                int gi = 0; float gm = lg[32];
#pragma unroll
                for (int q = 1; q < 4; ++q) if (lg[32 + q] > gm) { gm = lg[32 + q]; gi = q; }
                float gs = 0.f;
#pragma unroll
                for (int q = 0; q < 4; ++q) gs += __expf(lg[32 + q] - gm);
                const float gp = 1.f / gs;
                float le[8];
#pragma unroll
                for (int q = 0; q < 8; ++q) le[q] = lg[gi * 8 + q];
                int i0 = 0; float m0 = le[0];
#pragma unroll
                for (int q = 1; q < 8; ++q) if (le[q] > m0) { m0 = le[q]; i0 = q; }
                int i1 = -1; float m1 = -3.0e38f;
#pragma unroll
                for (int q = 0; q < 8; ++q) if (q != i0 && le[q] > m1) { m1 = le[q]; i1 = q; }
                const float e1 = __expf(m1 - m0), w0 = gp / (1.f + e1), w1 = gp * e1 / (1.f + e1);
                const int pr = (it8 * 16 + tid) * 2;
                EID[pr] = gi * 8 + i0; EWT[pr] = w0; EID[pr + 1] = gi * 8 + i1; EWT[pr + 1] = w1;
            }
        }
        __syncthreads();
        if (tid < 256) RNK[tid] = __hip_atomic_fetch_add((int*)(LCN + EID[tid]), 1, __ATOMIC_RELAXED, __HIP_MEMORY_SCOPE_WORKGROUP);
        __syncthreads();
        if (tid < 32) { const int c = LCN[tid]; LCN[tid] = c ? (int)atomicAdd(CNT + tid, (unsigned)c) : 0; }
        __syncthreads();
        if (tid < 256) { const int e = EID[tid], tok2 = blk * 256 + tid; const size_t sl = (size_t)(e * T + LCN[e] + RNK[tid]); LIST[2 * sl] = tok2; LIST[2 * sl + 1] = __float_as_int(EWT[tid]); }
    }
}

__device__ __forceinline__ void moe_tables(const Params& p, unsigned char* lds) {
    PG8_LAS int* tp = (PG8_LAS int*)((PG8_LAS unsigned char*)lds + MISC_OFF) + 32; PG8_LAS int* cn = tp + 64;
    const unsigned* CNT = (const unsigned*)(p.ws + WS_CTL) + CW_CNT;
    __syncthreads();
    if (threadIdx.x < 32) cn[threadIdx.x] = (int)CNT[threadIdx.x];
    __syncthreads();
    if (threadIdx.x == 0) { int a = 0; for (int e = 0; e < 32; ++e) { tp[e] = a; a += (cn[e] + 255) >> 8; } tp[32] = a; }
    __syncthreads();
    {
        PG8_LAS unsigned char* r2e = (PG8_LAS unsigned char*)(tp + 96);
        for (int rt = threadIdx.x; rt < 288; rt += 512) { int e = 0; while (e < 31 && tp[e + 1] <= rt) ++e; r2e[rt] = (unsigned char)e; }
    }
    __syncthreads();
}
__device__ __forceinline__ void phase10(const Params& p, unsigned char* lds) {
    moe_tables(p, lds);
    const PG8_LAS int* tp = (const PG8_LAS int*)((PG8_LAS unsigned char*)lds + MISC_OFF) + 32; const PG8_LAS int* cn = tp + 64;
    pg8::SchedMoE1 S{tp, cn, (const int*)(p.ws + WS_LIST), (const bf16*)(p.ws + WS_WE1), (int)gridDim.x, (int)blockIdx.x};
    pg8::EpiSwiglu E{(bf16*)(p.ws + WS_HID)};
    pg8::gemm_phase<pg8::EpiSwiglu, pg8::SchedMoE1, true, 1>((PG8_LAS unsigned char*)lds, (const void*)(p.ws + WS_H), D, S, E);
}
__device__ __forceinline__ void phase11(const Params& p, unsigned char* lds) {
    const PG8_LAS int* tp = (const PG8_LAS int*)((PG8_LAS unsigned char*)lds + MISC_OFF) + 32; const PG8_LAS int* cn = tp + 64;
    pg8::SchedMoE2 S{tp, (const bf16*)(p.ws + WS_WE2), (int)gridDim.x, (int)blockIdx.x};
    pg8::EpiScatter E{(bf16*)(p.ws + WS_PROJ), cn, (const int*)(p.ws + WS_LIST)};
    pg8::gemm_phase<pg8::EpiScatter, pg8::SchedMoE2, true, 1>((PG8_LAS unsigned char*)lds, (const void*)(p.ws + WS_HID), DE, S, E);
}

__device__ __forceinline__ void phase12(const Params& p) {
    const int tid = ltid(), lane = tid & 63, wave = tid >> 6, G = gridDim.x;
    const int gw = blockIdx.x * 8 + wave, NGW = G * 8;
    const float* MOD = (const float*)(p.ws + WS_MOD); const bf16* Y = (const bf16*)(p.ws + WS_PROJ); const bf16* XM = (const bf16*)(p.ws + WS_XMID);
    f32x4 gfin[4];
#pragma unroll
    for (int j = 0; j < 4; ++j) gfin[j] = ((const f32x4*)p.in[19])[lane + 64 * j];
    for (int row = gw; row < T; row += 2 * NGW) {
        unsigned long long xw[2][4], y0[2][4], y1[2][4]; f32x4 gt[2][4];
#pragma unroll
        for (int rr = 0; rr < 2; ++rr) {
            const int r = min(row + rr * NGW, T - 1);
#pragma unroll
            for (int j = 0; j < 4; ++j) {
                xw[rr][j] = ((const unsigned long long*)(XM + (size_t)r * D))[lane + 64 * j];
                y0[rr][j] = ((const unsigned long long*)(Y + (size_t)(2 * r) * 1024))[lane + 64 * j];
                y1[rr][j] = ((const unsigned long long*)(Y + (size_t)(2 * r + 1) * 1024))[lane + 64 * j];
                gt[rr][j] = ((const f32x4*)(MOD + (r >> 13) * 6144 + 5120))[lane + 64 * j];
            }
        }
#pragma unroll
        for (int rr = 0; rr < 2; ++rr) {
            const int r = row + rr * NGW;
            f32x4 v[4]; float ss = 0.f;
#pragma unroll
            for (int j = 0; j < 4; ++j) {
                const unsigned long long a = xw[rr][j], b0 = y0[rr][j], b1 = y1[rr][j];
                f32x4 xv, ys;
                xv.x = bf2f((unsigned)(a & 0xffff)); xv.y = bf2f((unsigned)((a >> 16) & 0xffff)); xv.z = bf2f((unsigned)((a >> 32) & 0xffff)); xv.w = bf2f((unsigned)(a >> 48));
                ys.x = bf2f((unsigned)(b0 & 0xffff)) + bf2f((unsigned)(b1 & 0xffff));
                ys.y = bf2f((unsigned)((b0 >> 16) & 0xffff)) + bf2f((unsigned)((b1 >> 16) & 0xffff));
                ys.z = bf2f((unsigned)((b0 >> 32) & 0xffff)) + bf2f((unsigned)((b1 >> 32) & 0xffff));
                ys.w = bf2f((unsigned)(b0 >> 48)) + bf2f((unsigned)(b1 >> 48));
                v[j] = xv + gt[rr][j] * ys;
                ss += v[j].x * v[j].x + v[j].y * v[j].y + v[j].z * v[j].z + v[j].w * v[j].w;
            }
            const float rn = frsq(wave_sum(ss) * (1.f / D) + EPS);
            if (r < T) {
#pragma unroll
                for (int j = 0; j < 4; ++j) ((f32x4*)(p.out + (size_t)r * D))[lane + 64 * j] = v[j] * rn * gfin[j];
            }
        }
    }
}

#define LAS __attribute__((address_space(3)))
#define XB_TMO      128
#define XB_XCNT(j)  (256  + 64 * (j))
#define XB_XSUB(j)  (1280 + 64 * (j))
#define XB_XGEN(j)  (2304 + 64 * (j))
#define XB_TOP      3328
#define XB_TOPGEN   3392
#define XCD_BAR_WORDS 3456
#define XB_SPIN_CAP (1u << 18)
__device__ __forceinline__ unsigned xb_ld(unsigned* p)              { return __hip_atomic_load(p, __ATOMIC_RELAXED, __HIP_MEMORY_SCOPE_AGENT); }
__device__ __forceinline__ unsigned xb_add(unsigned* p, unsigned v) { return __hip_atomic_fetch_add(p, v, __ATOMIC_RELAXED, __HIP_MEMORY_SCOPE_AGENT); }
__device__ __forceinline__ unsigned xb_xcc_id() { return (unsigned)__builtin_amdgcn_s_getreg((3 << 11) | 20) & 0xFu; }
#define XB_SPIN(cond, bar) do { unsigned _sp = 0; while (cond) { __builtin_amdgcn_s_sleep(1); \
    if ((++_sp & 255u) == 0u) { if (xb_ld(&(bar)[XB_TMO])) break; if (_sp > XB_SPIN_CAP) { atomicAdd(&(bar)[XB_TMO], 1u); break; } } } } while (0)
struct XcdBarrier { unsigned* bar; unsigned x; volatile LAS unsigned* st; };
__device__ __forceinline__ XcdBarrier xcd_barrier_post(unsigned* bar, volatile LAS unsigned* st) {
    XcdBarrier b; b.bar = bar; b.x = xb_xcc_id(); b.st = st;
    if (threadIdx.x == 0) (void)xb_add(&bar[XB_XCNT(b.x)], 1u);
    return b;
}
__device__ __forceinline__ void xcd_barrier_complete(unsigned* bar, unsigned x, unsigned& nloc, unsigned& nx) {
    const unsigned G = gridDim.x * gridDim.y * gridDim.z;
    unsigned sum, cnt, mine, sp = 0u;
    for (;;) {
        sum = 0u; cnt = 0u; mine = 0u;
#pragma unroll
        for (unsigned j = 0; j < 16; ++j) { const unsigned c = xb_ld(&bar[XB_XCNT(j)]); sum += c; cnt += (c > 0u) ? 1u : 0u; mine = (j == x) ? c : mine; }
        if (sum == G) break;
        __builtin_amdgcn_s_sleep(1);
        if ((++sp & 255u) == 0u) { if (xb_ld(&bar[XB_TMO])) break; if (sp > XB_SPIN_CAP) { atomicAdd(&bar[XB_TMO], 1u); break; } }
    }
    nloc = mine > 0u ? mine : 1u; nx = cnt > 0u ? cnt : 1u;
}
__device__ __forceinline__ void xcd_barrier(const XcdBarrier& b) {
    asm volatile("s_waitcnt vmcnt(0)" ::: "memory");
    __syncthreads();
    if (threadIdx.x == 0) {
        unsigned* bar = b.bar;
        __builtin_amdgcn_s_waitcnt(0);
        unsigned nloc = b.st[0], nx = b.st[1];
        if (nloc == 0u) { xcd_barrier_complete(bar, b.x, nloc, nx); b.st[0] = nloc; b.st[1] = nx; }
        const unsigned old = xb_add(&bar[XB_XSUB(b.x)], 1u);
        const unsigned gen = old / nloc;
        if (old + 1u == (gen + 1u) * nloc) {
            __builtin_amdgcn_fence(__ATOMIC_RELEASE, "agent");
            asm volatile("s_waitcnt vmcnt(0)" ::: "memory");
            const unsigned og = xb_add(&bar[XB_TOP], 1u);
            const unsigned tg = og / nx;
            if (og + 1u == (tg + 1u) * nx) xb_add(&bar[XB_TOPGEN], 1u);
            else XB_SPIN(xb_ld(&bar[XB_TOPGEN]) == tg, bar);
            __builtin_amdgcn_fence(__ATOMIC_ACQUIRE, "agent");
            xb_add(&bar[XB_XGEN(b.x)], 1u);
            asm volatile("s_waitcnt vmcnt(0)" ::: "memory");
        } else {
            XB_SPIN(xb_ld(&bar[XB_XGEN(b.x)]) == gen, bar);
            __builtin_amdgcn_fence(__ATOMIC_ACQUIRE, "agent");
            asm volatile("s_waitcnt vmcnt(0)" ::: "memory");
        }
    }
    __syncthreads();
}

constexpr int MISC_OFF_UNUSED = 0;
__global__ void __launch_bounds__(512, 2) mk_fwd(Params p) {
    extern __shared__ __attribute__((aligned(16))) unsigned char lds[];
    volatile LAS unsigned* MISC = (volatile LAS unsigned*)((LAS unsigned char*)lds + MISC_OFF);
    if (threadIdx.x < 256) MISC[threadIdx.x] = 0u;
    __syncthreads();
    XcdBarrier bar = xcd_barrier_post((unsigned*)(p.ws + WS_CTL) + CW_BAR, MISC + 8);
#ifndef REPEAT_PHASE
#define REPEAT_PHASE -1
#endif
#define PHASE(k, call) { call; xcd_barrier(bar); if ((k) == REPEAT_PHASE) { call; xcd_barrier(bar); call; xcd_barrier(bar); } }
    PHASE(0, phase0(p, lds))
    PHASE(1, phase1(p, lds))
    PHASE(2, phase2(p, lds))
    PHASE(4, phase4(p, lds))
    PHASE(5, phase5(p))
    PHASE(6, phase6(p, lds); phase7(p, lds))
    PHASE(8, phase8(p, lds))
    PHASE(9, phase9(p, lds))
    PHASE(10, phase10(p, lds))
    PHASE(11, phase11(p, lds))
    phase12(p);
}

extern "C" void kernel_launch(void* const* d_in, const int* in_sizes, int n_in, void* d_out, int out_size, void* d_ws, size_t ws_size, hipStream_t stream) {
    static int grid = 0;
    if (grid == 0) {
        if (n_in != 20 || in_sizes[0] != T * D || in_sizes[7] != D * IN_COLS || out_size != T * D || ws_size < WS_END) {
            fprintf(stderr, "kernel_launch: unexpected shapes (n_in %d in0 %d in7 %d out %d ws %zu)\n", n_in, n_in > 0 ? in_sizes[0] : -1, n_in > 7 ? in_sizes[7] : -1, out_size, ws_size); grid = -1; return; }
        int dev = 0, cus = 0;
        if (hipGetDevice(&dev) != hipSuccess || hipDeviceGetAttribute(&cus, hipDeviceAttributeMultiprocessorCount, dev) != hipSuccess) { grid = -1; return; }
        if (hipFuncSetAttribute((const void*)mk_fwd, hipFuncAttributeMaxDynamicSharedMemorySize, LDS_BYTES) != hipSuccess) { grid = -1; return; }
        grid = cus;
    }
    if (grid < 0) return;
    (void)hipMemsetAsync((char*)d_ws + WS_CTL, 0, CTL_BYTES, stream);
    Params a{};
    for (int i = 0; i < 20; ++i) a.in[i] = (const float*)d_in[i];
    a.out = (float*)d_out; a.ws = (unsigned char*)d_ws;
    hipLaunchKernelGGL(mk_fwd, dim3(grid), dim3(512), LDS_BYTES, stream, a);
}
```
